# Optimizing an MI355X kernel written in HIP

```python
import jax
import jax.numpy as jnp
from jax import lax
import numpy as np

D_MODEL = 1024
BATCH = 16
SEQ = 2048
DEPTH = 4

N_MIXERS = 3
HEAD_DIM = 64
MEM_LEN = 256
MEM_HEADS = 4
MEM_WIDTH = MEM_HEADS * HEAD_DIM
MIX_WIDTH = 3 * D_MODEL // 4
CONV_WIDTH = 3
DIL_GROUPS = ((128, 1), (512, 4), (2048, 16))
DIL_HEADS = 4
DIL_WIDTH = DIL_HEADS * HEAD_DIM
DIL_QKV_WIDTH = len(DIL_GROUPS) * DIL_WIDTH
POOL_WINDOWS = (2, 4, 8, 16)
POOL_GROUP = MIX_WIDTH // len(POOL_WINDOWS)
D_FF = 2816
N_EXPERTS = 8
TOP_K = 2
D_FF_EXPERT = 3584
MOE_BLOCK = 256
LN_EPS = 1e-5
NEG_INF = -1e30
DEEPNORM_ALPHA = (2 * DEPTH) ** 0.25
DEEPNORM_BETA = (8 * DEPTH) ** -0.25
N_A = (DEPTH + 2) // 3
N_B = (DEPTH + 1) // 3
N_C = DEPTH // 3
N_DENSE = (DEPTH + 1) // 2
N_MOE = DEPTH // 2

kernel_name = "hybrid_conv_dilattn_pool_moe_encoder"


def _normal(key, shape, fan_in, scale=1.0):
    return jax.random.normal(key, shape, jnp.float32) * (scale * fan_in ** -0.5)


def setup_inputs(seed: int = 0) -> dict:
    key = jax.random.key(seed)
    ks = iter(jax.random.split(key, 32))
    d = D_MODEL
    beta = DEEPNORM_BETA
    x = jax.random.normal(next(ks), (BATCH, SEQ, d), jnp.float32)
    mem = jax.random.normal(next(ks), (BATCH, MEM_LEN, d), jnp.float32)
    w_mem_kv = jnp.concatenate([_normal(next(ks), (d, MEM_WIDTH), d),
                                _normal(next(ks), (d, MEM_WIDTH), d, beta)], axis=1)
    a_w_in = _normal(next(ks), (N_A, d, 3 * MIX_WIDTH + MEM_WIDTH), d)
    a_conv_w = _normal(next(ks), (N_A, CONV_WIDTH, MIX_WIDTH), CONV_WIDTH)
    a_w_out = _normal(next(ks), (N_A, MIX_WIDTH + MEM_WIDTH, d), MIX_WIDTH + MEM_WIDTH, beta)
    b_w_in = jnp.concatenate([_normal(next(ks), (N_B, d, 2 * DIL_QKV_WIDTH), d),
                              _normal(next(ks), (N_B, d, DIL_QKV_WIDTH), d, beta),
                              _normal(next(ks), (N_B, d, MEM_WIDTH), d)], axis=-1)
    b_w_out = _normal(next(ks), (N_B, DIL_WIDTH + MEM_WIDTH, d), DIL_WIDTH + MEM_WIDTH, beta)
    c_w_in = _normal(next(ks), (N_C, d, MIX_WIDTH + MEM_WIDTH), d)
    c_pool_w = _normal(next(ks), (N_C, len(POOL_WINDOWS), POOL_GROUP, POOL_GROUP), POOL_GROUP)
    c_pool_scale = 1.0 + 0.1 * jax.random.normal(next(ks), (N_C, MIX_WIDTH), jnp.float32)
    c_w_out = _normal(next(ks), (N_C, MIX_WIDTH + MEM_WIDTH, d), MIX_WIDTH + MEM_WIDTH, beta)
    ln_g = 1.0 + 0.02 * jax.random.normal(next(ks), (DEPTH, 2, d), jnp.float32)
    ln_b = 0.02 * jax.random.normal(next(ks), (DEPTH, 2, d), jnp.float32)
    ffn_w_gate = _normal(next(ks), (N_DENSE, d, D_FF), d)
    ffn_w_up = _normal(next(ks), (N_DENSE, d, D_FF), d)
    ffn_w_down = _normal(next(ks), (N_DENSE, D_FF, d), D_FF, beta)
    moe_router = _normal(next(ks), (N_MOE, d, N_EXPERTS), d)
    moe_w_gate = _normal(next(ks), (N_MOE, N_EXPERTS, d, D_FF_EXPERT), d)
    moe_w_up = _normal(next(ks), (N_MOE, N_EXPERTS, d, D_FF_EXPERT), d)
    moe_w_down = _normal(next(ks), (N_MOE, N_EXPERTS, D_FF_EXPERT, d), D_FF_EXPERT, beta)
    return {"x": x, "mem": mem, "w_mem_kv": w_mem_kv,
            "a_w_in": a_w_in, "a_conv_w": a_conv_w, "a_w_out": a_w_out,
            "b_w_in": b_w_in, "b_w_out": b_w_out,
            "c_w_in": c_w_in, "c_pool_w": c_pool_w, "c_pool_scale": c_pool_scale, "c_w_out": c_w_out,
            "ln_g": ln_g, "ln_b": ln_b,
            "ffn_w_gate": ffn_w_gate, "ffn_w_up": ffn_w_up, "ffn_w_down": ffn_w_down,
            "moe_router": moe_router, "moe_w_gate": moe_w_gate, "moe_w_up": moe_w_up,
            "moe_w_down": moe_w_down}


def _layer_norm(x, g, b):
    xf = x.astype(jnp.float32)
    mu = jnp.mean(xf, axis=-1, keepdims=True)
    var = jnp.mean(jnp.square(xf - mu), axis=-1, keepdims=True)
    return ((xf - mu) * lax.rsqrt(var + LN_EPS) * g + b).astype(x.dtype)


def _alibi_slopes(n):
    return 2.0 ** (-8.0 * jnp.arange(1, n + 1, dtype=jnp.float32) / n)


def _mem_attention(q, mem_k, mem_v):
    b, s, _ = q.shape
    q = q.reshape(b, s, MEM_HEADS, HEAD_DIM)
    scores = jnp.einsum('bshc,bmhc->bhsm', q, mem_k).astype(jnp.float32) * HEAD_DIM ** -0.5
    p = jax.nn.softmax(scores, axis=-1)
    out = jnp.einsum('bhsm,bmhc->bshc', p.astype(mem_v.dtype), mem_v)
    return out.reshape(b, s, MEM_WIDTH)


def _short_conv_mixer(h, conv_w):
    gate_b, gate_c, u = jnp.split(h, 3, axis=-1)
    z = jnp.pad(gate_c * u, ((0, 0), (1, 1), (0, 0)))
    conv = conv_w[0] * z[:, :-2] + conv_w[1] * z[:, 1:-1] + conv_w[2] * z[:, 2:]
    return gate_b * conv


def _dilated_group(q, k, v, window, dilation, slopes):
    b, s, h, c = q.shape
    radius = (window // 2) // dilation
    blk = radius
    n_sub = s // dilation
    nb = -(-n_sub // blk)
    lp = nb * blk

    def by_residue(a):
        return a.reshape(b, n_sub, dilation, h, c)

    qs = jnp.pad(by_residue(q), ((0, 0), (0, lp - n_sub), (0, 0), (0, 0), (0, 0)))
    qs = qs.reshape(b, nb, blk, dilation, h, c)

    def key_windows(a):
        ap = jnp.pad(by_residue(a), ((0, 0), (blk, lp - n_sub + blk), (0, 0), (0, 0), (0, 0)))
        ap = ap.reshape(b, nb + 2, blk, dilation, h, c)
        return jnp.concatenate([ap[:, :-2], ap[:, 1:-1], ap[:, 2:]], axis=2)

    kw = key_windows(k)
    vw = key_windows(v)
    scores = jnp.einsum('bnqrhc,bnkrhc->bnrhqk', qs, kw).astype(jnp.float32) * c ** -0.5
    qi = jnp.arange(blk)
    ki = jnp.arange(3 * blk)
    diff = ki[None, :] - blk - qi[:, None]
    key_j = jnp.arange(nb)[:, None] * blk - blk + ki[None, :]
    mask = (jnp.abs(diff) <= radius)[None] & ((key_j >= 0) & (key_j < n_sub))[:, None, :]
    bias = -slopes[:, None, None] * (jnp.abs(diff) * dilation).astype(jnp.float32)[None]
    scores = jnp.where(mask[None, :, None, None], scores + bias[None, None, None], NEG_INF)
    m = jnp.max(scores, axis=-1, keepdims=True)
    p = jnp.exp(scores - m)
    den = jnp.sum(p, axis=-1)
    lse = m[..., 0] + jnp.log(den)
    out = jnp.einsum('bnrhqk,bnkrhc->bnqrhc', p, vw.astype(jnp.float32))
    out = out / jnp.transpose(den, (0, 1, 4, 2, 3))[..., None]
    out = out.reshape(b, lp, dilation, h, c)[:, :n_sub].reshape(b, s, h, c)
    lse = jnp.transpose(lse, (0, 1, 4, 2, 3)).reshape(b, lp, dilation, h)[:, :n_sub].reshape(b, s, h)
    return out, lse


def _dilated_mixer(h):
    b, s, _ = h.shape
    n_g = len(DIL_GROUPS)
    q, k, v = [h[..., i * DIL_QKV_WIDTH:(i + 1) * DIL_QKV_WIDTH].reshape(b, s, n_g, DIL_HEADS, HEAD_DIM)
               for i in range(3)]
    slopes = _alibi_slopes(n_g * DIL_HEADS).reshape(n_g, DIL_HEADS)
    outs, lses = [], []
    for g, (window, dilation) in enumerate(DIL_GROUPS):
        o, l = _dilated_group(q[:, :, g], k[:, :, g], v[:, :, g], window, dilation, slopes[g])
        outs.append(o)
        lses.append(l)
    wts = jax.nn.softmax(jnp.stack(lses), axis=0)
    out = jnp.sum(wts[..., None] * jnp.stack(outs), axis=0)
    return out.reshape(b, s, DIL_WIDTH).astype(h.dtype)


def _pool_mixer(u, pool_w, pool_scale):
    b, s, _ = u.shape
    cs = jnp.pad(jnp.cumsum(u.astype(jnp.float32), axis=1), ((0, 0), (1, 0), (0, 0)))
    t = jnp.arange(s)
    pooled = []
    for g, w in enumerate(POOL_WINDOWS):
        lo = jnp.clip(t - w // 2, 0, s - 1)
        hi = jnp.clip(t + w // 2 - 1, 0, s - 1)
        csg = cs[..., g * POOL_GROUP:(g + 1) * POOL_GROUP]
        cnt = (hi - lo + 1).astype(jnp.float32)[None, :, None]
        pooled.append((jnp.take(csg, hi + 1, axis=1) - jnp.take(csg, lo, axis=1)) / cnt)
    pooled = jnp.stack(pooled, axis=2)
    ug = u.reshape(b, s, len(POOL_WINDOWS), POOL_GROUP)
    diff = (pooled - ug.astype(jnp.float32)).astype(u.dtype)
    y = jnp.einsum('bsgc,gcd->bsgd', diff, pool_w).reshape(b, s, MIX_WIDTH)
    return y * pool_scale


def _swiglu(x, w_gate, w_up, w_down):
    hdn = jax.nn.silu(jnp.einsum('bsd,df->bsf', x, w_gate)) * jnp.einsum('bsd,df->bsf', x, w_up)
    return jnp.einsum('bsf,fd->bsd', hdn, w_down)


def _moe(x, router, w_gate, w_up, w_down):
    b, s, d = x.shape
    xf = x.reshape(-1, d)
    t = xf.shape[0]
    logits = (xf @ router).astype(jnp.float32)
    top_logit, top_idx = lax.top_k(logits, TOP_K)
    top_w = jax.nn.softmax(top_logit, axis=-1)
    a = t * TOP_K
    e_flat = top_idx.reshape(a)
    tok_flat = jnp.repeat(jnp.arange(t, dtype=jnp.int32), TOP_K)
    w_flat = top_w.reshape(a)
    order = jnp.argsort(e_flat)
    e_sorted = e_flat[order]
    counts = jnp.bincount(e_flat, length=N_EXPERTS)
    padded = (counts + MOE_BLOCK - 1) // MOE_BLOCK * MOE_BLOCK
    pad_end = jnp.cumsum(padded)
    pad_start = pad_end - padded
    start = jnp.cumsum(counts) - counts
    dest = pad_start[e_sorted] + jnp.arange(a) - start[e_sorted]
    n_blocks = -(-a // MOE_BLOCK) + N_EXPERTS
    rows = n_blocks * MOE_BLOCK
    row_tok = jnp.zeros((rows,), jnp.int32).at[dest].set(tok_flat[order])
    row_w = jnp.zeros((rows,), jnp.float32).at[dest].set(w_flat[order])
    block_e = jnp.minimum(jnp.searchsorted(pad_end, jnp.arange(n_blocks) * MOE_BLOCK, side='right'),
                          N_EXPERTS - 1)
    xb = xf[row_tok].reshape(n_blocks, MOE_BLOCK, d)

    def expert_block(args):
        xblk, e = args
        hdn = jax.nn.silu(xblk @ w_gate[e]) * (xblk @ w_up[e])
        return hdn @ w_down[e]

    yb = lax.map(expert_block, (xb, block_e)).reshape(rows, d)
    y = jax.ops.segment_sum(yb * row_w[:, None].astype(yb.dtype), row_tok, num_segments=t)
    return y.reshape(b, s, d)


def reference(x, mem, w_mem_kv, a_w_in, a_conv_w, a_w_out, b_w_in, b_w_out,
              c_w_in, c_pool_w, c_pool_scale, c_w_out, ln_g, ln_b,
              ffn_w_gate, ffn_w_up, ffn_w_down, moe_router, moe_w_gate, moe_w_up, moe_w_down):
    b = x.shape[0]
    m_len = mem.shape[1]
    kv = jnp.einsum('bmd,de->bme', mem, w_mem_kv).reshape(b, m_len, 2, MEM_HEADS, HEAD_DIM)
    mem_k, mem_v = kv[:, :, 0], kv[:, :, 1]
    for i in range(DEPTH):
        kind = i % N_MIXERS
        j = i // N_MIXERS
        if kind == 0:
            h = jnp.einsum('bsd,de->bse', x, a_w_in[j])
            mix = _short_conv_mixer(h[..., :3 * MIX_WIDTH], a_conv_w[j])
            q_mem = h[..., 3 * MIX_WIDTH:]
            w_out = a_w_out[j]
        elif kind == 1:
            h = jnp.einsum('bsd,de->bse', x, b_w_in[j])
            mix = _dilated_mixer(h[..., :3 * DIL_QKV_WIDTH])
            q_mem = h[..., 3 * DIL_QKV_WIDTH:]
            w_out = b_w_out[j]
        else:
            h = jnp.einsum('bsd,de->bse', x, c_w_in[j])
            mix = _pool_mixer(h[..., :MIX_WIDTH], c_pool_w[j], c_pool_scale[j])
            q_mem = h[..., MIX_WIDTH:]
            w_out = c_w_out[j]
        mem_out = _mem_attention(q_mem, mem_k, mem_v)
        y = jnp.einsum('bse,ed->bsd', jnp.concatenate([mix, mem_out], axis=-1), w_out)
        x = _layer_norm(DEEPNORM_ALPHA * x + y, ln_g[i, 0], ln_b[i, 0])
        f = i // 2
        if i % 2 == 0:
            y = _swiglu(x, ffn_w_gate[f], ffn_w_up[f], ffn_w_down[f])
        else:
            y = _moe(x, moe_router[f], moe_w_gate[f], moe_w_up[f], moe_w_down[f])
        x = _layer_norm(DEEPNORM_ALPHA * x + y, ln_g[i, 1], ln_b[i, 1])
    return x
```

```cpp
#include <hip/hip_runtime.h>
#include <cstdio>
#include <cstdint>

#ifndef MK_ONE_LAUNCH
#define MK_ONE_LAUNCH 0
#endif
#ifndef FAST_GEMM
#define FAST_GEMM 0
#endif
#ifndef FAST_ATTN
#define FAST_ATTN 0
#endif

#define GAS __attribute__((address_space(1)))
#define LAS __attribute__((address_space(3)))
typedef unsigned short bf16;
typedef unsigned v4u __attribute__((ext_vector_type(4)));
typedef unsigned v2u __attribute__((ext_vector_type(2)));
typedef float f32x4 __attribute__((ext_vector_type(4)));
typedef float f32x2 __attribute__((ext_vector_type(2)));
typedef float f32x16 __attribute__((ext_vector_type(16)));
typedef short bf16x8 __attribute__((ext_vector_type(8)));
typedef short s16x4 __attribute__((ext_vector_type(4)));
#define RLX_AGENT __ATOMIC_RELAXED, __HIP_MEMORY_SCOPE_AGENT
#define LDS_WAIT() asm volatile("s_waitcnt lgkmcnt(0)" ::: "memory")
#define VM_WAIT() asm volatile("s_waitcnt vmcnt(0)" ::: "memory")

constexpr int NB = 16, SEQ = 2048, T = NB * SEQ, D = 1024, ML = 256, MEMW = 256, MIXW = 768, HD = 64;
constexpr int FF = 2816, FFE = 3584, NE = 8;
constexpr int RMAX = (2 * T / 256 + NE) * 256;
constexpr float ALPHA = 1.6817928305074290f;
constexpr float LN_EPS = 1e-5f;
constexpr int NWAVES = 8, NTHREADS = 512, GRID = 256, NGW = GRID * NWAVES;

constexpr size_t MiB = 1u << 20;
constexpr size_t WS_CTL = 0, CTL_ZERO_BYTES = 1 * MiB;
constexpr size_t WS_META = 1 * MiB;
constexpr size_t WS_TOK = 2 * MiB;
constexpr size_t WS_WS = 4 * MiB;
constexpr size_t WS_WMOE = 64 * MiB;
constexpr size_t WS_XB = 232 * MiB;
constexpr size_t WS_MEMB = 296 * MiB;
constexpr size_t WS_MEMKV = 304 * MiB;
constexpr size_t WS_SCR = 308 * MiB;
constexpr size_t SC_H = 0, SC_CAT = 160 * MiB, SC_OG = 224 * MiB, SC_LSE = 320 * MiB, SC_DIFF = 224 * MiB;
constexpr size_t SC_HID = 0;
constexpr size_t SC_XS = 0, SC_HS = 132 * MiB;
constexpr size_t WS_END = WS_SCR + SC_HS + (size_t)RMAX * FFE * 2;
static_assert(WS_END <= 903 * MiB, "ws map");
constexpr size_t OFF_WKV = 0, OFF_AIN = 524288, OFF_AOUT = 5767168, OFF_BIN = 7864320, OFF_BOUT = 10485760, OFF_CIN = 11010048,
                 OFF_COUT = 12058624, OFF_FGU = 13107200, OFF_FD = 24641536, OFF_WS_END = 30408704;
static_assert(OFF_WS_END * 2 <= 60 * MiB, "small weights");
constexpr size_t OFF_MGU = 0, OFF_MD = (size_t)NE * 2 * FFE * D;
constexpr int CW_BAR = 4096;

constexpr int RING_BYTES = 131072, LDSCTL_OFF = RING_BYTES, MISC_OFF = LDSCTL_OFF + 320, LDS_BYTES = 147456;

__device__ __forceinline__ unsigned f2bf(float f) { unsigned u = __builtin_bit_cast(unsigned, f); return (u + 0x7fffu + ((u >> 16) & 1u)) >> 16; }
__device__ __forceinline__ unsigned pk2(float lo, float hi) { return f2bf(lo) | (f2bf(hi) << 16); }
__device__ __forceinline__ float bf2f(unsigned b) { return __builtin_bit_cast(float, b << 16); }
__device__ __forceinline__ float bflo(unsigned w) { return __builtin_bit_cast(float, w << 16); }
__device__ __forceinline__ float bfhi(unsigned w) { return __builtin_bit_cast(float, w & 0xffff0000u); }
__device__ __forceinline__ float wave_sum(float v) {
#pragma unroll
    for (int o = 1; o < 64; o <<= 1) v += __shfl_xor(v, o);
    return v;
}
__device__ __forceinline__ int ld_i32_agent(const int* p) { return (int)__hip_atomic_load((const unsigned*)p, RLX_AGENT); }
__device__ __forceinline__ float ld_f32_agent(const float* p) { return __builtin_bit_cast(float, __hip_atomic_load((const unsigned*)p, RLX_AGENT)); }

#define XB_TMO      128
#define XB_XCNT(j)  (256  + 64 * (j))
#define XB_XSUB(j)  (1280 + 64 * (j))
#define XB_XGEN(j)  (2304 + 64 * (j))
#define XB_TOP      3328
#define XB_TOPGEN   3392
#define XCD_BAR_WORDS 3456
#define XB_SPIN_CAP (1u << 18)
__device__ __forceinline__ unsigned xb_ld(unsigned* p)              { return __hip_atomic_load(p, __ATOMIC_RELAXED, __HIP_MEMORY_SCOPE_AGENT); }
__device__ __forceinline__ unsigned xb_add(unsigned* p, unsigned v) { return __hip_atomic_fetch_add(p, v, __ATOMIC_RELAXED, __HIP_MEMORY_SCOPE_AGENT); }
__device__ __forceinline__ unsigned xb_xcc_id() { return (unsigned)__builtin_amdgcn_s_getreg((3 << 11) | 20) & 0xFu; }
#define XB_SPIN(cond, bar) do { unsigned _sp = 0; while (cond) { __builtin_amdgcn_s_sleep(1); \
    if ((++_sp & 255u) == 0u) { if (xb_ld(&(bar)[XB_TMO])) break; if (_sp > XB_SPIN_CAP) { atomicAdd(&(bar)[XB_TMO], 1u); break; } } } } while (0)
struct XcdBarrier { unsigned* bar; unsigned x; volatile LAS unsigned* st; };
__device__ __forceinline__ XcdBarrier xcd_barrier_post(unsigned* bar, volatile LAS unsigned* st) {
    XcdBarrier b; b.bar = bar; b.x = xb_xcc_id(); b.st = st;
    if (threadIdx.x == 0) (void)xb_add(&bar[XB_XCNT(b.x)], 1u);
    return b;
}
__device__ __forceinline__ void xcd_barrier_complete(unsigned* bar, unsigned x, unsigned& nloc, unsigned& nx) {
    const unsigned G = gridDim.x * gridDim.y * gridDim.z;
    unsigned sum, cnt, mine, sp = 0u;
    for (;;) {
        sum = 0u; cnt = 0u; mine = 0u;
#pragma unroll
        for (unsigned j = 0; j < 16; ++j) { const unsigned c = xb_ld(&bar[XB_XCNT(j)]); sum += c; cnt += (c > 0u) ? 1u : 0u; mine = (j == x) ? c : mine; }
        if (sum == G) break;
        __builtin_amdgcn_s_sleep(1);
        if ((++sp & 255u) == 0u) { if (xb_ld(&bar[XB_TMO])) break; if (sp > XB_SPIN_CAP) { atomicAdd(&bar[XB_TMO], 1u); break; } }
    }
    nloc = mine > 0u ? mine : 1u; nx = cnt > 0u ? cnt : 1u;
}
__device__ __forceinline__ void xcd_barrier(const XcdBarrier& b) {
    asm volatile("s_waitcnt vmcnt(0)" ::: "memory");
    __syncthreads();
    if (threadIdx.x == 0) {
        unsigned* bar = b.bar;
        __builtin_amdgcn_s_waitcnt(0);
        unsigned nloc = b.st[0], nx = b.st[1];
        if (nloc == 0u) { xcd_barrier_complete(bar, b.x, nloc, nx); b.st[0] = nloc; b.st[1] = nx; }
        const unsigned old = xb_add(&bar[XB_XSUB(b.x)], 1u);
        const unsigned gen = old / nloc;
        if (old + 1u == (gen + 1u) * nloc) {
            __builtin_amdgcn_fence(__ATOMIC_RELEASE, "agent");
            asm volatile("s_waitcnt vmcnt(0)" ::: "memory");
            const unsigned og = xb_add(&bar[XB_TOP], 1u);
            const unsigned tg = og / nx;
            if (og + 1u == (tg + 1u) * nx) xb_add(&bar[XB_TOPGEN], 1u);
            else XB_SPIN(xb_ld(&bar[XB_TOPGEN]) == tg, bar);
            __builtin_amdgcn_fence(__ATOMIC_ACQUIRE, "agent");
            xb_add(&bar[XB_XGEN(b.x)], 1u);
            asm volatile("s_waitcnt vmcnt(0)" ::: "memory");
        } else {
            XB_SPIN(xb_ld(&bar[XB_XGEN(b.x)]) == gen, bar);
            __builtin_amdgcn_fence(__ATOMIC_ACQUIRE, "agent");
            asm volatile("s_waitcnt vmcnt(0)" ::: "memory");
        }
    }
    __syncthreads();
}

struct Args { const float* in[21]; float* out; unsigned char* ws; int lo, hi; };
enum { I_X = 0, I_MEM, I_WMEMKV, I_AWIN, I_ACONV, I_AWOUT, I_BWIN, I_BWOUT, I_CWIN, I_CPOOLW, I_CPOOLS, I_CWOUT, I_LNG, I_LNB,
       I_FG, I_FU, I_FD, I_ROUTER, I_MG, I_MU, I_MD };
struct Frame { LAS unsigned char* lds; int tid, lane, wave, gw; };

template <int NWM, class Epi>
__device__ __forceinline__ void naive_gemm(const Frame& F, const bf16* A, int lda, const float* W0, const float* W1, int ldw, int M, int N, int K, const Epi& epi, const int* tile_e, size_t wstride) {
    const int lane = F.lane, r16 = lane & 15, q4 = lane >> 4;
    const int tn = N / 32, ntiles = (M / 32) * tn;
    for (int tile = F.gw; tile < ntiles; tile += NGW) {
        const int m0 = (tile / tn) * 32, n0 = (tile % tn) * 32;
        size_t woff = 0;
        if (tile_e) woff = (size_t)ld_i32_agent(tile_e + (m0 >> 8)) * wstride;
        const float* w0 = W0 + woff; const float* w1 = (NWM == 2) ? W1 + woff : nullptr;
        f32x4 acc[NWM][2][2];
#pragma unroll
        for (int w = 0; w < NWM; ++w)
#pragma unroll
            for (int i = 0; i < 2; ++i)
#pragma unroll
                for (int j = 0; j < 2; ++j) acc[w][i][j] = (f32x4){0.f, 0.f, 0.f, 0.f};
        for (int k0 = 0; k0 < K; k0 += 32) {
            bf16x8 a[2], b[NWM][2];
#pragma unroll
            for (int i = 0; i < 2; ++i) a[i] = *(const bf16x8*)(A + (size_t)(m0 + 16 * i + r16) * lda + k0 + 8 * q4);
#pragma unroll
            for (int w = 0; w < NWM; ++w)
#pragma unroll
                for (int jn = 0; jn < 2; ++jn) {
                    const float* wp = (w == 0 ? w0 : w1) + (size_t)(k0 + 8 * q4) * ldw + n0 + 16 * jn + r16;
#pragma unroll
                    for (int j = 0; j < 8; ++j) b[w][jn][j] = (short)f2bf(wp[(size_t)j * ldw]);
                }
#pragma unroll
            for (int w = 0; w < NWM; ++w)
#pragma unroll
                for (int i = 0; i < 2; ++i)
#pragma unroll
                    for (int jn = 0; jn < 2; ++jn) acc[w][i][jn] = __builtin_amdgcn_mfma_f32_16x16x32_bf16(a[i], b[w][jn], acc[w][i][jn], 0, 0, 0);
        }
#pragma unroll
        for (int i = 0; i < 2; ++i)
#pragma unroll
            for (int jn = 0; jn < 2; ++jn)
#pragma unroll
                for (int r = 0; r < 4; ++r) {
                    const int row = m0 + 16 * i + q4 * 4 + r, col = n0 + 16 * jn + r16;
                    if constexpr (NWM == 2) epi(row, col, acc[0][i][jn][r], acc[1][i][jn][r]); else epi(row, col, acc[0][i][jn][r], 0.f);
                }
    }
}
struct NEpiBf16 { bf16* O; int ldo; __device__ __forceinline__ void operator()(int r, int c, float v, float) const { O[(size_t)r * ldo + c] = (bf16)f2bf(v); } };
struct NEpiResid { const float* base; float* out; __device__ __forceinline__ void operator()(int r, int c, float v, float) const { const size_t o = (size_t)r * D + c; out[o] = ALPHA * base[o] + v; } };
struct NEpiSwiglu { bf16* O; int ldo; __device__ __forceinline__ void operator()(int r, int c, float g, float u) const { const float s = g / (1.f + __expf(-g)); O[(size_t)r * ldo + c] = (bf16)f2bf(s * u); } };
struct NEpiScale { bf16* O; int ldo; int coff; const float* scale; __device__ __forceinline__ void operator()(int r, int c, float v, float) const { O[(size_t)r * ldo + coff + c] = (bf16)f2bf(v * scale[coff + c]); } };

__device__ __forceinline__ void prep_phase(const Frame& F, const float* x, const float* mem, bf16* XB, bf16* MEMB) {
    const size_t gt = (size_t)blockIdx.x * NTHREADS + F.tid, NT = (size_t)GRID * NTHREADS;
    for (size_t i = gt; i < (size_t)T * D / 8; i += NT) { const f32x4 a = ((const f32x4*)x)[2 * i], b = ((const f32x4*)x)[2 * i + 1];
        v4u o; o.x = pk2(a.x, a.y); o.y = pk2(a.z, a.w); o.z = pk2(b.x, b.y); o.w = pk2(b.z, b.w); ((v4u*)XB)[i] = o; }
    for (size_t i = gt; i < (size_t)NB * ML * D / 8; i += NT) { const f32x4 a = ((const f32x4*)mem)[2 * i], b = ((const f32x4*)mem)[2 * i + 1];
        v4u o; o.x = pk2(a.x, a.y); o.y = pk2(a.z, a.w); o.z = pk2(b.x, b.y); o.w = pk2(b.z, b.w); ((v4u*)MEMB)[i] = o; }
}
__device__ __forceinline__ void unpack8(const v4u w, float (&f)[8]) { f[0] = bflo(w.x); f[1] = bfhi(w.x); f[2] = bflo(w.y); f[3] = bfhi(w.y); f[4] = bflo(w.z); f[5] = bfhi(w.z); f[6] = bflo(w.w); f[7] = bfhi(w.w); }
__device__ __forceinline__ v4u pack8(const float (&f)[8]) { v4u o; o.x = pk2(f[0], f[1]); o.y = pk2(f[2], f[3]); o.z = pk2(f[4], f[5]); o.w = pk2(f[6], f[7]); return o; }

__device__ __forceinline__ void mixA_phase(const Frame& F, const bf16* H, const float* convw, bf16* CAT) {
    const size_t gt = (size_t)blockIdx.x * NTHREADS + F.tid, NT = (size_t)GRID * NTHREADS;
    for (size_t it = gt; it < (size_t)T * 96; it += NT) {
        const int t = (int)(it / 96), c8 = (int)(it % 96) * 8, s = t & (SEQ - 1);
        const bf16* hr = H + (size_t)t * 2560 + c8;
        float gb[8], z0[8], z1[8], z2[8], a[8], b[8];
        unpack8(*(const v4u*)hr, gb);
        unpack8(*(const v4u*)(hr + 768), a); unpack8(*(const v4u*)(hr + 1536), b);
#pragma unroll
        for (int i = 0; i < 8; ++i) z1[i] = a[i] * b[i];
        if (s > 0) { unpack8(*(const v4u*)(hr - 2560 + 768), a); unpack8(*(const v4u*)(hr - 2560 + 1536), b);
#pragma unroll
            for (int i = 0; i < 8; ++i) z0[i] = a[i] * b[i]; }
        else {
#pragma unroll
            for (int i = 0; i < 8; ++i) z0[i] = 0.f; }
        if (s < SEQ - 1) { unpack8(*(const v4u*)(hr + 2560 + 768), a); unpack8(*(const v4u*)(hr + 2560 + 1536), b);
#pragma unroll
            for (int i = 0; i < 8; ++i) z2[i] = a[i] * b[i]; }
        else {
#pragma unroll
            for (int i = 0; i < 8; ++i) z2[i] = 0.f; }
        float o[8];
#pragma unroll
        for (int i = 0; i < 8; ++i) o[i] = gb[i] * (convw[c8 + i] * z0[i] + convw[768 + c8 + i] * z1[i] + convw[1536 + c8 + i] * z2[i]);
        *(v4u*)(CAT + (size_t)t * 1024 + c8) = pack8(o);
    }
}
__device__ __forceinline__ void poolC_phase(const Frame& F, const bf16* H, bf16* OUT, int ldo) {
    const size_t gt = (size_t)blockIdx.x * NTHREADS + F.tid, NT = (size_t)GRID * NTHREADS;
    for (size_t it = gt; it < (size_t)T * 96; it += NT) {
        const int t = (int)(it / 96), ch = (int)(it % 96), c8 = ch * 8, s = t & (SEQ - 1), g = ch / 24, w = 2 << g;
        int lo = s - w / 2; lo = lo < 0 ? 0 : lo; int hi = s + w / 2 - 1; hi = hi > SEQ - 1 ? SEQ - 1 : hi;
        const bf16* base = H + (size_t)(t - s) * 1024 + c8;
        float acc[8], u[8], v[8];
#pragma unroll
        for (int i = 0; i < 8; ++i) acc[i] = 0.f;
        for (int p = lo; p <= hi; ++p) { unpack8(*(const v4u*)(base + (size_t)p * 1024), v);
#pragma unroll
            for (int i = 0; i < 8; ++i) acc[i] += v[i]; }
        unpack8(*(const v4u*)(base + (size_t)s * 1024), u);
        const float inv = 1.f / (float)(hi - lo + 1);
        float o[8];
#pragma unroll
        for (int i = 0; i < 8; ++i) o[i] = acc[i] * inv - u[i];
        *(v4u*)(OUT + (size_t)t * ldo + c8) = pack8(o);
    }
}

template <bool ROUTER, bool COMBINE>
__device__ __forceinline__ void ln_phase(const Frame& F, float* XR, bf16* XB, const float* g, const float* b, const float* router, int* E01, float* W01, const int* DEST, const bf16* YB, int* cntWG) {
    LAS int* cntL = (LAS int*)F.lds;
    if (ROUTER) { if (F.tid < 8) cntL[F.tid] = 0; __syncthreads(); }
    f32x4 gv[4], bv[4];
#pragma unroll
    for (int j = 0; j < 4; ++j) { gv[j] = ((const f32x4*)g)[F.lane + 64 * j]; bv[j] = ((const f32x4*)b)[F.lane + 64 * j]; }
    for (int i = 0; i < 16; ++i) {
        const int t = blockIdx.x * 128 + F.wave * 16 + i;
        f32x4* xr = (f32x4*)(XR + (size_t)t * D) + F.lane;
        f32x4 v[4]; float s = 0.f;
#pragma unroll
        for (int j = 0; j < 4; ++j) v[j] = xr[64 * j];
        if (COMBINE) {
            const int d0 = ld_i32_agent(DEST + 2 * t), d1 = ld_i32_agent(DEST + 2 * t + 1);
            const float w0 = ld_f32_agent(W01 + 2 * t), w1 = ld_f32_agent(W01 + 2 * t + 1);
            const v2u* y0 = (const v2u*)(YB + (size_t)d0 * D) + F.lane; const v2u* y1 = (const v2u*)(YB + (size_t)d1 * D) + F.lane;
#pragma unroll
            for (int j = 0; j < 4; ++j) { const v2u a = y0[64 * j], c = y1[64 * j];
                v[j].x = ALPHA * v[j].x + w0 * bflo(a.x) + w1 * bflo(c.x); v[j].y = ALPHA * v[j].y + w0 * bfhi(a.x) + w1 * bfhi(c.x);
                v[j].z = ALPHA * v[j].z + w0 * bflo(a.y) + w1 * bflo(c.y); v[j].w = ALPHA * v[j].w + w0 * bfhi(a.y) + w1 * bfhi(c.y); }
        }
#pragma unroll
        for (int j = 0; j < 4; ++j) s += (v[j].x + v[j].y) + (v[j].z + v[j].w);
        const float mean = wave_sum(s) * (1.f / D); float s2 = 0.f;
#pragma unroll
        for (int j = 0; j < 4; ++j) { v[j] = v[j] - mean; s2 += (v[j].x * v[j].x + v[j].y * v[j].y) + (v[j].z * v[j].z + v[j].w * v[j].w); }
        const float rstd = 1.f / sqrtf(wave_sum(s2) * (1.f / D) + LN_EPS);
        v2u* o8 = (v2u*)(XB + (size_t)t * D) + F.lane;
#pragma unroll
        for (int j = 0; j < 4; ++j) { v[j] = v[j] * rstd * gv[j] + bv[j]; xr[64 * j] = v[j]; v2u o; o.x = pk2(v[j].x, v[j].y); o.y = pk2(v[j].z, v[j].w); o8[64 * j] = o; }
        if (ROUTER) {
            float lg[8];
#pragma unroll
            for (int e = 0; e < 8; ++e) lg[e] = 0.f;
#pragma unroll
            for (int j = 0; j < 4; ++j)
#pragma unroll
                for (int q = 0; q < 4; ++q) { const int c = 4 * F.lane + 256 * j + q; const f32x4 r0 = ((const f32x4*)router)[2 * c], r1 = ((const f32x4*)router)[2 * c + 1]; const float xv = v[j][q];
                    lg[0] += xv * r0.x; lg[1] += xv * r0.y; lg[2] += xv * r0.z; lg[3] += xv * r0.w; lg[4] += xv * r1.x; lg[5] += xv * r1.y; lg[6] += xv * r1.z; lg[7] += xv * r1.w; }
#pragma unroll
            for (int e = 0; e < 8; ++e) lg[e] = wave_sum(lg[e]);
            float b0 = lg[0]; int i0 = 0;
#pragma unroll
            for (int e = 1; e < 8; ++e) if (lg[e] > b0) { b0 = lg[e]; i0 = e; }
            float b1 = -3.0e38f; int i1 = 0;
#pragma unroll
            for (int e = 0; e < 8; ++e) if (e != i0 && lg[e] > b1) { b1 = lg[e]; i1 = e; }
            const float w0 = 1.f / (1.f + __expf(b1 - b0));
            if (F.lane == 0) { E01[2 * t] = i0; E01[2 * t + 1] = i1; W01[2 * t] = w0; W01[2 * t + 1] = 1.f - w0; __hip_atomic_fetch_add(&cntL[i0], 1, __ATOMIC_RELAXED, __HIP_MEMORY_SCOPE_WORKGROUP); __hip_atomic_fetch_add(&cntL[i1], 1, __ATOMIC_RELAXED, __HIP_MEMORY_SCOPE_WORKGROUP); }
        }
    }
    if (ROUTER) { __syncthreads(); if (F.tid < 8) cntWG[blockIdx.x * 8 + F.tid] = cntL[F.tid]; }
}
__device__ __forceinline__ void scatter_phase(const Frame& F, const int* cntWG, const int* E01, int* DEST, const bf16* XB, bf16* XS, int* tile_e, int* nMp) {
    LAS int* L = (LAS int*)F.lds;
    if (F.tid < 8) { int tot = 0, base = 0; for (int w = 0; w < GRID; ++w) { const int c = ld_i32_agent(cntWG + w * 8 + F.tid); if (w < (int)blockIdx.x) base += c; tot += c; } L[F.tid] = base; L[8 + F.tid] = tot; }
    __syncthreads();
    if (F.tid == 0) { int ps = 0; for (int e = 0; e < 8; ++e) { L[16 + e] = ps; ps += (L[8 + e] + 255) / 256 * 256; } L[24] = ps; }
    __syncthreads();
    if (F.wave == 0) {
        const int tA = blockIdx.x * 128 + F.lane, tB = tA + 64;
        const int eA0 = ld_i32_agent(E01 + 2 * tA), eA1 = ld_i32_agent(E01 + 2 * tA + 1), eB0 = ld_i32_agent(E01 + 2 * tB), eB1 = ld_i32_agent(E01 + 2 * tB + 1);
        const unsigned long long lt = (1ull << F.lane) - 1ull;
        int dA0 = 0, dA1 = 0, dB0 = 0, dB1 = 0;
        for (int e = 0; e < 8; ++e) {
            const unsigned long long mA0 = __ballot(eA0 == e), mA1 = __ballot(eA1 == e), mB0 = __ballot(eB0 == e), mB1 = __ballot(eB1 == e);
            const int start = L[16 + e] + L[e];
            const int cA = __popcll(mA0 & lt) + __popcll(mA1 & lt), totA = __popcll(mA0) + __popcll(mA1), cB = totA + __popcll(mB0 & lt) + __popcll(mB1 & lt);
            if (eA0 == e) dA0 = start + cA; if (eA1 == e) dA1 = start + cA;
            if (eB0 == e) dB0 = start + cB; if (eB1 == e) dB1 = start + cB;
        }
        DEST[2 * tA] = dA0; DEST[2 * tA + 1] = dA1; DEST[2 * tB] = dB0; DEST[2 * tB + 1] = dB1;
        L[32 + 2 * F.lane] = dA0; L[32 + 2 * F.lane + 1] = dA1; L[32 + 2 * (F.lane + 64)] = dB0; L[32 + 2 * (F.lane + 64) + 1] = dB1;
    }
    __syncthreads();
    for (int i = 0; i < 16; ++i) {
        const int tl = F.wave * 16 + i, t = blockIdx.x * 128 + tl;
        const v4u* src = (const v4u*)(XB + (size_t)t * D) + F.lane; const v4u a = src[0], b = src[64];
#pragma unroll
        for (int k = 0; k < 2; ++k) { v4u* dst = (v4u*)(XS + (size_t)L[32 + 2 * tl + k] * D) + F.lane; dst[0] = a; dst[64] = b; }
    }
    if (blockIdx.x == 0) {
        const int nM = L[24] / 256;
        for (int i = F.tid; i < nM; i += NTHREADS) { int e = 0;
#pragma unroll
            for (int q = 1; q < 8; ++q) if (i * 256 >= L[16 + q]) e = q;
            tile_e[i] = e; }
        if (F.tid == 0) *nMp = nM;
    }
    __syncthreads();
}

__device__ __forceinline__ void memattn_naive(const Frame& F, const bf16* H, int ldh, int qoff, const bf16* MEMKV, bf16* CAT, int ldc, int coff) {
    const size_t gt = (size_t)blockIdx.x * NTHREADS + F.tid, NT = (size_t)GRID * NTHREADS;
    for (size_t it = gt; it < (size_t)T * 4; it += NT) {
        const int t = (int)(it >> 2), h = (int)(it & 3), bb = t / SEQ;
        float q[64], o[64];
#pragma unroll
        for (int c = 0; c < 8; ++c) { float f[8]; unpack8(*(const v4u*)(H + (size_t)t * ldh + qoff + 64 * h + 8 * c), f);
#pragma unroll
            for (int i = 0; i < 8; ++i) { q[8 * c + i] = f[i] * 0.125f; o[8 * c + i] = 0.f; } }
        float m = -3.0e38f, l = 0.f;
        for (int k = 0; k < ML; ++k) {
            const bf16* kr = MEMKV + (size_t)(bb * ML + k) * 512 + 64 * h;
            float sc = 0.f;
#pragma unroll
            for (int c = 0; c < 8; ++c) { float f[8]; unpack8(*(const v4u*)(kr + 8 * c), f);
#pragma unroll
                for (int i = 0; i < 8; ++i) sc += q[8 * c + i] * f[i]; }
            const float mn = fmaxf(m, sc), al = __expf(m - mn), p = __expf(sc - mn);
            l = l * al + p; m = mn;
#pragma unroll
            for (int c = 0; c < 8; ++c) { float f[8]; unpack8(*(const v4u*)(kr + 256 + 8 * c), f);
#pragma unroll
                for (int i = 0; i < 8; ++i) o[8 * c + i] = o[8 * c + i] * al + p * f[i]; }
        }
        const float inv = 1.f / l;
#pragma unroll
        for (int c = 0; c < 8; ++c) { float f[8];
#pragma unroll
            for (int i = 0; i < 8; ++i) f[i] = o[8 * c + i] * inv;
            *(v4u*)(CAT + (size_t)t * ldc + coff + 64 * h + 8 * c) = pack8(f); }
    }
}
__device__ __forceinline__ void dilattn_naive(const Frame& F, const bf16* H, bf16* CAT, int ldc) {
    const size_t gt = (size_t)blockIdx.x * NTHREADS + F.tid, NT = (size_t)GRID * NTHREADS;
    for (size_t it = gt; it < (size_t)T * 4; it += NT) {
        const int t = (int)(it >> 2), h = (int)(it & 3), s = t & (SEQ - 1);
        float q[64], o[64];
#pragma unroll
        for (int i = 0; i < 64; ++i) o[i] = 0.f;
        float m = -3.0e38f, l = 0.f;
        for (int g = 0; g < 3; ++g) {
            const int dl = 1 << (2 * g), nsub = SEQ / dl, j = s / dl, r = s % dl;
            const float slope = exp2f(-8.f * (float)(4 * g + h + 1) / 12.f) * (float)dl;
#pragma unroll
            for (int c = 0; c < 8; ++c) { float f[8]; unpack8(*(const v4u*)(H + (size_t)t * 2560 + 256 * g + 64 * h + 8 * c), f);
#pragma unroll
                for (int i = 0; i < 8; ++i) q[8 * c + i] = f[i] * 0.125f; }
            const int jlo = j - 64 < 0 ? 0 : j - 64, jhi = j + 64 > nsub - 1 ? nsub - 1 : j + 64;
            for (int jj = jlo; jj <= jhi; ++jj) {
                const bf16* kr = H + (size_t)(t - s + jj * dl + r) * 2560 + 768 + 256 * g + 64 * h;
                float sc = 0.f;
#pragma unroll
                for (int c = 0; c < 8; ++c) { float f[8]; unpack8(*(const v4u*)(kr + 8 * c), f);
#pragma unroll
                    for (int i = 0; i < 8; ++i) sc += q[8 * c + i] * f[i]; }
                const int ad = jj > j ? jj - j : j - jj;
                sc -= slope * (float)ad;
                const float mn = fmaxf(m, sc), al = __expf(m - mn), p = __expf(sc - mn);
                l = l * al + p; m = mn;
#pragma unroll
                for (int c = 0; c < 8; ++c) { float f[8]; unpack8(*(const v4u*)(kr + 768 + 8 * c), f);
#pragma unroll
                    for (int i = 0; i < 8; ++i) o[8 * c + i] = o[8 * c + i] * al + p * f[i]; }
            }
        }
        const float inv = 1.f / l;
#pragma unroll
        for (int c = 0; c < 8; ++c) { float f[8];
#pragma unroll
            for (int i = 0; i < 8; ++i) f[i] = o[8 * c + i] * inv;
            *(v4u*)(CAT + (size_t)t * ldc + 64 * h + 8 * c) = pack8(f); }
    }
}

constexpr int NPHASE = 34;
__global__ void __launch_bounds__(NTHREADS, 2) mega(Args args) {
    extern __shared__ __attribute__((aligned(16))) unsigned char lds[];
    Frame F; F.lds = (LAS unsigned char*)lds; F.tid = threadIdx.x; F.lane = F.tid & 63; F.wave = __builtin_amdgcn_readfirstlane(F.tid >> 6); F.gw = blockIdx.x * NWAVES + F.wave;
    volatile LAS unsigned* MISC = (volatile LAS unsigned*)(F.lds + MISC_OFF);
    unsigned char* ws = args.ws;
    unsigned* ctl = (unsigned*)(ws + WS_CTL);
    for (int u = F.tid; u < (LDS_BYTES - LDSCTL_OFF) / 4; u += NTHREADS) ((LAS unsigned*)(F.lds + LDSCTL_OFF))[u] = 0u;
    __syncthreads();
    const int lo = args.lo, hi = args.hi;
    XcdBarrier bar; bar.bar = ctl + CW_BAR; bar.x = 0; bar.st = nullptr;
    if (hi - lo > 1) bar = xcd_barrier_post(ctl + CW_BAR, MISC + 8);
#define IN(k) (lo <= (k) && (k) < hi)
#define SEAM(k) do { if (IN(k) && IN((k) + 1)) xcd_barrier(bar); else __syncthreads(); } while (0)
    const float* x_in = args.in[I_X]; float* XR = args.out;
    int* cntWG = (int*)(ws + WS_META); int* tile_e = (int*)(ws + WS_META + 16384); int* nMp = (int*)(ws + WS_META + 32768);
    int* E01 = (int*)(ws + WS_TOK); float* W01 = (float*)(ws + WS_TOK + 262144); int* DEST = (int*)(ws + WS_TOK + 524288);
    bf16* XB = (bf16*)(ws + WS_XB); bf16* MEMB = (bf16*)(ws + WS_MEMB); bf16* MEMKV = (bf16*)(ws + WS_MEMKV);
    bf16* Hb = (bf16*)(ws + WS_SCR + SC_H); bf16* CAT = (bf16*)(ws + WS_SCR + SC_CAT); bf16* DIFF = (bf16*)(ws + WS_SCR + SC_DIFF);
    bf16* HID = (bf16*)(ws + WS_SCR + SC_HID); bf16* XS = (bf16*)(ws + WS_SCR + SC_XS); bf16* HS = (bf16*)(ws + WS_SCR + SC_HS); bf16* YB = XS;
    const float* ln_g = args.in[I_LNG]; const float* ln_b = args.in[I_LNB];

    if (IN(0)) { prep_phase(F, x_in, args.in[I_MEM], XB, MEMB); SEAM(0); }
    if (IN(1)) { naive_gemm<1>(F, MEMB, D, args.in[I_WMEMKV], nullptr, 512, NB * ML, 512, D, NEpiBf16{MEMKV, 512}, nullptr, 0); SEAM(1); }

    if (IN(2)) { naive_gemm<1>(F, XB, D, args.in[I_AWIN], nullptr, 2560, T, 2560, D, NEpiBf16{Hb, 2560}, nullptr, 0); SEAM(2); }
    if (IN(3)) { mixA_phase(F, Hb, args.in[I_ACONV], CAT); memattn_naive(F, Hb, 2560, 2304, MEMKV, CAT, 1024, 768); SEAM(3); }
    if (IN(4)) { naive_gemm<1>(F, CAT, 1024, args.in[I_AWOUT], nullptr, D, T, D, 1024, NEpiResid{x_in, XR}, nullptr, 0); SEAM(4); }
    if (IN(5)) { ln_phase<false, false>(F, XR, XB, ln_g + 0 * D, ln_b + 0 * D, nullptr, nullptr, nullptr, nullptr, nullptr, nullptr); SEAM(5); }
    if (IN(6)) { naive_gemm<2>(F, XB, D, args.in[I_FG], args.in[I_FU], FF, T, FF, D, NEpiSwiglu{HID, FF}, nullptr, 0); SEAM(6); }
    if (IN(7)) { naive_gemm<1>(F, HID, FF, args.in[I_FD], nullptr, D, T, D, FF, NEpiResid{XR, XR}, nullptr, 0); SEAM(7); }
    if (IN(8)) { ln_phase<false, false>(F, XR, XB, ln_g + 1 * D, ln_b + 1 * D, nullptr, nullptr, nullptr, nullptr, nullptr, nullptr); SEAM(8); }

    if (IN(9)) { naive_gemm<1>(F, XB, D, args.in[I_BWIN], nullptr, 2560, T, 2560, D, NEpiBf16{Hb, 2560}, nullptr, 0); SEAM(9); }
    if (IN(10)) { dilattn_naive(F, Hb, CAT, 512); memattn_naive(F, Hb, 2560, 2304, MEMKV, CAT, 512, 256); SEAM(10); }
    if (IN(11)) { SEAM(11); }
    if (IN(12)) { naive_gemm<1>(F, CAT, 512, args.in[I_BWOUT], nullptr, D, T, D, 512, NEpiResid{XR, XR}, nullptr, 0); SEAM(12); }
    if (IN(13)) { ln_phase<true, false>(F, XR, XB, ln_g + 2 * D, ln_b + 2 * D, args.in[I_ROUTER], E01, W01, nullptr, nullptr, cntWG); SEAM(13); }
    if (IN(14)) { scatter_phase(F, cntWG, E01, DEST, XB, XS, tile_e, nMp); SEAM(14); }
    if (IN(15)) { const int nM = ld_i32_agent(nMp); naive_gemm<2>(F, XS, D, args.in[I_MG], args.in[I_MU], FFE, nM * 256, FFE, D, NEpiSwiglu{HS, FFE}, tile_e, (size_t)D * FFE); SEAM(15); }
    if (IN(16)) { const int nM = ld_i32_agent(nMp); naive_gemm<1>(F, HS, FFE, args.in[I_MD], nullptr, D, nM * 256, D, FFE, NEpiBf16{YB, D}, tile_e, (size_t)FFE * D); SEAM(16); }
    if (IN(17)) { ln_phase<false, true>(F, XR, XB, ln_g + 3 * D, ln_b + 3 * D, nullptr, nullptr, W01, DEST, YB, nullptr); SEAM(17); }

    if (IN(18)) { naive_gemm<1>(F, XB, D, args.in[I_CWIN], nullptr, 1024, T, 1024, D, NEpiBf16{Hb, 1024}, nullptr, 0); SEAM(18); }
    if (IN(19)) { poolC_phase(F, Hb, DIFF, 768); memattn_naive(F, Hb, 1024, 768, MEMKV, CAT, 1024, 768); SEAM(19); }
    if (IN(20)) {
#pragma unroll 1
        for (int g = 0; g < 4; ++g) naive_gemm<1>(F, DIFF + 192 * g, 768, args.in[I_CPOOLW] + (size_t)g * 192 * 192, nullptr, 192, T, 192, 192, NEpiScale{CAT, 1024, 192 * g, args.in[I_CPOOLS]}, nullptr, 0);
        SEAM(20); }
    if (IN(21)) { naive_gemm<1>(F, CAT, 1024, args.in[I_CWOUT], nullptr, D, T, D, 1024, NEpiResid{XR, XR}, nullptr, 0); SEAM(21); }
    if (IN(22)) { ln_phase<false, false>(F, XR, XB, ln_g + 4 * D, ln_b + 4 * D, nullptr, nullptr, nullptr, nullptr, nullptr, nullptr); SEAM(22); }
    if (IN(23)) { naive_gemm<2>(F, XB, D, args.in[I_FG] + (size_t)D * FF, args.in[I_FU] + (size_t)D * FF, FF, T, FF, D, NEpiSwiglu{HID, FF}, nullptr, 0); SEAM(23); }
    if (IN(24)) { naive_gemm<1>(F, HID, FF, args.in[I_FD] + (size_t)FF * D, nullptr, D, T, D, FF, NEpiResid{XR, XR}, nullptr, 0); SEAM(24); }
    if (IN(25)) { ln_phase<false, false>(F, XR, XB, ln_g + 5 * D, ln_b + 5 * D, nullptr, nullptr, nullptr, nullptr, nullptr, nullptr); SEAM(25); }

    if (IN(26)) { naive_gemm<1>(F, XB, D, args.in[I_AWIN] + (size_t)D * 2560, nullptr, 2560, T, 2560, D, NEpiBf16{Hb, 2560}, nullptr, 0); SEAM(26); }
    if (IN(27)) { mixA_phase(F, Hb, args.in[I_ACONV] + 3 * 768, CAT); memattn_naive(F, Hb, 2560, 2304, MEMKV, CAT, 1024, 768); SEAM(27); }
    if (IN(28)) { naive_gemm<1>(F, CAT, 1024, args.in[I_AWOUT] + (size_t)D * D, nullptr, D, T, D, 1024, NEpiResid{XR, XR}, nullptr, 0); SEAM(28); }
    if (IN(29)) { ln_phase<true, false>(F, XR, XB, ln_g + 6 * D, ln_b + 6 * D, args.in[I_ROUTER] + D * NE, E01, W01, nullptr, nullptr, cntWG); SEAM(29); }
    if (IN(30)) { scatter_phase(F, cntWG, E01, DEST, XB, XS, tile_e, nMp); SEAM(30); }
    if (IN(31)) { const int nM = ld_i32_agent(nMp); naive_gemm<2>(F, XS, D, args.in[I_MG] + (size_t)NE * D * FFE, args.in[I_MU] + (size_t)NE * D * FFE, FFE, nM * 256, FFE, D, NEpiSwiglu{HS, FFE}, tile_e, (size_t)D * FFE); SEAM(31); }
    if (IN(32)) { const int nM = ld_i32_agent(nMp); naive_gemm<1>(F, HS, FFE, args.in[I_MD] + (size_t)NE * FFE * D, nullptr, D, nM * 256, D, FFE, NEpiBf16{YB, D}, tile_e, (size_t)FFE * D); SEAM(32); }
    if (IN(33)) { ln_phase<false, true>(F, XR, XB, ln_g + 7 * D, ln_b + 7 * D, nullptr, nullptr, W01, DEST, YB, nullptr); }
#undef IN
#undef SEAM
}

extern "C" void kernel_launch(void* const* d_in, const int* in_sizes, int n_in, void* d_out, int out_size, void* d_ws, size_t ws_size, hipStream_t stream) {
    static int ok = 0;
    if (ok == 0) {
        ok = 1;
        if (n_in != 21 || out_size != T * D || ws_size < WS_END) { fprintf(stderr, "kernel_launch: unexpected shapes (n_in %d, out %d, ws %zu < %zu)\n", n_in, out_size, ws_size, (size_t)WS_END); ok = -1; }
        if (ok > 0 && hipFuncSetAttribute((const void*)mega, hipFuncAttributeMaxDynamicSharedMemorySize, LDS_BYTES) != hipSuccess) { fprintf(stderr, "kernel_launch: hipFuncSetAttribute failed\n"); ok = -1; }
        int dev = 0, cus = 0; (void)hipGetDevice(&dev); (void)hipDeviceGetAttribute(&cus, hipDeviceAttributeMultiprocessorCount, dev);
        if (cus < GRID) { fprintf(stderr, "kernel_launch: %d CUs < %d\n", cus, GRID); ok = -1; }
        (void)hipGetLastError();
    }
    if (ok < 0) return;
    (void)hipMemsetAsync((char*)d_ws + WS_CTL, 0, CTL_ZERO_BYTES, stream);
    Args a{};
    for (int i = 0; i < 21; ++i) a.in[i] = (const float*)d_in[i];
    a.out = (float*)d_out; a.ws = (unsigned char*)d_ws;
#if MK_ONE_LAUNCH
    a.lo = 0; a.hi = NPHASE;
    hipLaunchKernelGGL(mega, dim3(GRID), dim3(NTHREADS), LDS_BYTES, stream, a);
#else
    for (int p = 0; p < NPHASE; ++p) { if (p == 11) continue; a.lo = p; a.hi = p + 1; hipLaunchKernelGGL(mega, dim3(GRID), dim3(NTHREADS), LDS_BYTES, stream, a); }
#endif
}
```

```cpp
#include <hip/hip_runtime.h>
#include <cstdio>
#include <cstdint>

#ifndef MK_ONE_LAUNCH
#define MK_ONE_LAUNCH 1
#endif
#ifndef FAST_GEMM
#define FAST_GEMM 0
#endif
#ifndef FAST_ATTN
#define FAST_ATTN 0
#endif

#define GAS __attribute__((address_space(1)))
#define LAS __attribute__((address_space(3)))
typedef unsigned short bf16;
typedef unsigned v4u __attribute__((ext_vector_type(4)));
typedef unsigned v2u __attribute__((ext_vector_type(2)));
typedef float f32x4 __attribute__((ext_vector_type(4)));
typedef float f32x2 __attribute__((ext_vector_type(2)));
typedef float f32x16 __attribute__((ext_vector_type(16)));
typedef short bf16x8 __attribute__((ext_vector_type(8)));
typedef short s16x4 __attribute__((ext_vector_type(4)));
#define RLX_AGENT __ATOMIC_RELAXED, __HIP_MEMORY_SCOPE_AGENT
#define LDS_WAIT() asm volatile("s_waitcnt lgkmcnt(0)" ::: "memory")
#define VM_WAIT() asm volatile("s_waitcnt vmcnt(0)" ::: "memory")

constexpr int NB = 16, SEQ = 2048, T = NB * SEQ, D = 1024, ML = 256, MEMW = 256, MIXW = 768, HD = 64;
constexpr int FF = 2816, FFE = 3584, NE = 8;
constexpr int RMAX = (2 * T / 256 + NE) * 256;
constexpr float ALPHA = 1.6817928305074290f;
constexpr float LN_EPS = 1e-5f;
constexpr int NWAVES = 8, NTHREADS = 512, GRID = 256, NGW = GRID * NWAVES;

constexpr size_t MiB = 1u << 20;
constexpr size_t WS_CTL = 0, CTL_ZERO_BYTES = 1 * MiB;
constexpr size_t WS_META = 1 * MiB;
constexpr size_t WS_TOK = 2 * MiB;
constexpr size_t WS_WS = 4 * MiB;
constexpr size_t WS_WMOE = 64 * MiB;
constexpr size_t WS_XB = 232 * MiB;
constexpr size_t WS_MEMB = 296 * MiB;
constexpr size_t WS_MEMKV = 304 * MiB;
constexpr size_t WS_SCR = 308 * MiB;
constexpr size_t SC_H = 0, SC_CAT = 160 * MiB, SC_OG = 224 * MiB, SC_LSE = 320 * MiB, SC_DIFF = 224 * MiB;
constexpr size_t SC_HID = 0;
constexpr size_t SC_XS = 0, SC_HS = 132 * MiB;
constexpr size_t WS_END = WS_SCR + SC_HS + (size_t)RMAX * FFE * 2;
static_assert(WS_END <= 903 * MiB, "ws map");
constexpr size_t OFF_WKV = 0, OFF_AIN = 524288, OFF_AOUT = 5767168, OFF_BIN = 7864320, OFF_BOUT = 10485760, OFF_CIN = 11010048,
                 OFF_COUT = 12058624, OFF_FGU = 13107200, OFF_FD = 24641536, OFF_WS_END = 30408704;
static_assert(OFF_WS_END * 2 <= 60 * MiB, "small weights");
constexpr size_t OFF_MGU = 0, OFF_MD = (size_t)NE * 2 * FFE * D;
constexpr int CW_BAR = 4096;

constexpr int RING_BYTES = 131072, LDSCTL_OFF = RING_BYTES, MISC_OFF = LDSCTL_OFF + 320, LDS_BYTES = 147456;

__device__ __forceinline__ unsigned f2bf(float f) { unsigned u = __builtin_bit_cast(unsigned, f); return (u + 0x7fffu + ((u >> 16) & 1u)) >> 16; }
__device__ __forceinline__ unsigned pk2(float lo, float hi) { return f2bf(lo) | (f2bf(hi) << 16); }
__device__ __forceinline__ float bf2f(unsigned b) { return __builtin_bit_cast(float, b << 16); }
__device__ __forceinline__ float bflo(unsigned w) { return __builtin_bit_cast(float, w << 16); }
__device__ __forceinline__ float bfhi(unsigned w) { return __builtin_bit_cast(float, w & 0xffff0000u); }
__device__ __forceinline__ float wave_sum(float v) {
#pragma unroll
    for (int o = 1; o < 64; o <<= 1) v += __shfl_xor(v, o);
    return v;
}
__device__ __forceinline__ int ld_i32_agent(const int* p) { return (int)__hip_atomic_load((const unsigned*)p, RLX_AGENT); }
__device__ __forceinline__ float ld_f32_agent(const float* p) { return __builtin_bit_cast(float, __hip_atomic_load((const unsigned*)p, RLX_AGENT)); }

#define XB_TMO      128
#define XB_XCNT(j)  (256  + 64 * (j))
#define XB_XSUB(j)  (1280 + 64 * (j))
#define XB_XGEN(j)  (2304 + 64 * (j))
#define XB_TOP      3328
#define XB_TOPGEN   3392
#define XCD_BAR_WORDS 3456
#define XB_SPIN_CAP (1u << 18)
__device__ __forceinline__ unsigned xb_ld(unsigned* p)              { return __hip_atomic_load(p, __ATOMIC_RELAXED, __HIP_MEMORY_SCOPE_AGENT); }
__device__ __forceinline__ unsigned xb_add(unsigned* p, unsigned v) { return __hip_atomic_fetch_add(p, v, __ATOMIC_RELAXED, __HIP_MEMORY_SCOPE_AGENT); }
__device__ __forceinline__ unsigned xb_xcc_id() { return (unsigned)__builtin_amdgcn_s_getreg((3 << 11) | 20) & 0xFu; }
#define XB_SPIN(cond, bar) do { unsigned _sp = 0; while (cond) { __builtin_amdgcn_s_sleep(1); \
    if ((++_sp & 255u) == 0u) { if (xb_ld(&(bar)[XB_TMO])) break; if (_sp > XB_SPIN_CAP) { atomicAdd(&(bar)[XB_TMO], 1u); break; } } } } while (0)
struct XcdBarrier { unsigned* bar; unsigned x; volatile LAS unsigned* st; };
__device__ __forceinline__ XcdBarrier xcd_barrier_post(unsigned* bar, volatile LAS unsigned* st) {
    XcdBarrier b; b.bar = bar; b.x = xb_xcc_id(); b.st = st;
    if (threadIdx.x == 0) (void)xb_add(&bar[XB_XCNT(b.x)], 1u);
    return b;
}
__device__ __forceinline__ void xcd_barrier_complete(unsigned* bar, unsigned x, unsigned& nloc, unsigned& nx) {
    const unsigned G = gridDim.x * gridDim.y * gridDim.z;
    unsigned sum, cnt, mine, sp = 0u;
    for (;;) {
        sum = 0u; cnt = 0u; mine = 0u;
#pragma unroll
        for (unsigned j = 0; j < 16; ++j) { const unsigned c = xb_ld(&bar[XB_XCNT(j)]); sum += c; cnt += (c > 0u) ? 1u : 0u; mine = (j == x) ? c : mine; }
        if (sum == G) break;
        __builtin_amdgcn_s_sleep(1);
        if ((++sp & 255u) == 0u) { if (xb_ld(&bar[XB_TMO])) break; if (sp > XB_SPIN_CAP) { atomicAdd(&bar[XB_TMO], 1u); break; } }
    }
    nloc = mine > 0u ? mine : 1u; nx = cnt > 0u ? cnt : 1u;
}
__device__ __forceinline__ void xcd_barrier(const XcdBarrier& b) {
    asm volatile("s_waitcnt vmcnt(0)" ::: "memory");
    __syncthreads();
    if (threadIdx.x == 0) {
        unsigned* bar = b.bar;
        __builtin_amdgcn_s_waitcnt(0);
        unsigned nloc = b.st[0], nx = b.st[1];
        if (nloc == 0u) { xcd_barrier_complete(bar, b.x, nloc, nx); b.st[0] = nloc; b.st[1] = nx; }
        const unsigned old = xb_add(&bar[XB_XSUB(b.x)], 1u);
        const unsigned gen = old / nloc;
        if (old + 1u == (gen + 1u) * nloc) {
            __builtin_amdgcn_fence(__ATOMIC_RELEASE, "agent");
            asm volatile("s_waitcnt vmcnt(0)" ::: "memory");
            const unsigned og = xb_add(&bar[XB_TOP], 1u);
            const unsigned tg = og / nx;
            if (og + 1u == (tg + 1u) * nx) xb_add(&bar[XB_TOPGEN], 1u);
            else XB_SPIN(xb_ld(&bar[XB_TOPGEN]) == tg, bar);
            __builtin_amdgcn_fence(__ATOMIC_ACQUIRE, "agent");
            xb_add(&bar[XB_XGEN(b.x)], 1u);
            asm volatile("s_waitcnt vmcnt(0)" ::: "memory");
        } else {
            XB_SPIN(xb_ld(&bar[XB_XGEN(b.x)]) == gen, bar);
            __builtin_amdgcn_fence(__ATOMIC_ACQUIRE, "agent");
            asm volatile("s_waitcnt vmcnt(0)" ::: "memory");
        }
    }
    __syncthreads();
}

struct Args { const float* in[21]; float* out; unsigned char* ws; int lo, hi; };
enum { I_X = 0, I_MEM, I_WMEMKV, I_AWIN, I_ACONV, I_AWOUT, I_BWIN, I_BWOUT, I_CWIN, I_CPOOLW, I_CPOOLS, I_CWOUT, I_LNG, I_LNB,
       I_FG, I_FU, I_FD, I_ROUTER, I_MG, I_MU, I_MD };
struct Frame { LAS unsigned char* lds; int tid, lane, wave, gw; };

template <int NWM, class Epi>
__device__ __forceinline__ void naive_gemm(const Frame& F, const bf16* A, int lda, const float* W0, const float* W1, int ldw, int M, int N, int K, const Epi& epi, const int* tile_e, size_t wstride) {
    const int lane = F.lane, r16 = lane & 15, q4 = lane >> 4;
    const int tn = N / 32, ntiles = (M / 32) * tn;
    for (int tile = F.gw; tile < ntiles; tile += NGW) {
        const int m0 = (tile / tn) * 32, n0 = (tile % tn) * 32;
        size_t woff = 0;
        if (tile_e) woff = (size_t)ld_i32_agent(tile_e + (m0 >> 8)) * wstride;
        const float* w0 = W0 + woff; const float* w1 = (NWM == 2) ? W1 + woff : nullptr;
        f32x4 acc[NWM][2][2];
#pragma unroll
        for (int w = 0; w < NWM; ++w)
#pragma unroll
            for (int i = 0; i < 2; ++i)
#pragma unroll
                for (int j = 0; j < 2; ++j) acc[w][i][j] = (f32x4){0.f, 0.f, 0.f, 0.f};
        for (int k0 = 0; k0 < K; k0 += 32) {
            bf16x8 a[2], b[NWM][2];
#pragma unroll
            for (int i = 0; i < 2; ++i) a[i] = *(const bf16x8*)(A + (size_t)(m0 + 16 * i + r16) * lda + k0 + 8 * q4);
#pragma unroll
            for (int w = 0; w < NWM; ++w)
#pragma unroll
                for (int jn = 0; jn < 2; ++jn) {
                    const float* wp = (w == 0 ? w0 : w1) + (size_t)(k0 + 8 * q4) * ldw + n0 + 16 * jn + r16;
#pragma unroll
                    for (int j = 0; j < 8; ++j) b[w][jn][j] = (short)f2bf(wp[(size_t)j * ldw]);
                }
#pragma unroll
            for (int w = 0; w < NWM; ++w)
#pragma unroll
                for (int i = 0; i < 2; ++i)
#pragma unroll
                    for (int jn = 0; jn < 2; ++jn) acc[w][i][jn] = __builtin_amdgcn_mfma_f32_16x16x32_bf16(a[i], b[w][jn], acc[w][i][jn], 0, 0, 0);
        }
#pragma unroll
        for (int i = 0; i < 2; ++i)
#pragma unroll
            for (int jn = 0; jn < 2; ++jn)
#pragma unroll
                for (int r = 0; r < 4; ++r) {
                    const int row = m0 + 16 * i + q4 * 4 + r, col = n0 + 16 * jn + r16;
                    if constexpr (NWM == 2) epi(row, col, acc[0][i][jn][r], acc[1][i][jn][r]); else epi(row, col, acc[0][i][jn][r], 0.f);
                }
    }
}
struct NEpiBf16 { bf16* O; int ldo; __device__ __forceinline__ void operator()(int r, int c, float v, float) const { O[(size_t)r * ldo + c] = (bf16)f2bf(v); } };
struct NEpiResid { const float* base; float* out; __device__ __forceinline__ void operator()(int r, int c, float v, float) const { const size_t o = (size_t)r * D + c; out[o] = ALPHA * base[o] + v; } };
struct NEpiSwiglu { bf16* O; int ldo; __device__ __forceinline__ void operator()(int r, int c, float g, float u) const { const float s = g / (1.f + __expf(-g)); O[(size_t)r * ldo + c] = (bf16)f2bf(s * u); } };
struct NEpiScale { bf16* O; int ldo; int coff; const float* scale; __device__ __forceinline__ void operator()(int r, int c, float v, float) const { O[(size_t)r * ldo + coff + c] = (bf16)f2bf(v * scale[coff + c]); } };

__device__ __forceinline__ void prep_phase(const Frame& F, const float* x, const float* mem, bf16* XB, bf16* MEMB) {
    const size_t gt = (size_t)blockIdx.x * NTHREADS + F.tid, NT = (size_t)GRID * NTHREADS;
    for (size_t i = gt; i < (size_t)T * D / 8; i += NT) { const f32x4 a = ((const f32x4*)x)[2 * i], b = ((const f32x4*)x)[2 * i + 1];
        v4u o; o.x = pk2(a.x, a.y); o.y = pk2(a.z, a.w); o.z = pk2(b.x, b.y); o.w = pk2(b.z, b.w); ((v4u*)XB)[i] = o; }
    for (size_t i = gt; i < (size_t)NB * ML * D / 8; i += NT) { const f32x4 a = ((const f32x4*)mem)[2 * i], b = ((const f32x4*)mem)[2 * i + 1];
        v4u o; o.x = pk2(a.x, a.y); o.y = pk2(a.z, a.w); o.z = pk2(b.x, b.y); o.w = pk2(b.z, b.w); ((v4u*)MEMB)[i] = o; }
}
__device__ __forceinline__ void unpack8(const v4u w, float (&f)[8]) { f[0] = bflo(w.x); f[1] = bfhi(w.x); f[2] = bflo(w.y); f[3] = bfhi(w.y); f[4] = bflo(w.z); f[5] = bfhi(w.z); f[6] = bflo(w.w); f[7] = bfhi(w.w); }
__device__ __forceinline__ v4u pack8(const float (&f)[8]) { v4u o; o.x = pk2(f[0], f[1]); o.y = pk2(f[2], f[3]); o.z = pk2(f[4], f[5]); o.w = pk2(f[6], f[7]); return o; }

__device__ __forceinline__ void mixA_phase(const Frame& F, const bf16* H, const float* convw, bf16* CAT) {
    const size_t gt = (size_t)blockIdx.x * NTHREADS + F.tid, NT = (size_t)GRID * NTHREADS;
    for (size_t it = gt; it < (size_t)T * 96; it += NT) {
        const int t = (int)(it / 96), c8 = (int)(it % 96) * 8, s = t & (SEQ - 1);
        const bf16* hr = H + (size_t)t * 2560 + c8;
        float gb[8], z0[8], z1[8], z2[8], a[8], b[8];
        unpack8(*(const v4u*)hr, gb);
        unpack8(*(const v4u*)(hr + 768), a); unpack8(*(const v4u*)(hr + 1536), b);
#pragma unroll
        for (int i = 0; i < 8; ++i) z1[i] = a[i] * b[i];
        if (s > 0) { unpack8(*(const v4u*)(hr - 2560 + 768), a); unpack8(*(const v4u*)(hr - 2560 + 1536), b);
#pragma unroll
            for (int i = 0; i < 8; ++i) z0[i] = a[i] * b[i]; }
        else {
#pragma unroll
            for (int i = 0; i < 8; ++i) z0[i] = 0.f; }
        if (s < SEQ - 1) { unpack8(*(const v4u*)(hr + 2560 + 768), a); unpack8(*(const v4u*)(hr + 2560 + 1536), b);
#pragma unroll
            for (int i = 0; i < 8; ++i) z2[i] = a[i] * b[i]; }
        else {
#pragma unroll
            for (int i = 0; i < 8; ++i) z2[i] = 0.f; }
        float o[8];
#pragma unroll
        for (int i = 0; i < 8; ++i) o[i] = gb[i] * (convw[c8 + i] * z0[i] + convw[768 + c8 + i] * z1[i] + convw[1536 + c8 + i] * z2[i]);
        *(v4u*)(CAT + (size_t)t * 1024 + c8) = pack8(o);
    }
}
__device__ __forceinline__ void poolC_phase(const Frame& F, const bf16* H, bf16* OUT, int ldo) {
    const size_t gt = (size_t)blockIdx.x * NTHREADS + F.tid, NT = (size_t)GRID * NTHREADS;
    for (size_t it = gt; it < (size_t)T * 96; it += NT) {
        const int t = (int)(it / 96), ch = (int)(it % 96), c8 = ch * 8, s = t & (SEQ - 1), g = ch / 24, w = 2 << g;
        int lo = s - w / 2; lo = lo < 0 ? 0 : lo; int hi = s + w / 2 - 1; hi = hi > SEQ - 1 ? SEQ - 1 : hi;
        const bf16* base = H + (size_t)(t - s) * 1024 + c8;
        float acc[8], u[8], v[8];
#pragma unroll
        for (int i = 0; i < 8; ++i) acc[i] = 0.f;
        for (int p = lo; p <= hi; ++p) { unpack8(*(const v4u*)(base + (size_t)p * 1024), v);
#pragma unroll
            for (int i = 0; i < 8; ++i) acc[i] += v[i]; }
        unpack8(*(const v4u*)(base + (size_t)s * 1024), u);
        const float inv = 1.f / (float)(hi - lo + 1);
        float o[8];
#pragma unroll
        for (int i = 0; i < 8; ++i) o[i] = acc[i] * inv - u[i];
        *(v4u*)(OUT + (size_t)t * ldo + c8) = pack8(o);
    }
}

template <bool ROUTER, bool COMBINE>
__device__ __forceinline__ void ln_phase(const Frame& F, float* XR, bf16* XB, const float* g, const float* b, const float* router, int* E01, float* W01, const int* DEST, const bf16* YB, int* cntWG) {
    LAS int* cntL = (LAS int*)F.lds;
    if (ROUTER) { if (F.tid < 8) cntL[F.tid] = 0; __syncthreads(); }
    f32x4 gv[4], bv[4];
#pragma unroll
    for (int j = 0; j < 4; ++j) { gv[j] = ((const f32x4*)g)[F.lane + 64 * j]; bv[j] = ((const f32x4*)b)[F.lane + 64 * j]; }
    for (int i = 0; i < 16; ++i) {
        const int t = blockIdx.x * 128 + F.wave * 16 + i;
        f32x4* xr = (f32x4*)(XR + (size_t)t * D) + F.lane;
        f32x4 v[4]; float s = 0.f;
#pragma unroll
        for (int j = 0; j < 4; ++j) v[j] = xr[64 * j];
        if (COMBINE) {
            const int d0 = ld_i32_agent(DEST + 2 * t), d1 = ld_i32_agent(DEST + 2 * t + 1);
            const float w0 = ld_f32_agent(W01 + 2 * t), w1 = ld_f32_agent(W01 + 2 * t + 1);
            const v2u* y0 = (const v2u*)(YB + (size_t)d0 * D) + F.lane; const v2u* y1 = (const v2u*)(YB + (size_t)d1 * D) + F.lane;
#pragma unroll
            for (int j = 0; j < 4; ++j) { const v2u a = y0[64 * j], c = y1[64 * j];
                v[j].x = ALPHA * v[j].x + w0 * bflo(a.x) + w1 * bflo(c.x); v[j].y = ALPHA * v[j].y + w0 * bfhi(a.x) + w1 * bfhi(c.x);
                v[j].z = ALPHA * v[j].z + w0 * bflo(a.y) + w1 * bflo(c.y); v[j].w = ALPHA * v[j].w + w0 * bfhi(a.y) + w1 * bfhi(c.y); }
        }
#pragma unroll
        for (int j = 0; j < 4; ++j) s += (v[j].x + v[j].y) + (v[j].z + v[j].w);
        const float mean = wave_sum(s) * (1.f / D); float s2 = 0.f;
#pragma unroll
        for (int j = 0; j < 4; ++j) { v[j] = v[j] - mean; s2 += (v[j].x * v[j].x + v[j].y * v[j].y) + (v[j].z * v[j].z + v[j].w * v[j].w); }
        const float rstd = 1.f / sqrtf(wave_sum(s2) * (1.f / D) + LN_EPS);
        v2u* o8 = (v2u*)(XB + (size_t)t * D) + F.lane;
#pragma unroll
        for (int j = 0; j < 4; ++j) { v[j] = v[j] * rstd * gv[j] + bv[j]; xr[64 * j] = v[j]; v2u o; o.x = pk2(v[j].x, v[j].y); o.y = pk2(v[j].z, v[j].w); o8[64 * j] = o; }
        if (ROUTER) {
            float lg[8];
#pragma unroll
            for (int e = 0; e < 8; ++e) lg[e] = 0.f;
#pragma unroll
            for (int j = 0; j < 4; ++j)
#pragma unroll
                for (int q = 0; q < 4; ++q) { const int c = 4 * F.lane + 256 * j + q; const f32x4 r0 = ((const f32x4*)router)[2 * c], r1 = ((const f32x4*)router)[2 * c + 1]; const float xv = v[j][q];
                    lg[0] += xv * r0.x; lg[1] += xv * r0.y; lg[2] += xv * r0.z; lg[3] += xv * r0.w; lg[4] += xv * r1.x; lg[5] += xv * r1.y; lg[6] += xv * r1.z; lg[7] += xv * r1.w; }
#pragma unroll
            for (int e = 0; e < 8; ++e) lg[e] = wave_sum(lg[e]);
            float b0 = lg[0]; int i0 = 0;
#pragma unroll
            for (int e = 1; e < 8; ++e) if (lg[e] > b0) { b0 = lg[e]; i0 = e; }
            float b1 = -3.0e38f; int i1 = 0;
#pragma unroll
            for (int e = 0; e < 8; ++e) if (e != i0 && lg[e] > b1) { b1 = lg[e]; i1 = e; }
            const float w0 = 1.f / (1.f + __expf(b1 - b0));
            if (F.lane == 0) { E01[2 * t] = i0; E01[2 * t + 1] = i1; W01[2 * t] = w0; W01[2 * t + 1] = 1.f - w0; __hip_atomic_fetch_add(&cntL[i0], 1, __ATOMIC_RELAXED, __HIP_MEMORY_SCOPE_WORKGROUP); __hip_atomic_fetch_add(&cntL[i1], 1, __ATOMIC_RELAXED, __HIP_MEMORY_SCOPE_WORKGROUP); }
        }
    }
    if (ROUTER) { __syncthreads(); if (F.tid < 8) cntWG[blockIdx.x * 8 + F.tid] = cntL[F.tid]; }
}
__device__ __forceinline__ void scatter_phase(const Frame& F, const int* cntWG, const int* E01, int* DEST, const bf16* XB, bf16* XS, int* tile_e, int* nMp) {
    LAS int* L = (LAS int*)F.lds;
    if (F.tid < 8) { int tot = 0, base = 0; for (int w = 0; w < GRID; ++w) { const int c = ld_i32_agent(cntWG + w * 8 + F.tid); if (w < (int)blockIdx.x) base += c; tot += c; } L[F.tid] = base; L[8 + F.tid] = tot; }
    __syncthreads();
    if (F.tid == 0) { int ps = 0; for (int e = 0; e < 8; ++e) { L[16 + e] = ps; ps += (L[8 + e] + 255) / 256 * 256; } L[24] = ps; }
    __syncthreads();
    if (F.wave == 0) {
        const int tA = blockIdx.x * 128 + F.lane, tB = tA + 64;
        const int eA0 = ld_i32_agent(E01 + 2 * tA), eA1 = ld_i32_agent(E01 + 2 * tA + 1), eB0 = ld_i32_agent(E01 + 2 * tB), eB1 = ld_i32_agent(E01 + 2 * tB + 1);
        const unsigned long long lt = (1ull << F.lane) - 1ull;
        int dA0 = 0, dA1 = 0, dB0 = 0, dB1 = 0;
        for (int e = 0; e < 8; ++e) {
            const unsigned long long mA0 = __ballot(eA0 == e), mA1 = __ballot(eA1 == e), mB0 = __ballot(eB0 == e), mB1 = __ballot(eB1 == e);
            const int start = L[16 + e] + L[e];
            const int cA = __popcll(mA0 & lt) + __popcll(mA1 & lt), totA = __popcll(mA0) + __popcll(mA1), cB = totA + __popcll(mB0 & lt) + __popcll(mB1 & lt);
            if (eA0 == e) dA0 = start + cA; if (eA1 == e) dA1 = start + cA;
            if (eB0 == e) dB0 = start + cB; if (eB1 == e) dB1 = start + cB;
        }
        DEST[2 * tA] = dA0; DEST[2 * tA + 1] = dA1; DEST[2 * tB] = dB0; DEST[2 * tB + 1] = dB1;
        L[32 + 2 * F.lane] = dA0; L[32 + 2 * F.lane + 1] = dA1; L[32 + 2 * (F.lane + 64)] = dB0; L[32 + 2 * (F.lane + 64) + 1] = dB1;
    }
    __syncthreads();
    for (int i = 0; i < 16; ++i) {
        const int tl = F.wave * 16 + i, t = blockIdx.x * 128 + tl;
        const v4u* src = (const v4u*)(XB + (size_t)t * D) + F.lane; const v4u a = src[0], b = src[64];
#pragma unroll
        for (int k = 0; k < 2; ++k) { v4u* dst = (v4u*)(XS + (size_t)L[32 + 2 * tl + k] * D) + F.lane; dst[0] = a; dst[64] = b; }
    }
    if (blockIdx.x == 0) {
        const int nM = L[24] / 256;
        for (int i = F.tid; i < nM; i += NTHREADS) { int e = 0;
#pragma unroll
            for (int q = 1; q < 8; ++q) if (i * 256 >= L[16 + q]) e = q;
            tile_e[i] = e; }
        if (F.tid == 0) *nMp = nM;
    }
    __syncthreads();
}

__device__ __forceinline__ void memattn_naive(const Frame& F, const bf16* H, int ldh, int qoff, const bf16* MEMKV, bf16* CAT, int ldc, int coff) {
    const size_t gt = (size_t)blockIdx.x * NTHREADS + F.tid, NT = (size_t)GRID * NTHREADS;
    for (size_t it = gt; it < (size_t)T * 4; it += NT) {
        const int t = (int)(it >> 2), h = (int)(it & 3), bb = t / SEQ;
        float q[64], o[64];
#pragma unroll
        for (int c = 0; c < 8; ++c) { float f[8]; unpack8(*(const v4u*)(H + (size_t)t * ldh + qoff + 64 * h + 8 * c), f);
#pragma unroll
            for (int i = 0; i < 8; ++i) { q[8 * c + i] = f[i] * 0.125f; o[8 * c + i] = 0.f; } }
        float m = -3.0e38f, l = 0.f;
        for (int k = 0; k < ML; ++k) {
            const bf16* kr = MEMKV + (size_t)(bb * ML + k) * 512 + 64 * h;
            float sc = 0.f;
#pragma unroll
            for (int c = 0; c < 8; ++c) { float f[8]; unpack8(*(const v4u*)(kr + 8 * c), f);
#pragma unroll
                for (int i = 0; i < 8; ++i) sc += q[8 * c + i] * f[i]; }
            const float mn = fmaxf(m, sc), al = __expf(m - mn), p = __expf(sc - mn);
            l = l * al + p; m = mn;
#pragma unroll
            for (int c = 0; c < 8; ++c) { float f[8]; unpack8(*(const v4u*)(kr + 256 + 8 * c), f);
#pragma unroll
                for (int i = 0; i < 8; ++i) o[8 * c + i] = o[8 * c + i] * al + p * f[i]; }
        }
        const float inv = 1.f / l;
#pragma unroll
        for (int c = 0; c < 8; ++c) { float f[8];
#pragma unroll
            for (int i = 0; i < 8; ++i) f[i] = o[8 * c + i] * inv;
            *(v4u*)(CAT + (size_t)t * ldc + coff + 64 * h + 8 * c) = pack8(f); }
    }
}
__device__ __forceinline__ void dilattn_naive(const Frame& F, const bf16* H, bf16* CAT, int ldc) {
    const size_t gt = (size_t)blockIdx.x * NTHREADS + F.tid, NT = (size_t)GRID * NTHREADS;
    for (size_t it = gt; it < (size_t)T * 4; it += NT) {
        const int t = (int)(it >> 2), h = (int)(it & 3), s = t & (SEQ - 1);
        float q[64], o[64];
#pragma unroll
        for (int i = 0; i < 64; ++i) o[i] = 0.f;
        float m = -3.0e38f, l = 0.f;
        for (int g = 0; g < 3; ++g) {
            const int dl = 1 << (2 * g), nsub = SEQ / dl, j = s / dl, r = s % dl;
            const float slope = exp2f(-8.f * (float)(4 * g + h + 1) / 12.f) * (float)dl;
#pragma unroll
            for (int c = 0; c < 8; ++c) { float f[8]; unpack8(*(const v4u*)(H + (size_t)t * 2560 + 256 * g + 64 * h + 8 * c), f);
#pragma unroll
                for (int i = 0; i < 8; ++i) q[8 * c + i] = f[i] * 0.125f; }
            const int jlo = j - 64 < 0 ? 0 : j - 64, jhi = j + 64 > nsub - 1 ? nsub - 1 : j + 64;
            for (int jj = jlo; jj <= jhi; ++jj) {
                const bf16* kr = H + (size_t)(t - s + jj * dl + r) * 2560 + 768 + 256 * g + 64 * h;
                float sc = 0.f;
#pragma unroll
                for (int c = 0; c < 8; ++c) { float f[8]; unpack8(*(const v4u*)(kr + 8 * c), f);
#pragma unroll
                    for (int i = 0; i < 8; ++i) sc += q[8 * c + i] * f[i]; }
                const int ad = jj > j ? jj - j : j - jj;
                sc -= slope * (float)ad;
                const float mn = fmaxf(m, sc), al = __expf(m - mn), p = __expf(sc - mn);
                l = l * al + p; m = mn;
#pragma unroll
                for (int c = 0; c < 8; ++c) { float f[8]; unpack8(*(const v4u*)(kr + 768 + 8 * c), f);
#pragma unroll
                    for (int i = 0; i < 8; ++i) o[8 * c + i] = o[8 * c + i] * al + p * f[i]; }
            }
        }
        const float inv = 1.f / l;
#pragma unroll
        for (int c = 0; c < 8; ++c) { float f[8];
#pragma unroll
            for (int i = 0; i < 8; ++i) f[i] = o[8 * c + i] * inv;
            *(v4u*)(CAT + (size_t)t * ldc + 64 * h + 8 * c) = pack8(f); }
    }
}

constexpr int NPHASE = 34;
__global__ void __launch_bounds__(NTHREADS, 2) mega(Args args) {
    extern __shared__ __attribute__((aligned(16))) unsigned char lds[];
    Frame F; F.lds = (LAS unsigned char*)lds; F.tid = threadIdx.x; F.lane = F.tid & 63; F.wave = __builtin_amdgcn_readfirstlane(F.tid >> 6); F.gw = blockIdx.x * NWAVES + F.wave;
    volatile LAS unsigned* MISC = (volatile LAS unsigned*)(F.lds + MISC_OFF);
    unsigned char* ws = args.ws;
    unsigned* ctl = (unsigned*)(ws + WS_CTL);
    for (int u = F.tid; u < (LDS_BYTES - LDSCTL_OFF) / 4; u += NTHREADS) ((LAS unsigned*)(F.lds + LDSCTL_OFF))[u] = 0u;
    __syncthreads();
    const int lo = args.lo, hi = args.hi;
    XcdBarrier bar; bar.bar = ctl + CW_BAR; bar.x = 0; bar.st = nullptr;
    if (hi - lo > 1) bar = xcd_barrier_post(ctl + CW_BAR, MISC + 8);
#define IN(k) (lo <= (k) && (k) < hi)
#define SEAM(k) do { if (IN(k) && IN((k) + 1)) xcd_barrier(bar); else __syncthreads(); } while (0)
    const float* x_in = args.in[I_X]; float* XR = args.out;
    int* cntWG = (int*)(ws + WS_META); int* tile_e = (int*)(ws + WS_META + 16384); int* nMp = (int*)(ws + WS_META + 32768);
    int* E01 = (int*)(ws + WS_TOK); float* W01 = (float*)(ws + WS_TOK + 262144); int* DEST = (int*)(ws + WS_TOK + 524288);
    bf16* XB = (bf16*)(ws + WS_XB); bf16* MEMB = (bf16*)(ws + WS_MEMB); bf16* MEMKV = (bf16*)(ws + WS_MEMKV);
    bf16* Hb = (bf16*)(ws + WS_SCR + SC_H); bf16* CAT = (bf16*)(ws + WS_SCR + SC_CAT); bf16* DIFF = (bf16*)(ws + WS_SCR + SC_DIFF);
    bf16* HID = (bf16*)(ws + WS_SCR + SC_HID); bf16* XS = (bf16*)(ws + WS_SCR + SC_XS); bf16* HS = (bf16*)(ws + WS_SCR + SC_HS); bf16* YB = XS;
    const float* ln_g = args.in[I_LNG]; const float* ln_b = args.in[I_LNB];

    if (IN(0)) { prep_phase(F, x_in, args.in[I_MEM], XB, MEMB); SEAM(0); }
    if (IN(1)) { naive_gemm<1>(F, MEMB, D, args.in[I_WMEMKV], nullptr, 512, NB * ML, 512, D, NEpiBf16{MEMKV, 512}, nullptr, 0); SEAM(1); }

    if (IN(2)) { naive_gemm<1>(F, XB, D, args.in[I_AWIN], nullptr, 2560, T, 2560, D, NEpiBf16{Hb, 2560}, nullptr, 0); SEAM(2); }
    if (IN(3)) { mixA_phase(F, Hb, args.in[I_ACONV], CAT); memattn_naive(F, Hb, 2560, 2304, MEMKV, CAT, 1024, 768); SEAM(3); }
    if (IN(4)) { naive_gemm<1>(F, CAT, 1024, args.in[I_AWOUT], nullptr, D, T, D, 1024, NEpiResid{x_in, XR}, nullptr, 0); SEAM(4); }
    if (IN(5)) { ln_phase<false, false>(F, XR, XB, ln_g + 0 * D, ln_b + 0 * D, nullptr, nullptr, nullptr, nullptr, nullptr, nullptr); SEAM(5); }
    if (IN(6)) { naive_gemm<2>(F, XB, D, args.in[I_FG], args.in[I_FU], FF, T, FF, D, NEpiSwiglu{HID, FF}, nullptr, 0); SEAM(6); }
    if (IN(7)) { naive_gemm<1>(F, HID, FF, args.in[I_FD], nullptr, D, T, D, FF, NEpiResid{XR, XR}, nullptr, 0); SEAM(7); }
    if (IN(8)) { ln_phase<false, false>(F, XR, XB, ln_g + 1 * D, ln_b + 1 * D, nullptr, nullptr, nullptr, nullptr, nullptr, nullptr); SEAM(8); }

    if (IN(9)) { naive_gemm<1>(F, XB, D, args.in[I_BWIN], nullptr, 2560, T, 2560, D, NEpiBf16{Hb, 2560}, nullptr, 0); SEAM(9); }
    if (IN(10)) { dilattn_naive(F, Hb, CAT, 512); memattn_naive(F, Hb, 2560, 2304, MEMKV, CAT, 512, 256); SEAM(10); }
    if (IN(11)) { SEAM(11); }
    if (IN(12)) { naive_gemm<1>(F, CAT, 512, args.in[I_BWOUT], nullptr, D, T, D, 512, NEpiResid{XR, XR}, nullptr, 0); SEAM(12); }
    if (IN(13)) { ln_phase<true, false>(F, XR, XB, ln_g + 2 * D, ln_b + 2 * D, args.in[I_ROUTER], E01, W01, nullptr, nullptr, cntWG); SEAM(13); }
    if (IN(14)) { scatter_phase(F, cntWG, E01, DEST, XB, XS, tile_e, nMp); SEAM(14); }
    if (IN(15)) { const int nM = ld_i32_agent(nMp); naive_gemm<2>(F, XS, D, args.in[I_MG], args.in[I_MU], FFE, nM * 256, FFE, D, NEpiSwiglu{HS, FFE}, tile_e, (size_t)D * FFE); SEAM(15); }
    if (IN(16)) { const int nM = ld_i32_agent(nMp); naive_gemm<1>(F, HS, FFE, args.in[I_MD], nullptr, D, nM * 256, D, FFE, NEpiBf16{YB, D}, tile_e, (size_t)FFE * D); SEAM(16); }
    if (IN(17)) { ln_phase<false, true>(F, XR, XB, ln_g + 3 * D, ln_b + 3 * D, nullptr, nullptr, W01, DEST, YB, nullptr); SEAM(17); }

    if (IN(18)) { naive_gemm<1>(F, XB, D, args.in[I_CWIN], nullptr, 1024, T, 1024, D, NEpiBf16{Hb, 1024}, nullptr, 0); SEAM(18); }
    if (IN(19)) { poolC_phase(F, Hb, DIFF, 768); memattn_naive(F, Hb, 1024, 768, MEMKV, CAT, 1024, 768); SEAM(19); }
    if (IN(20)) {
#pragma unroll 1
        for (int g = 0; g < 4; ++g) naive_gemm<1>(F, DIFF + 192 * g, 768, args.in[I_CPOOLW] + (size_t)g * 192 * 192, nullptr, 192, T, 192, 192, NEpiScale{CAT, 1024, 192 * g, args.in[I_CPOOLS]}, nullptr, 0);
        SEAM(20); }
    if (IN(21)) { naive_gemm<1>(F, CAT, 1024, args.in[I_CWOUT], nullptr, D, T, D, 1024, NEpiResid{XR, XR}, nullptr, 0); SEAM(21); }
    if (IN(22)) { ln_phase<false, false>(F, XR, XB, ln_g + 4 * D, ln_b + 4 * D, nullptr, nullptr, nullptr, nullptr, nullptr, nullptr); SEAM(22); }
    if (IN(23)) { naive_gemm<2>(F, XB, D, args.in[I_FG] + (size_t)D * FF, args.in[I_FU] + (size_t)D * FF, FF, T, FF, D, NEpiSwiglu{HID, FF}, nullptr, 0); SEAM(23); }
    if (IN(24)) { naive_gemm<1>(F, HID, FF, args.in[I_FD] + (size_t)FF * D, nullptr, D, T, D, FF, NEpiResid{XR, XR}, nullptr, 0); SEAM(24); }
    if (IN(25)) { ln_phase<false, false>(F, XR, XB, ln_g + 5 * D, ln_b + 5 * D, nullptr, nullptr, nullptr, nullptr, nullptr, nullptr); SEAM(25); }

    if (IN(26)) { naive_gemm<1>(F, XB, D, args.in[I_AWIN] + (size_t)D * 2560, nullptr, 2560, T, 2560, D, NEpiBf16{Hb, 2560}, nullptr, 0); SEAM(26); }
    if (IN(27)) { mixA_phase(F, Hb, args.in[I_ACONV] + 3 * 768, CAT); memattn_naive(F, Hb, 2560, 2304, MEMKV, CAT, 1024, 768); SEAM(27); }
    if (IN(28)) { naive_gemm<1>(F, CAT, 1024, args.in[I_AWOUT] + (size_t)D * D, nullptr, D, T, D, 1024, NEpiResid{XR, XR}, nullptr, 0); SEAM(28); }
    if (IN(29)) { ln_phase<true, false>(F, XR, XB, ln_g + 6 * D, ln_b + 6 * D, args.in[I_ROUTER] + D * NE, E01, W01, nullptr, nullptr, cntWG); SEAM(29); }
    if (IN(30)) { scatter_phase(F, cntWG, E01, DEST, XB, XS, tile_e, nMp); SEAM(30); }
    if (IN(31)) { const int nM = ld_i32_agent(nMp); naive_gemm<2>(F, XS, D, args.in[I_MG] + (size_t)NE * D * FFE, args.in[I_MU] + (size_t)NE * D * FFE, FFE, nM * 256, FFE, D, NEpiSwiglu{HS, FFE}, tile_e, (size_t)D * FFE); SEAM(31); }
    if (IN(32)) { const int nM = ld_i32_agent(nMp); naive_gemm<1>(F, HS, FFE, args.in[I_MD] + (size_t)NE * FFE * D, nullptr, D, nM * 256, D, FFE, NEpiBf16{YB, D}, tile_e, (size_t)FFE * D); SEAM(32); }
    if (IN(33)) { ln_phase<false, true>(F, XR, XB, ln_g + 7 * D, ln_b + 7 * D, nullptr, nullptr, W01, DEST, YB, nullptr); }
#undef IN
#undef SEAM
}

extern "C" void kernel_launch(void* const* d_in, const int* in_sizes, int n_in, void* d_out, int out_size, void* d_ws, size_t ws_size, hipStream_t stream) {
    static int ok = 0;
    if (ok == 0) {
        ok = 1;
        if (n_in != 21 || out_size != T * D || ws_size < WS_END) { fprintf(stderr, "kernel_launch: unexpected shapes (n_in %d, out %d, ws %zu < %zu)\n", n_in, out_size, ws_size, (size_t)WS_END); ok = -1; }
        if (ok > 0 && hipFuncSetAttribute((const void*)mega, hipFuncAttributeMaxDynamicSharedMemorySize, LDS_BYTES) != hipSuccess) { fprintf(stderr, "kernel_launch: hipFuncSetAttribute failed\n"); ok = -1; }
        int dev = 0, cus = 0; (void)hipGetDevice(&dev); (void)hipDeviceGetAttribute(&cus, hipDeviceAttributeMultiprocessorCount, dev);
        if (cus < GRID) { fprintf(stderr, "kernel_launch: %d CUs < %d\n", cus, GRID); ok = -1; }
        (void)hipGetLastError();
    }
    if (ok < 0) return;
    (void)hipMemsetAsync((char*)d_ws + WS_CTL, 0, CTL_ZERO_BYTES, stream);
    Args a{};
    for (int i = 0; i < 21; ++i) a.in[i] = (const float*)d_in[i];
    a.out = (float*)d_out; a.ws = (unsigned char*)d_ws;
#if MK_ONE_LAUNCH
    a.lo = 0; a.hi = NPHASE;
    hipLaunchKernelGGL(mega, dim3(GRID), dim3(NTHREADS), LDS_BYTES, stream, a);
#else
    for (int p = 0; p < NPHASE; ++p) { if (p == 11) continue; a.lo = p; a.hi = p + 1; hipLaunchKernelGGL(mega, dim3(GRID), dim3(NTHREADS), LDS_BYTES, stream, a); }
#endif
}
```

```cpp
#include <hip/hip_runtime.h>
#include <cstdio>
#include <cstdint>

#ifndef MK_ONE_LAUNCH
#define MK_ONE_LAUNCH 1
#endif
#ifndef FAST_GEMM
#define FAST_GEMM 1
#endif
#ifndef FAST_ATTN
#define FAST_ATTN 0
#endif

#define GAS __attribute__((address_space(1)))
#define LAS __attribute__((address_space(3)))
typedef unsigned short bf16;
typedef unsigned v4u __attribute__((ext_vector_type(4)));
typedef unsigned v2u __attribute__((ext_vector_type(2)));
typedef float f32x4 __attribute__((ext_vector_type(4)));
typedef float f32x2 __attribute__((ext_vector_type(2)));
typedef float f32x16 __attribute__((ext_vector_type(16)));
typedef short bf16x8 __attribute__((ext_vector_type(8)));
typedef short s16x4 __attribute__((ext_vector_type(4)));
#define RLX_AGENT __ATOMIC_RELAXED, __HIP_MEMORY_SCOPE_AGENT
#define LDS_WAIT() asm volatile("s_waitcnt lgkmcnt(0)" ::: "memory")
#define VM_WAIT() asm volatile("s_waitcnt vmcnt(0)" ::: "memory")

constexpr int NB = 16, SEQ = 2048, T = NB * SEQ, D = 1024, ML = 256, MEMW = 256, MIXW = 768, HD = 64;
constexpr int FF = 2816, FFE = 3584, NE = 8;
constexpr int RMAX = (2 * T / 256 + NE) * 256;
constexpr float ALPHA = 1.6817928305074290f;
constexpr float LN_EPS = 1e-5f;
constexpr int NWAVES = 8, NTHREADS = 512, GRID = 256, NGW = GRID * NWAVES;

constexpr size_t MiB = 1u << 20;
constexpr size_t WS_CTL = 0, CTL_ZERO_BYTES = 1 * MiB;
constexpr size_t WS_META = 1 * MiB;
constexpr size_t WS_TOK = 2 * MiB;
constexpr size_t WS_WS = 4 * MiB;
constexpr size_t WS_WMOE = 64 * MiB;
constexpr size_t WS_XB = 232 * MiB;
constexpr size_t WS_MEMB = 296 * MiB;
constexpr size_t WS_MEMKV = 304 * MiB;
constexpr size_t WS_SCR = 308 * MiB;
constexpr size_t SC_H = 0, SC_CAT = 160 * MiB, SC_OG = 224 * MiB, SC_LSE = 320 * MiB, SC_DIFF = 224 * MiB;
constexpr size_t SC_HID = 0;
constexpr size_t SC_XS = 0, SC_HS = 132 * MiB;
constexpr size_t WS_END = WS_SCR + SC_HS + (size_t)RMAX * FFE * 2;
static_assert(WS_END <= 903 * MiB, "ws map");
constexpr size_t OFF_WKV = 0, OFF_AIN = 524288, OFF_AOUT = 5767168, OFF_BIN = 7864320, OFF_BOUT = 10485760, OFF_CIN = 11010048,
                 OFF_COUT = 12058624, OFF_FGU = 13107200, OFF_FD = 24641536, OFF_WS_END = 30408704;
static_assert(OFF_WS_END * 2 <= 60 * MiB, "small weights");
constexpr size_t OFF_MGU = 0, OFF_MD = (size_t)NE * 2 * FFE * D;
constexpr int CW_BAR = 4096;

constexpr int RING_BYTES = 131072, LDSCTL_OFF = RING_BYTES, MISC_OFF = LDSCTL_OFF + 320, LDS_BYTES = 147456;

__device__ __forceinline__ unsigned f2bf(float f) { unsigned u = __builtin_bit_cast(unsigned, f); return (u + 0x7fffu + ((u >> 16) & 1u)) >> 16; }
__device__ __forceinline__ unsigned pk2(float lo, float hi) { return f2bf(lo) | (f2bf(hi) << 16); }
__device__ __forceinline__ float bf2f(unsigned b) { return __builtin_bit_cast(float, b << 16); }
__device__ __forceinline__ float bflo(unsigned w) { return __builtin_bit_cast(float, w << 16); }
__device__ __forceinline__ float bfhi(unsigned w) { return __builtin_bit_cast(float, w & 0xffff0000u); }
__device__ __forceinline__ float wave_sum(float v) {
#pragma unroll
    for (int o = 1; o < 64; o <<= 1) v += __shfl_xor(v, o);
    return v;
}
__device__ __forceinline__ int ld_i32_agent(const int* p) { return (int)__hip_atomic_load((const unsigned*)p, RLX_AGENT); }
__device__ __forceinline__ float ld_f32_agent(const float* p) { return __builtin_bit_cast(float, __hip_atomic_load((const unsigned*)p, RLX_AGENT)); }

#define XB_TMO      128
#define XB_XCNT(j)  (256  + 64 * (j))
#define XB_XSUB(j)  (1280 + 64 * (j))
#define XB_XGEN(j)  (2304 + 64 * (j))
#define XB_TOP      3328
#define XB_TOPGEN   3392
#define XCD_BAR_WORDS 3456
#define XB_SPIN_CAP (1u << 18)
__device__ __forceinline__ unsigned xb_ld(unsigned* p)              { return __hip_atomic_load(p, __ATOMIC_RELAXED, __HIP_MEMORY_SCOPE_AGENT); }
__device__ __forceinline__ unsigned xb_add(unsigned* p, unsigned v) { return __hip_atomic_fetch_add(p, v, __ATOMIC_RELAXED, __HIP_MEMORY_SCOPE_AGENT); }
__device__ __forceinline__ unsigned xb_xcc_id() { return (unsigned)__builtin_amdgcn_s_getreg((3 << 11) | 20) & 0xFu; }
#define XB_SPIN(cond, bar) do { unsigned _sp = 0; while (cond) { __builtin_amdgcn_s_sleep(1); \
    if ((++_sp & 255u) == 0u) { if (xb_ld(&(bar)[XB_TMO])) break; if (_sp > XB_SPIN_CAP) { atomicAdd(&(bar)[XB_TMO], 1u); break; } } } } while (0)
struct XcdBarrier { unsigned* bar; unsigned x; volatile LAS unsigned* st; };
__device__ __forceinline__ XcdBarrier xcd_barrier_post(unsigned* bar, volatile LAS unsigned* st) {
    XcdBarrier b; b.bar = bar; b.x = xb_xcc_id(); b.st = st;
    if (threadIdx.x == 0) (void)xb_add(&bar[XB_XCNT(b.x)], 1u);
    return b;
}
__device__ __forceinline__ void xcd_barrier_complete(unsigned* bar, unsigned x, unsigned& nloc, unsigned& nx) {
    const unsigned G = gridDim.x * gridDim.y * gridDim.z;
    unsigned sum, cnt, mine, sp = 0u;
    for (;;) {
        sum = 0u; cnt = 0u; mine = 0u;
#pragma unroll
        for (unsigned j = 0; j < 16; ++j) { const unsigned c = xb_ld(&bar[XB_XCNT(j)]); sum += c; cnt += (c > 0u) ? 1u : 0u; mine = (j == x) ? c : mine; }
        if (sum == G) break;
        __builtin_amdgcn_s_sleep(1);
        if ((++sp & 255u) == 0u) { if (xb_ld(&bar[XB_TMO])) break; if (sp > XB_SPIN_CAP) { atomicAdd(&bar[XB_TMO], 1u); break; } }
    }
    nloc = mine > 0u ? mine : 1u; nx = cnt > 0u ? cnt : 1u;
}
__device__ __forceinline__ void xcd_barrier(const XcdBarrier& b) {
    asm volatile("s_waitcnt vmcnt(0)" ::: "memory");
    __syncthreads();
    if (threadIdx.x == 0) {
        unsigned* bar = b.bar;
        __builtin_amdgcn_s_waitcnt(0);
        unsigned nloc = b.st[0], nx = b.st[1];
        if (nloc == 0u) { xcd_barrier_complete(bar, b.x, nloc, nx); b.st[0] = nloc; b.st[1] = nx; }
        const unsigned old = xb_add(&bar[XB_XSUB(b.x)], 1u);
        const unsigned gen = old / nloc;
        if (old + 1u == (gen + 1u) * nloc) {
            __builtin_amdgcn_fence(__ATOMIC_RELEASE, "agent");
            asm volatile("s_waitcnt vmcnt(0)" ::: "memory");
            const unsigned og = xb_add(&bar[XB_TOP], 1u);
            const unsigned tg = og / nx;
            if (og + 1u == (tg + 1u) * nx) xb_add(&bar[XB_TOPGEN], 1u);
            else XB_SPIN(xb_ld(&bar[XB_TOPGEN]) == tg, bar);
            __builtin_amdgcn_fence(__ATOMIC_ACQUIRE, "agent");
            xb_add(&bar[XB_XGEN(b.x)], 1u);
            asm volatile("s_waitcnt vmcnt(0)" ::: "memory");
        } else {
            XB_SPIN(xb_ld(&bar[XB_XGEN(b.x)]) == gen, bar);
            __builtin_amdgcn_fence(__ATOMIC_ACQUIRE, "agent");
            asm volatile("s_waitcnt vmcnt(0)" ::: "memory");
        }
    }
    __syncthreads();
}

namespace pg8 {
#define PG8_LAS __attribute__((address_space(3)))
typedef unsigned short bf16_t;
typedef short bf16x8 __attribute__((ext_vector_type(8)));
typedef float f32x4 __attribute__((ext_vector_type(4)));
typedef unsigned u32x4 __attribute__((ext_vector_type(4)));
constexpr int BM = 256, BK = 64, HALF = 128, HTB = HALF * BK * 2  , STAGE_BYTES = 8 * HTB, NXCD = 8, WGM = 8;

__host__ __device__ __forceinline__ int lds_byte(int r, int c) { const int st = (r >> 4) * 2 + (c >> 5), rr = r & 15, cc = c & 31, ob = rr * 64 + cc * 2; return st * 1024 + (ob ^ (((ob >> 9) & 1) << 5)); }
__host__ __device__ __forceinline__ void stage_rc(int b, int& R, int& C) { const int st = b / 1024, sb = b % 1024, swz = sb ^ (((sb >> 9) & 1) << 5); R = (st >> 1) * 16 + swz / 64; C = (st & 1) * 32 + (swz % 64) / 2; }
__host__ __device__ __forceinline__ int perm32(int rho) { const int n = rho >> 4, i = rho & 15; return 8 * (i >> 2) + 4 * n + (i & 3); }

struct Unit { int pm, pn; };
struct Gemm { const bf16_t* A; const bf16_t* Bt; int M, N, K; };

struct StaticOrder {
    int nM, nN, nwg, G, c;
    __host__ __device__ void init(int M, int N, int G_, int c_) { nM = M / BM; nN = N / BM; nwg = nM * nN; G = G_; c = c_; }
    __host__ __device__ bool next(int i, Unit& u) const {
        const long L = (long)i * G + c; if (L >= nwg) return false;
        int wgid = (int)L; { const int q = nwg / NXCD, r = nwg % NXCD, xcd = wgid % NXCD, off = wgid / NXCD; wgid = (xcd < r ? xcd * (q + 1) : r * (q + 1) + (xcd - r) * q) + off; }
        const int nig = WGM * nN, gid = wgid / nig, fm = gid * WGM, gsz = (nM - fm) < WGM ? (nM - fm) : WGM;
        u.pm = fm + ((wgid % nig) % gsz); u.pn = (wgid % nig) / gsz; return true;
    }
    __device__ __forceinline__ void a_ready(const Unit&) const {}
    __device__ __forceinline__ void done(const Unit&) const {}
    __device__ __forceinline__ size_t boff(const Unit&) const { return 0; }
};
struct MoeOrder : StaticOrder {
    const int* tile_e; size_t estride;
    __device__ __forceinline__ size_t boff(const Unit& u) const { return (size_t)__builtin_amdgcn_readfirstlane((int)__hip_atomic_load((const unsigned*)tile_e + u.pm, __ATOMIC_RELAXED, __HIP_MEMORY_SCOPE_AGENT)) * estride; }
};

__device__ __forceinline__ unsigned cvt_pk_bf16(float lo, float hi) { unsigned r; asm volatile("v_cvt_pk_bf16_f32 %0, %1, %2" : "=v"(r) : "v"(lo), "v"(hi)); return r; }
typedef float f32x2 __attribute__((ext_vector_type(2)));
template <int ACT  > struct EpiBf16 {
    static constexpr bool PERM = true, AFTER_DRAIN = false; static_assert(ACT == 0, "EpiBf16: ACT is 0");
    bf16_t* O; int ldc; const float* bias; int split_cols; size_t split_stride; float scale0;
    __device__ __forceinline__ void operator()(const f32x4 (&acc)[2][2][4][2], const Unit& u, int wr, int wc, int fr, int fq) const {
        const int row0 = u.pm * BM + wr * 64 + fr; int colt = u.pn * BM; bf16_t* base = O;
        float sc = 1.f; if (split_cols) { const int t = colt / split_cols; base += (size_t)t * split_stride; colt -= t * split_cols; if (t == 0) sc = scale0; }
        const int col0 = colt + wc * 32 + 8 * fq, bcol0 = u.pn * BM + wc * 32 + 8 * fq;
        f32x4 bv[2][2];
#pragma unroll
        for (int bj = 0; bj < 2; ++bj)
#pragma unroll
            for (int n = 0; n < 2; ++n) bv[bj][n] = bias ? *(const f32x4*)(bias + bcol0 + bj * HALF + 4 * n) : (f32x4){0.f, 0.f, 0.f, 0.f};
#pragma unroll
        for (int ai = 0; ai < 2; ++ai)
#pragma unroll
            for (int m = 0; m < 4; ++m) { bf16_t* rowp = base + (size_t)(row0 + ai * HALF + m * 16) * ldc + col0;
#pragma unroll
                for (int bj = 0; bj < 2; ++bj) { f32x4 v0 = acc[ai][bj][m][0] + bv[bj][0], v1 = acc[ai][bj][m][1] + bv[bj][1];
                    v0 = v0 * sc; v1 = v1 * sc; u32x4 w; w.x = cvt_pk_bf16(v0[0], v0[1]); w.y = cvt_pk_bf16(v0[2], v0[3]); w.z = cvt_pk_bf16(v1[0], v1[1]); w.w = cvt_pk_bf16(v1[2], v1[3]);
                    *(u32x4*)(rowp + bj * HALF) = w; } }
    }
};

struct EpiSwiglu {
    static constexpr bool PERM = true, AFTER_DRAIN = false;
    bf16_t* O; int ldc;
    __device__ __forceinline__ void operator()(const f32x4 (&acc)[2][2][4][2], const Unit& u, int wr, int wc, int fr, int fq) const {
        const int row0 = u.pm * BM + wr * 64 + fr, col0 = u.pn * HALF + wc * 32 + 8 * fq;
#pragma unroll
        for (int ai = 0; ai < 2; ++ai)
#pragma unroll
            for (int m = 0; m < 4; ++m) { bf16_t* rowp = O + (size_t)(row0 + ai * HALF + m * 16) * ldc + col0;
                float h[8];
#pragma unroll
                for (int n = 0; n < 2; ++n)
#pragma unroll
                    for (int j = 0; j < 4; ++j) { const float gte = acc[ai][0][m][n][j], up = acc[ai][1][m][n][j];
                        h[4 * n + j] = gte * __builtin_amdgcn_rcpf(1.0f + __builtin_amdgcn_exp2f(-1.4426950408889634f * gte)) * up; }
                u32x4 w; w.x = cvt_pk_bf16(h[0], h[1]); w.y = cvt_pk_bf16(h[2], h[3]); w.z = cvt_pk_bf16(h[4], h[5]); w.w = cvt_pk_bf16(h[6], h[7]);
                *(u32x4*)rowp = w; }
    }
};
struct EpiResid {
    static constexpr bool PERM = false, AFTER_DRAIN = false;
    const float* base; float* out; int ldc; float alpha;
    __device__ __forceinline__ void operator()(const f32x4 (&acc)[2][2][4][2], const Unit& u, int wr, int wc, int fr, int fq) const {
        const int row0 = u.pm * BM + wr * 64 + fr, col0 = u.pn * BM + wc * 32 + 4 * fq;
#pragma unroll
        for (int ai = 0; ai < 2; ++ai)
#pragma unroll
            for (int m = 0; m < 4; ++m) { const size_t ro = (size_t)(row0 + ai * HALF + m * 16) * ldc + col0;
                f32x4 bs[2][2];
#pragma unroll
                for (int bj = 0; bj < 2; ++bj)
#pragma unroll
                    for (int n = 0; n < 2; ++n) bs[bj][n] = *(const f32x4*)(base + ro + bj * HALF + n * 16);
#pragma unroll
                for (int bj = 0; bj < 2; ++bj)
#pragma unroll
                    for (int n = 0; n < 2; ++n) *(f32x4*)(out + ro + bj * HALF + n * 16) = bs[bj][n] * alpha + acc[ai][bj][m][n]; }
    }
};

template <class Epi, class Sched, bool ALIGN_EPI = false, bool SP2 = false>
__device__ __forceinline__ void gemm_phase(PG8_LAS unsigned char* lds, const Gemm g, const Sched& S, const Epi& E) {
    const int tid = threadIdx.x, wid = __builtin_amdgcn_readfirstlane(tid >> 6), lane = tid & 63, wr = wid >> 2, wc = wid & 3, fr = lane & 15, fq = lane >> 4;
    const int K = g.K, nt = K / BK;
    unsigned voffA[2], voffB[2];
#pragma unroll
    for (int i = 0; i < 2; ++i) { int R, C; stage_rc(tid * 16 + i * 8192, R, C); const int Rb = Epi::PERM ? ((R & ~31) + perm32(R & 31)) : R;
        voffA[i] = (unsigned)(R * K + C) * 2u; voffB[i] = (unsigned)(Rb * K + C) * 2u; }
    const size_t kstep = (size_t)(BK * 2);
    const size_t hstep = (size_t)HALF * K * 2;
    const size_t tstep = 2 * hstep;
    const unsigned ldsw = (unsigned)wid * 1024u;
    const int aoff = lds_byte(wr * 64 + fr, fq * 8), boff = lds_byte(wc * 32 + fr, fq * 8);
#define PG8_SA(b, h) (((b) * 2 + (h)) * HTB)
#define PG8_SB(b, h) ((4 + (b) * 2 + (h)) * HTB)
#define PG8_STAGE(bufoff, gbase, voff) do { _Pragma("unroll") for (int _i = 0; _i < 2; ++_i) \
        __builtin_amdgcn_global_load_lds((const unsigned*)((const char*)(gbase) + (voff)[_i]), (PG8_LAS unsigned*)(lds + (bufoff) + ldsw + _i * 8192), 16, 0, 0); } while (0)
#define PG8_LDA(dst, b, h) do { _Pragma("unroll") for (int m = 0; m < 4; ++m) _Pragma("unroll") for (int k = 0; k < 2; ++k) dst[m][k] = *(const PG8_LAS bf16x8*)(lds + PG8_SA(b, h) + aoff + m * 2048 + k * 1024); } while (0)
#define PG8_LDB(dst, b, h) do { _Pragma("unroll") for (int n = 0; n < 2; ++n) _Pragma("unroll") for (int k = 0; k < 2; ++k) dst[n][k] = *(const PG8_LAS bf16x8*)(lds + PG8_SB(b, h) + boff + n * 2048 + k * 1024); } while (0)
#define PG8_MMA(ai, bj, At, Bt) do { __builtin_amdgcn_s_setprio(1); _Pragma("unroll") for (int m = 0; m < 4; ++m) _Pragma("unroll") for (int n = 0; n < 2; ++n) _Pragma("unroll") for (int k = 0; k < 2; ++k) \
        acc[ai][bj][m][n] = __builtin_amdgcn_mfma_f32_16x16x32_bf16(Bt[n][k], At[m][k], acc[ai][bj][m][n], 0, 0, 0); __builtin_amdgcn_s_setprio(0); } while (0)
#define PG8_WAIT_V(n) asm volatile("s_waitcnt vmcnt(" #n ")" ::: "memory")
#define PG8_WAIT_L(n) asm volatile("s_waitcnt lgkmcnt(" #n ")" ::: "memory")
#define PG8_BAR __builtin_amdgcn_s_barrier()
#define PG8_SCHED __builtin_amdgcn_sched_barrier(0)
    Unit cur, nxt; int ui = 0;
    if (!S.next(0, cur)) return;
    f32x4 acc[2][2][4][2];
#pragma unroll
    for (int a = 0; a < 2; ++a)
#pragma unroll
        for (int b = 0; b < 2; ++b)
#pragma unroll
            for (int m = 0; m < 4; ++m)
#pragma unroll
                for (int n = 0; n < 2; ++n) acc[a][b][m][n] = (f32x4){0.f, 0.f, 0.f, 0.f};
    bf16x8 At[4][2], B0[2][2], B1[2][2];
    const char* cA = (const char*)g.A + (size_t)cur.pm * tstep; const char* cB = (const char*)g.Bt + S.boff(cur) * 2 + (size_t)cur.pn * tstep;
    S.a_ready(cur);
    if constexpr (SP2) {
        PG8_STAGE(PG8_SB(0, 0), cB, voffB); PG8_STAGE(PG8_SB(0, 1), cB + hstep, voffB); PG8_STAGE(PG8_SA(0, 0), cA, voffA); PG8_STAGE(PG8_SA(0, 1), cA + hstep, voffA);
        if (wr == 1) PG8_BAR;
        PG8_WAIT_V(2); PG8_BAR;
        PG8_STAGE(PG8_SB(1, 0), cB + kstep, voffB); PG8_STAGE(PG8_SA(1, 0), cA + kstep, voffA); PG8_STAGE(PG8_SB(1, 1), cB + hstep + kstep, voffB);
        PG8_WAIT_V(6); PG8_BAR;
    } else {
        PG8_STAGE(PG8_SB(0, 0), cB, voffB); PG8_STAGE(PG8_SA(0, 0), cA, voffA); PG8_STAGE(PG8_SB(0, 1), cB + hstep, voffB); PG8_STAGE(PG8_SA(0, 1), cA + hstep, voffA);
        if (wr == 1) PG8_BAR;
        PG8_WAIT_V(4); PG8_BAR;
        PG8_STAGE(PG8_SB(1, 0), cB + kstep, voffB); PG8_STAGE(PG8_SA(1, 0), cA + kstep, voffA); PG8_STAGE(PG8_SB(1, 1), cB + hstep + kstep, voffB);
        PG8_WAIT_V(6); PG8_BAR;
    }
    for (;;) {
        const bool has_next = S.next(ui + 1, nxt);
        const char* nA = has_next ? (const char*)g.A + (size_t)nxt.pm * tstep : cA; const char* nB = has_next ? (const char*)g.Bt + S.boff(nxt) * 2 + (size_t)nxt.pn * tstep : cB;
        for (int t = 0; t < nt; t += 2) {
            const bool last = (t == nt - 2);
            const char* a1 = cA + (size_t)(t + 1) * kstep;
            const char* a2 = last ? nA : cA + (size_t)(t + 2) * kstep; const char* b2 = last ? nB : cB + (size_t)(t + 2) * kstep;
            const char* a3 = a2 + kstep; const char* b3 = b2 + kstep;
            if (last && has_next) S.a_ready(nxt);
            if constexpr (SP2) {
            PG8_LDB(B0, 0, 0); PG8_LDB(B1, 0, 1); PG8_SCHED; PG8_LDA(At, 0, 0); PG8_STAGE(PG8_SA(1, 1), a1 + hstep, voffA);
            PG8_WAIT_V(8); PG8_WAIT_L(0); PG8_BAR; PG8_MMA(0, 0, At, B0); PG8_MMA(0, 1, At, B1); PG8_BAR; PG8_SCHED;
            PG8_LDA(At, 0, 1); PG8_STAGE(PG8_SB(0, 0), b2, voffB); PG8_STAGE(PG8_SB(0, 1), b2 + hstep, voffB); PG8_STAGE(PG8_SA(0, 0), a2, voffA);
            PG8_WAIT_V(8); PG8_WAIT_L(0); PG8_BAR; PG8_MMA(1, 0, At, B0); PG8_MMA(1, 1, At, B1); PG8_BAR; PG8_SCHED;
            PG8_LDB(B0, 1, 0); PG8_LDB(B1, 1, 1); PG8_SCHED; PG8_LDA(At, 1, 0); PG8_STAGE(PG8_SA(0, 1), a2 + hstep, voffA);
            PG8_WAIT_V(8); PG8_WAIT_L(0); PG8_BAR; PG8_MMA(0, 0, At, B0); PG8_MMA(0, 1, At, B1); PG8_BAR; PG8_SCHED;
            PG8_LDA(At, 1, 1); PG8_STAGE(PG8_SB(1, 0), b3, voffB); PG8_STAGE(PG8_SB(1, 1), b3 + hstep, voffB); PG8_STAGE(PG8_SA(1, 0), a3, voffA);
            PG8_WAIT_V(8); PG8_WAIT_L(0); PG8_BAR; PG8_MMA(1, 0, At, B0); PG8_MMA(1, 1, At, B1); PG8_BAR; PG8_SCHED;
            } else {
            PG8_LDB(B0, 0, 0); PG8_SCHED; PG8_LDA(At, 0, 0); PG8_STAGE(PG8_SA(1, 1), a1 + hstep, voffA);
            PG8_WAIT_L(8); PG8_BAR; PG8_WAIT_L(0); PG8_MMA(0, 0, At, B0); PG8_BAR; PG8_SCHED;
            PG8_LDB(B1, 0, 1); PG8_STAGE(PG8_SB(0, 0), b2, voffB);
            PG8_BAR; PG8_WAIT_L(0); PG8_MMA(0, 1, At, B1); PG8_BAR;
            PG8_LDA(At, 0, 1); PG8_STAGE(PG8_SA(0, 0), a2, voffA);
            PG8_BAR; PG8_WAIT_L(0); PG8_MMA(1, 0, At, B0); PG8_BAR; PG8_SCHED;
            PG8_STAGE(PG8_SB(0, 1), b2 + hstep, voffB);
            PG8_WAIT_V(6); PG8_BAR; PG8_MMA(1, 1, At, B1); PG8_BAR;
            PG8_LDB(B0, 1, 0); PG8_SCHED; PG8_LDA(At, 1, 0); PG8_STAGE(PG8_SA(0, 1), a2 + hstep, voffA);
            PG8_WAIT_L(8); PG8_BAR; PG8_WAIT_L(0); PG8_MMA(0, 0, At, B0); PG8_BAR; PG8_SCHED;
            PG8_LDB(B1, 1, 1); PG8_STAGE(PG8_SB(1, 0), b3, voffB);
            PG8_BAR; PG8_WAIT_L(0); PG8_MMA(0, 1, At, B1); PG8_BAR;
            PG8_LDA(At, 1, 1); PG8_STAGE(PG8_SA(1, 0), a3, voffA);
            PG8_BAR; PG8_WAIT_L(0); PG8_MMA(1, 0, At, B0); PG8_BAR; PG8_SCHED;
            PG8_STAGE(PG8_SB(1, 1), b3 + hstep, voffB);
            PG8_WAIT_V(6); PG8_BAR; PG8_MMA(1, 1, At, B1); PG8_BAR;
            }
        }
        if constexpr (ALIGN_EPI) { if (wr == 0) PG8_BAR; }
        if constexpr (!Epi::AFTER_DRAIN) { E(acc, cur, wr, wc, fr, fq); S.done(cur); }
        if (!has_next) break;
#pragma unroll
        for (int a = 0; a < 2; ++a)
#pragma unroll
            for (int b = 0; b < 2; ++b)
#pragma unroll
                for (int m = 0; m < 4; ++m)
#pragma unroll
                    for (int n = 0; n < 2; ++n) acc[a][b][m][n] = (f32x4){0.f, 0.f, 0.f, 0.f};
        cur = nxt; cA = nA; cB = nB; ++ui;
        if constexpr (ALIGN_EPI) { if (wr == 1) PG8_BAR; }
    }
    PG8_WAIT_V(0);
    if constexpr (!ALIGN_EPI) { if (wr == 0) PG8_BAR; }
    PG8_BAR;
    if constexpr (Epi::AFTER_DRAIN) { E.fused(acc, cur, wr, wc, fr, fq, lds, wid, lane); S.done(cur); }
#undef PG8_SA
#undef PG8_SB
#undef PG8_STAGE
#undef PG8_LDA
#undef PG8_LDB
#undef PG8_MMA
#undef PG8_WAIT_V
#undef PG8_WAIT_L
#undef PG8_BAR
#undef PG8_SCHED
}
}


struct Args { const float* in[21]; float* out; unsigned char* ws; int lo, hi; };
enum { I_X = 0, I_MEM, I_WMEMKV, I_AWIN, I_ACONV, I_AWOUT, I_BWIN, I_BWOUT, I_CWIN, I_CPOOLW, I_CPOOLS, I_CWOUT, I_LNG, I_LNB,
       I_FG, I_FU, I_FD, I_ROUTER, I_MG, I_MU, I_MD };
struct Frame { LAS unsigned char* lds; int tid, lane, wave, gw; };

template <int NWM, class Epi>
__device__ __forceinline__ void naive_gemm(const Frame& F, const bf16* A, int lda, const float* W0, const float* W1, int ldw, int M, int N, int K, const Epi& epi, const int* tile_e, size_t wstride) {
    const int lane = F.lane, r16 = lane & 15, q4 = lane >> 4;
    const int tn = N / 32, ntiles = (M / 32) * tn;
    for (int tile = F.gw; tile < ntiles; tile += NGW) {
        const int m0 = (tile / tn) * 32, n0 = (tile % tn) * 32;
        size_t woff = 0;
        if (tile_e) woff = (size_t)ld_i32_agent(tile_e + (m0 >> 8)) * wstride;
        const float* w0 = W0 + woff; const float* w1 = (NWM == 2) ? W1 + woff : nullptr;
        f32x4 acc[NWM][2][2];
#pragma unroll
        for (int w = 0; w < NWM; ++w)
#pragma unroll
            for (int i = 0; i < 2; ++i)
#pragma unroll
                for (int j = 0; j < 2; ++j) acc[w][i][j] = (f32x4){0.f, 0.f, 0.f, 0.f};
        for (int k0 = 0; k0 < K; k0 += 32) {
            bf16x8 a[2], b[NWM][2];
#pragma unroll
            for (int i = 0; i < 2; ++i) a[i] = *(const bf16x8*)(A + (size_t)(m0 + 16 * i + r16) * lda + k0 + 8 * q4);
#pragma unroll
            for (int w = 0; w < NWM; ++w)
#pragma unroll
                for (int jn = 0; jn < 2; ++jn) {
                    const float* wp = (w == 0 ? w0 : w1) + (size_t)(k0 + 8 * q4) * ldw + n0 + 16 * jn + r16;
#pragma unroll
                    for (int j = 0; j < 8; ++j) b[w][jn][j] = (short)f2bf(wp[(size_t)j * ldw]);
                }
#pragma unroll
            for (int w = 0; w < NWM; ++w)
#pragma unroll
                for (int i = 0; i < 2; ++i)
#pragma unroll
                    for (int jn = 0; jn < 2; ++jn) acc[w][i][jn] = __builtin_amdgcn_mfma_f32_16x16x32_bf16(a[i], b[w][jn], acc[w][i][jn], 0, 0, 0);
        }
#pragma unroll
        for (int i = 0; i < 2; ++i)
#pragma unroll
            for (int jn = 0; jn < 2; ++jn)
#pragma unroll
                for (int r = 0; r < 4; ++r) {
                    const int row = m0 + 16 * i + q4 * 4 + r, col = n0 + 16 * jn + r16;
                    if constexpr (NWM == 2) epi(row, col, acc[0][i][jn][r], acc[1][i][jn][r]); else epi(row, col, acc[0][i][jn][r], 0.f);
                }
    }
}
struct NEpiBf16 { bf16* O; int ldo; __device__ __forceinline__ void operator()(int r, int c, float v, float) const { O[(size_t)r * ldo + c] = (bf16)f2bf(v); } };
struct NEpiResid { const float* base; float* out; __device__ __forceinline__ void operator()(int r, int c, float v, float) const { const size_t o = (size_t)r * D + c; out[o] = ALPHA * base[o] + v; } };
struct NEpiSwiglu { bf16* O; int ldo; __device__ __forceinline__ void operator()(int r, int c, float g, float u) const { const float s = g / (1.f + __expf(-g)); O[(size_t)r * ldo + c] = (bf16)f2bf(s * u); } };
struct NEpiScale { bf16* O; int ldo; int coff; const float* scale; __device__ __forceinline__ void operator()(int r, int c, float v, float) const { O[(size_t)r * ldo + coff + c] = (bf16)f2bf(v * scale[coff + c]); } };

__device__ __forceinline__ void prep_phase(const Frame& F, const float* x, const float* mem, bf16* XB, bf16* MEMB) {
    const size_t gt = (size_t)blockIdx.x * NTHREADS + F.tid, NT = (size_t)GRID * NTHREADS;
    for (size_t i = gt; i < (size_t)T * D / 8; i += NT) { const f32x4 a = ((const f32x4*)x)[2 * i], b = ((const f32x4*)x)[2 * i + 1];
        v4u o; o.x = pk2(a.x, a.y); o.y = pk2(a.z, a.w); o.z = pk2(b.x, b.y); o.w = pk2(b.z, b.w); ((v4u*)XB)[i] = o; }
    for (size_t i = gt; i < (size_t)NB * ML * D / 8; i += NT) { const f32x4 a = ((const f32x4*)mem)[2 * i], b = ((const f32x4*)mem)[2 * i + 1];
        v4u o; o.x = pk2(a.x, a.y); o.y = pk2(a.z, a.w); o.z = pk2(b.x, b.y); o.w = pk2(b.z, b.w); ((v4u*)MEMB)[i] = o; }
}
__device__ __forceinline__ void unpack8(const v4u w, float (&f)[8]) { f[0] = bflo(w.x); f[1] = bfhi(w.x); f[2] = bflo(w.y); f[3] = bfhi(w.y); f[4] = bflo(w.z); f[5] = bfhi(w.z); f[6] = bflo(w.w); f[7] = bfhi(w.w); }
__device__ __forceinline__ v4u pack8(const float (&f)[8]) { v4u o; o.x = pk2(f[0], f[1]); o.y = pk2(f[2], f[3]); o.z = pk2(f[4], f[5]); o.w = pk2(f[6], f[7]); return o; }

__device__ __forceinline__ void mixA_phase(const Frame& F, const bf16* H, const float* convw, bf16* CAT) {
    const size_t gt = (size_t)blockIdx.x * NTHREADS + F.tid, NT = (size_t)GRID * NTHREADS;
    for (size_t it = gt; it < (size_t)T * 96; it += NT) {
        const int t = (int)(it / 96), c8 = (int)(it % 96) * 8, s = t & (SEQ - 1);
        const bf16* hr = H + (size_t)t * 2560 + c8;
        float gb[8], z0[8], z1[8], z2[8], a[8], b[8];
        unpack8(*(const v4u*)hr, gb);
        unpack8(*(const v4u*)(hr + 768), a); unpack8(*(const v4u*)(hr + 1536), b);
#pragma unroll
        for (int i = 0; i < 8; ++i) z1[i] = a[i] * b[i];
        if (s > 0) { unpack8(*(const v4u*)(hr - 2560 + 768), a); unpack8(*(const v4u*)(hr - 2560 + 1536), b);
#pragma unroll
            for (int i = 0; i < 8; ++i) z0[i] = a[i] * b[i]; }
        else {
#pragma unroll
            for (int i = 0; i < 8; ++i) z0[i] = 0.f; }
        if (s < SEQ - 1) { unpack8(*(const v4u*)(hr + 2560 + 768), a); unpack8(*(const v4u*)(hr + 2560 + 1536), b);
#pragma unroll
            for (int i = 0; i < 8; ++i) z2[i] = a[i] * b[i]; }
        else {
#pragma unroll
            for (int i = 0; i < 8; ++i) z2[i] = 0.f; }
        float o[8];
#pragma unroll
        for (int i = 0; i < 8; ++i) o[i] = gb[i] * (convw[c8 + i] * z0[i] + convw[768 + c8 + i] * z1[i] + convw[1536 + c8 + i] * z2[i]);
        *(v4u*)(CAT + (size_t)t * 1024 + c8) = pack8(o);
    }
}
__device__ __forceinline__ void poolC_phase(const Frame& F, const bf16* H, bf16* OUT, int ldo) {
    const size_t gt = (size_t)blockIdx.x * NTHREADS + F.tid, NT = (size_t)GRID * NTHREADS;
    for (size_t it = gt; it < (size_t)T * 96; it += NT) {
        const int t = (int)(it / 96), ch = (int)(it % 96), c8 = ch * 8, s = t & (SEQ - 1), g = ch / 24, w = 2 << g;
        int lo = s - w / 2; lo = lo < 0 ? 0 : lo; int hi = s + w / 2 - 1; hi = hi > SEQ - 1 ? SEQ - 1 : hi;
        const bf16* base = H + (size_t)(t - s) * 1024 + c8;
        float acc[8], u[8], v[8];
#pragma unroll
        for (int i = 0; i < 8; ++i) acc[i] = 0.f;
        for (int p = lo; p <= hi; ++p) { unpack8(*(const v4u*)(base + (size_t)p * 1024), v);
#pragma unroll
            for (int i = 0; i < 8; ++i) acc[i] += v[i]; }
        unpack8(*(const v4u*)(base + (size_t)s * 1024), u);
        const float inv = 1.f / (float)(hi - lo + 1);
        float o[8];
#pragma unroll
        for (int i = 0; i < 8; ++i) o[i] = acc[i] * inv - u[i];
        *(v4u*)(OUT + (size_t)t * ldo + c8) = pack8(o);
    }
}


__device__ __forceinline__ void tr_item(const float* W, int N, int k0, int n0, bf16* WT, int ldk, int drow0, LAS float* scr, int lane) {
#pragma unroll 8
    for (int i = 0; i < 32; ++i) { const int kk = 2 * i + (lane >> 5); scr[kk * 33 + (lane & 31)] = W[(size_t)(k0 + kk) * N + n0 + (lane & 31)]; }
    LDS_WAIT(); asm volatile("" ::: "memory");
    const int c = lane & 7;
#pragma unroll
    for (int j = 0; j < 4; ++j) { const int n = (lane >> 3) + 8 * j; const LAS float* sp = scr + (8 * c) * 33 + n;
        v4u o; o.x = pk2(sp[0 * 33], sp[1 * 33]); o.y = pk2(sp[2 * 33], sp[3 * 33]); o.z = pk2(sp[4 * 33], sp[5 * 33]); o.w = pk2(sp[6 * 33], sp[7 * 33]);
        *(v4u*)(WT + (size_t)(drow0 + n) * ldk + k0 + 8 * c) = o; }
    LDS_WAIT(); asm volatile("" ::: "memory");
}
template <int MODE>
__device__ __forceinline__ void tr_matrix(const Frame& F, const float* W, int K, int N, bf16* WT, int ldk, int& rot) {
    LAS float* scr = (LAS float*)(F.lds + F.wave * 16384);
    const int nblk = N / 32, nitems = (K / 64) * nblk;
    for (int it = (F.gw + NGW - (rot % NGW)) % NGW; it < nitems; it += NGW) {
        const int k0 = (it / nblk) * 64, n0 = (it % nblk) * 32;
        const int drow0 = MODE == 0 ? n0 : ((n0 >> 7) * 256 + (n0 & 127) + (MODE == 2 ? 128 : 0));
        tr_item(W, N, k0, n0, WT, ldk, drow0, scr, F.lane);
    }
    rot += nitems;
}
__device__ __forceinline__ void convert_moe(const Frame& F, const float* wg, const float* wu, const float* wd, bf16* WMOE, int& rot) {
#pragma unroll 1
    for (int e = 0; e < NE; ++e) {
        tr_matrix<1>(F, wg + (size_t)e * D * FFE, D, FFE, WMOE + OFF_MGU + (size_t)e * 2 * FFE * D, D, rot);
        tr_matrix<2>(F, wu + (size_t)e * D * FFE, D, FFE, WMOE + OFF_MGU + (size_t)e * 2 * FFE * D, D, rot);
        tr_matrix<0>(F, wd + (size_t)e * FFE * D, FFE, D, WMOE + OFF_MD + (size_t)e * D * FFE, FFE, rot);
    }
}
__device__ __forceinline__ void fold_pool(const Frame& F, const float* pw, const float* ps, const float* wout, bf16* WT) {
    const int item = blockIdx.x * NTHREADS + F.tid;
    if (item < 1024 * 96) {
        const int n = item & 1023, kc = item >> 10, g = kc / 24, c0 = kc * 8 - g * 192;
        float acc[8];
#pragma unroll
        for (int i = 0; i < 8; ++i) acc[i] = 0.f;
        const float* P = pw + (size_t)g * 192 * 192 + (size_t)c0 * 192;
        for (int d = 0; d < 192; ++d) { const float w = wout[(size_t)(g * 192 + d) * D + n] * ps[g * 192 + d];
#pragma unroll
            for (int i = 0; i < 8; ++i) acc[i] += P[i * 192 + d] * w; }
        *(v4u*)(WT + (size_t)n * D + kc * 8) = pack8(acc);
    }
}
__device__ __forceinline__ void convert_small(const Frame& F, const Args& a, bf16* WSM, int& rot) {
    tr_matrix<0>(F, a.in[I_WMEMKV], D, 512, WSM + OFF_WKV, D, rot);
    tr_matrix<0>(F, a.in[I_AWIN], D, 2560, WSM + OFF_AIN, D, rot);
    tr_matrix<0>(F, a.in[I_AWIN] + (size_t)D * 2560, D, 2560, WSM + OFF_AIN + (size_t)2560 * D, D, rot);
    tr_matrix<0>(F, a.in[I_AWOUT], D, D, WSM + OFF_AOUT, D, rot);
    tr_matrix<0>(F, a.in[I_AWOUT] + (size_t)D * D, D, D, WSM + OFF_AOUT + (size_t)D * D, D, rot);
    tr_matrix<0>(F, a.in[I_BWIN], D, 2560, WSM + OFF_BIN, D, rot);
    tr_matrix<0>(F, a.in[I_BWOUT], 512, D, WSM + OFF_BOUT, 512, rot);
    tr_matrix<0>(F, a.in[I_CWIN], D, D, WSM + OFF_CIN, D, rot);
    tr_matrix<0>(F, a.in[I_CWOUT] + (size_t)768 * D, 256, D, WSM + OFF_COUT + 768, D, rot);
#pragma unroll 1
    for (int f = 0; f < 2; ++f) {
        tr_matrix<1>(F, a.in[I_FG] + (size_t)f * D * FF, D, FF, WSM + OFF_FGU + (size_t)f * 2 * FF * D, D, rot);
        tr_matrix<2>(F, a.in[I_FU] + (size_t)f * D * FF, D, FF, WSM + OFF_FGU + (size_t)f * 2 * FF * D, D, rot);
        tr_matrix<0>(F, a.in[I_FD] + (size_t)f * FF * D, FF, D, WSM + OFF_FD + (size_t)f * D * FF, FF, rot);
    }
}

template <bool ROUTER, bool COMBINE>
__device__ __forceinline__ void ln_phase(const Frame& F, float* XR, bf16* XB, const float* g, const float* b, const float* router, int* E01, float* W01, const int* DEST, const bf16* YB, int* cntWG) {
    LAS int* cntL = (LAS int*)F.lds;
    if (ROUTER) { if (F.tid < 8) cntL[F.tid] = 0; __syncthreads(); }
    f32x4 gv[4], bv[4];
#pragma unroll
    for (int j = 0; j < 4; ++j) { gv[j] = ((const f32x4*)g)[F.lane + 64 * j]; bv[j] = ((const f32x4*)b)[F.lane + 64 * j]; }
    for (int i = 0; i < 16; ++i) {
        const int t = blockIdx.x * 128 + F.wave * 16 + i;
        f32x4* xr = (f32x4*)(XR + (size_t)t * D) + F.lane;
        f32x4 v[4]; float s = 0.f;
#pragma unroll
        for (int j = 0; j < 4; ++j) v[j] = xr[64 * j];
        if (COMBINE) {
            const int d0 = ld_i32_agent(DEST + 2 * t), d1 = ld_i32_agent(DEST + 2 * t + 1);
            const float w0 = ld_f32_agent(W01 + 2 * t), w1 = ld_f32_agent(W01 + 2 * t + 1);
            const v2u* y0 = (const v2u*)(YB + (size_t)d0 * D) + F.lane; const v2u* y1 = (const v2u*)(YB + (size_t)d1 * D) + F.lane;
#pragma unroll
            for (int j = 0; j < 4; ++j) { const v2u a = y0[64 * j], c = y1[64 * j];
                v[j].x = ALPHA * v[j].x + w0 * bflo(a.x) + w1 * bflo(c.x); v[j].y = ALPHA * v[j].y + w0 * bfhi(a.x) + w1 * bfhi(c.x);
                v[j].z = ALPHA * v[j].z + w0 * bflo(a.y) + w1 * bflo(c.y); v[j].w = ALPHA * v[j].w + w0 * bfhi(a.y) + w1 * bfhi(c.y); }
        }
#pragma unroll
        for (int j = 0; j < 4; ++j) s += (v[j].x + v[j].y) + (v[j].z + v[j].w);
        const float mean = wave_sum(s) * (1.f / D); float s2 = 0.f;
#pragma unroll
        for (int j = 0; j < 4; ++j) { v[j] = v[j] - mean; s2 += (v[j].x * v[j].x + v[j].y * v[j].y) + (v[j].z * v[j].z + v[j].w * v[j].w); }
        const float rstd = 1.f / sqrtf(wave_sum(s2) * (1.f / D) + LN_EPS);
        v2u* o8 = (v2u*)(XB + (size_t)t * D) + F.lane;
#pragma unroll
        for (int j = 0; j < 4; ++j) { v[j] = v[j] * rstd * gv[j] + bv[j]; xr[64 * j] = v[j]; v2u o; o.x = pk2(v[j].x, v[j].y); o.y = pk2(v[j].z, v[j].w); o8[64 * j] = o; }
        if (ROUTER) {
            float lg[8];
#pragma unroll
            for (int e = 0; e < 8; ++e) lg[e] = 0.f;
#pragma unroll
            for (int j = 0; j < 4; ++j)
#pragma unroll
                for (int q = 0; q < 4; ++q) { const int c = 4 * F.lane + 256 * j + q; const f32x4 r0 = ((const f32x4*)router)[2 * c], r1 = ((const f32x4*)router)[2 * c + 1]; const float xv = v[j][q];
                    lg[0] += xv * r0.x; lg[1] += xv * r0.y; lg[2] += xv * r0.z; lg[3] += xv * r0.w; lg[4] += xv * r1.x; lg[5] += xv * r1.y; lg[6] += xv * r1.z; lg[7] += xv * r1.w; }
#pragma unroll
            for (int e = 0; e < 8; ++e) lg[e] = wave_sum(lg[e]);
            float b0 = lg[0]; int i0 = 0;
#pragma unroll
            for (int e = 1; e < 8; ++e) if (lg[e] > b0) { b0 = lg[e]; i0 = e; }
            float b1 = -3.0e38f; int i1 = 0;
#pragma unroll
            for (int e = 0; e < 8; ++e) if (e != i0 && lg[e] > b1) { b1 = lg[e]; i1 = e; }
            const float w0 = 1.f / (1.f + __expf(b1 - b0));
            if (F.lane == 0) { E01[2 * t] = i0; E01[2 * t + 1] = i1; W01[2 * t] = w0; W01[2 * t + 1] = 1.f - w0; __hip_atomic_fetch_add(&cntL[i0], 1, __ATOMIC_RELAXED, __HIP_MEMORY_SCOPE_WORKGROUP); __hip_atomic_fetch_add(&cntL[i1], 1, __ATOMIC_RELAXED, __HIP_MEMORY_SCOPE_WORKGROUP); }
        }
    }
    if (ROUTER) { __syncthreads(); if (F.tid < 8) cntWG[blockIdx.x * 8 + F.tid] = cntL[F.tid]; }
}
__device__ __forceinline__ void scatter_phase(const Frame& F, const int* cntWG, const int* E01, int* DEST, const bf16* XB, bf16* XS, int* tile_e, int* nMp) {
    LAS int* L = (LAS int*)F.lds;
    if (F.tid < 8) { int tot = 0, base = 0; for (int w = 0; w < GRID; ++w) { const int c = ld_i32_agent(cntWG + w * 8 + F.tid); if (w < (int)blockIdx.x) base += c; tot += c; } L[F.tid] = base; L[8 + F.tid] = tot; }
    __syncthreads();
    if (F.tid == 0) { int ps = 0; for (int e = 0; e < 8; ++e) { L[16 + e] = ps; ps += (L[8 + e] + 255) / 256 * 256; } L[24] = ps; }
    __syncthreads();
    if (F.wave == 0) {
        const int tA = blockIdx.x * 128 + F.lane, tB = tA + 64;
        const int eA0 = ld_i32_agent(E01 + 2 * tA), eA1 = ld_i32_agent(E01 + 2 * tA + 1), eB0 = ld_i32_agent(E01 + 2 * tB), eB1 = ld_i32_agent(E01 + 2 * tB + 1);
        const unsigned long long lt = (1ull << F.lane) - 1ull;
        int dA0 = 0, dA1 = 0, dB0 = 0, dB1 = 0;
        for (int e = 0; e < 8; ++e) {
            const unsigned long long mA0 = __ballot(eA0 == e), mA1 = __ballot(eA1 == e), mB0 = __ballot(eB0 == e), mB1 = __ballot(eB1 == e);
            const int start = L[16 + e] + L[e];
            const int cA = __popcll(mA0 & lt) + __popcll(mA1 & lt), totA = __popcll(mA0) + __popcll(mA1), cB = totA + __popcll(mB0 & lt) + __popcll(mB1 & lt);
            if (eA0 == e) dA0 = start + cA; if (eA1 == e) dA1 = start + cA;
            if (eB0 == e) dB0 = start + cB; if (eB1 == e) dB1 = start + cB;
        }
        DEST[2 * tA] = dA0; DEST[2 * tA + 1] = dA1; DEST[2 * tB] = dB0; DEST[2 * tB + 1] = dB1;
        L[32 + 2 * F.lane] = dA0; L[32 + 2 * F.lane + 1] = dA1; L[32 + 2 * (F.lane + 64)] = dB0; L[32 + 2 * (F.lane + 64) + 1] = dB1;
    }
    __syncthreads();
    for (int i = 0; i < 16; ++i) {
        const int tl = F.wave * 16 + i, t = blockIdx.x * 128 + tl;
        const v4u* src = (const v4u*)(XB + (size_t)t * D) + F.lane; const v4u a = src[0], b = src[64];
#pragma unroll
        for (int k = 0; k < 2; ++k) { v4u* dst = (v4u*)(XS + (size_t)L[32 + 2 * tl + k] * D) + F.lane; dst[0] = a; dst[64] = b; }
    }
    if (blockIdx.x == 0) {
        const int nM = L[24] / 256;
        for (int i = F.tid; i < nM; i += NTHREADS) { int e = 0;
#pragma unroll
            for (int q = 1; q < 8; ++q) if (i * 256 >= L[16 + q]) e = q;
            tile_e[i] = e; }
        if (F.tid == 0) *nMp = nM;
    }
    __syncthreads();
}

__device__ __forceinline__ void memattn_naive(const Frame& F, const bf16* H, int ldh, int qoff, const bf16* MEMKV, bf16* CAT, int ldc, int coff) {
    const size_t gt = (size_t)blockIdx.x * NTHREADS + F.tid, NT = (size_t)GRID * NTHREADS;
    for (size_t it = gt; it < (size_t)T * 4; it += NT) {
        const int t = (int)(it >> 2), h = (int)(it & 3), bb = t / SEQ;
        float q[64], o[64];
#pragma unroll
        for (int c = 0; c < 8; ++c) { float f[8]; unpack8(*(const v4u*)(H + (size_t)t * ldh + qoff + 64 * h + 8 * c), f);
#pragma unroll
            for (int i = 0; i < 8; ++i) { q[8 * c + i] = f[i] * 0.125f; o[8 * c + i] = 0.f; } }
        float m = -3.0e38f, l = 0.f;
        for (int k = 0; k < ML; ++k) {
            const bf16* kr = MEMKV + (size_t)(bb * ML + k) * 512 + 64 * h;
            float sc = 0.f;
#pragma unroll
            for (int c = 0; c < 8; ++c) { float f[8]; unpack8(*(const v4u*)(kr + 8 * c), f);
#pragma unroll
                for (int i = 0; i < 8; ++i) sc += q[8 * c + i] * f[i]; }
            const float mn = fmaxf(m, sc), al = __expf(m - mn), p = __expf(sc - mn);
            l = l * al + p; m = mn;
#pragma unroll
            for (int c = 0; c < 8; ++c) { float f[8]; unpack8(*(const v4u*)(kr + 256 + 8 * c), f);
#pragma unroll
                for (int i = 0; i < 8; ++i) o[8 * c + i] = o[8 * c + i] * al + p * f[i]; }
        }
        const float inv = 1.f / l;
#pragma unroll
        for (int c = 0; c < 8; ++c) { float f[8];
#pragma unroll
            for (int i = 0; i < 8; ++i) f[i] = o[8 * c + i] * inv;
            *(v4u*)(CAT + (size_t)t * ldc + coff + 64 * h + 8 * c) = pack8(f); }
    }
}
__device__ __forceinline__ void dilattn_naive(const Frame& F, const bf16* H, bf16* CAT, int ldc) {
    const size_t gt = (size_t)blockIdx.x * NTHREADS + F.tid, NT = (size_t)GRID * NTHREADS;
    for (size_t it = gt; it < (size_t)T * 4; it += NT) {
        const int t = (int)(it >> 2), h = (int)(it & 3), s = t & (SEQ - 1);
        float q[64], o[64];
#pragma unroll
        for (int i = 0; i < 64; ++i) o[i] = 0.f;
        float m = -3.0e38f, l = 0.f;
        for (int g = 0; g < 3; ++g) {
            const int dl = 1 << (2 * g), nsub = SEQ / dl, j = s / dl, r = s % dl;
            const float slope = exp2f(-8.f * (float)(4 * g + h + 1) / 12.f) * (float)dl;
#pragma unroll
            for (int c = 0; c < 8; ++c) { float f[8]; unpack8(*(const v4u*)(H + (size_t)t * 2560 + 256 * g + 64 * h + 8 * c), f);
#pragma unroll
                for (int i = 0; i < 8; ++i) q[8 * c + i] = f[i] * 0.125f; }
            const int jlo = j - 64 < 0 ? 0 : j - 64, jhi = j + 64 > nsub - 1 ? nsub - 1 : j + 64;
            for (int jj = jlo; jj <= jhi; ++jj) {
                const bf16* kr = H + (size_t)(t - s + jj * dl + r) * 2560 + 768 + 256 * g + 64 * h;
                float sc = 0.f;
#pragma unroll
                for (int c = 0; c < 8; ++c) { float f[8]; unpack8(*(const v4u*)(kr + 8 * c), f);
#pragma unroll
                    for (int i = 0; i < 8; ++i) sc += q[8 * c + i] * f[i]; }
                const int ad = jj > j ? jj - j : j - jj;
                sc -= slope * (float)ad;
                const float mn = fmaxf(m, sc), al = __expf(m - mn), p = __expf(sc - mn);
                l = l * al + p; m = mn;
#pragma unroll
                for (int c = 0; c < 8; ++c) { float f[8]; unpack8(*(const v4u*)(kr + 768 + 8 * c), f);
#pragma unroll
                    for (int i = 0; i < 8; ++i) o[8 * c + i] = o[8 * c + i] * al + p * f[i]; }
            }
        }
        const float inv = 1.f / l;
#pragma unroll
        for (int c = 0; c < 8; ++c) { float f[8];
#pragma unroll
            for (int i = 0; i < 8; ++i) f[i] = o[8 * c + i] * inv;
            *(v4u*)(CAT + (size_t)t * ldc + 64 * h + 8 * c) = pack8(f); }
    }
}

constexpr int NPHASE = 34;
__global__ void __launch_bounds__(NTHREADS, 2) mega(Args args) {
    extern __shared__ __attribute__((aligned(16))) unsigned char lds[];
    Frame F; F.lds = (LAS unsigned char*)lds; F.tid = threadIdx.x; F.lane = F.tid & 63; F.wave = __builtin_amdgcn_readfirstlane(F.tid >> 6); F.gw = blockIdx.x * NWAVES + F.wave;
    volatile LAS unsigned* MISC = (volatile LAS unsigned*)(F.lds + MISC_OFF);
    unsigned char* ws = args.ws;
    unsigned* ctl = (unsigned*)(ws + WS_CTL);
    for (int u = F.tid; u < (LDS_BYTES - LDSCTL_OFF) / 4; u += NTHREADS) ((LAS unsigned*)(F.lds + LDSCTL_OFF))[u] = 0u;
    __syncthreads();
    const int lo = args.lo, hi = args.hi;
    XcdBarrier bar; bar.bar = ctl + CW_BAR; bar.x = 0; bar.st = nullptr;
    if (hi - lo > 1) bar = xcd_barrier_post(ctl + CW_BAR, MISC + 8);
#define IN(k) (lo <= (k) && (k) < hi)
#define SEAM(k) do { if (IN(k) && IN((k) + 1)) xcd_barrier(bar); else __syncthreads(); } while (0)
    const float* x_in = args.in[I_X]; float* XR = args.out;
    int* cntWG = (int*)(ws + WS_META); int* tile_e = (int*)(ws + WS_META + 16384); int* nMp = (int*)(ws + WS_META + 32768);
    int* E01 = (int*)(ws + WS_TOK); float* W01 = (float*)(ws + WS_TOK + 262144); int* DEST = (int*)(ws + WS_TOK + 524288);
    bf16* XB = (bf16*)(ws + WS_XB); bf16* MEMB = (bf16*)(ws + WS_MEMB); bf16* MEMKV = (bf16*)(ws + WS_MEMKV);
    bf16* Hb = (bf16*)(ws + WS_SCR + SC_H); bf16* CAT = (bf16*)(ws + WS_SCR + SC_CAT); bf16* DIFF = (bf16*)(ws + WS_SCR + SC_DIFF);
    bf16* HID = (bf16*)(ws + WS_SCR + SC_HID); bf16* XS = (bf16*)(ws + WS_SCR + SC_XS); bf16* HS = (bf16*)(ws + WS_SCR + SC_HS); bf16* YB = XS;
    const float* ln_g = args.in[I_LNG]; const float* ln_b = args.in[I_LNB];

    bf16* WSM = (bf16*)(ws + WS_WS); bf16* WMOE = (bf16*)(ws + WS_WMOE);
#if FAST_GEMM
#define GEMM_BF16(A_, B_, M_, N_, K_, O_) do { pg8::Gemm g_{A_, B_, M_, N_, K_}; pg8::StaticOrder S_; S_.init(M_, N_, GRID, (int)blockIdx.x); pg8::EpiBf16<0> E_{O_, N_, nullptr, 0, 0, 1.f}; \
        pg8::gemm_phase<pg8::EpiBf16<0>, pg8::StaticOrder, true, true>(F.lds, g_, S_, E_); } while (0)
#define GEMM_RESID(A_, B_, K_, BASE_) do { pg8::Gemm g_{A_, B_, T, D, K_}; pg8::StaticOrder S_; S_.init(T, D, GRID, (int)blockIdx.x); pg8::EpiResid E_{BASE_, XR, D, ALPHA}; \
        pg8::gemm_phase<pg8::EpiResid, pg8::StaticOrder, true, true>(F.lds, g_, S_, E_); } while (0)
#define GEMM_SWIGLU(A_, B_, M_, NH_, O_) do { pg8::Gemm g_{A_, B_, M_, 2 * (NH_), D}; pg8::StaticOrder S_; S_.init(M_, 2 * (NH_), GRID, (int)blockIdx.x); pg8::EpiSwiglu E_{O_, NH_}; \
        pg8::gemm_phase<pg8::EpiSwiglu, pg8::StaticOrder, true, true>(F.lds, g_, S_, E_); } while (0)
#define GEMM_MOE_GU() do { const int nM_ = ld_i32_agent(nMp); pg8::Gemm g_{XS, WMOE + OFF_MGU, nM_ * 256, 2 * FFE, D}; pg8::MoeOrder S_; S_.init(nM_ * 256, 2 * FFE, GRID, (int)blockIdx.x); S_.tile_e = tile_e; S_.estride = (size_t)2 * FFE * D; \
        pg8::EpiSwiglu E_{HS, FFE}; pg8::gemm_phase<pg8::EpiSwiglu, pg8::MoeOrder, true, true>(F.lds, g_, S_, E_); } while (0)
#define GEMM_MOE_D() do { const int nM_ = ld_i32_agent(nMp); pg8::Gemm g_{HS, WMOE + OFF_MD, nM_ * 256, D, FFE}; pg8::MoeOrder S_; S_.init(nM_ * 256, D, GRID, (int)blockIdx.x); S_.tile_e = tile_e; S_.estride = (size_t)D * FFE; \
        pg8::EpiBf16<0> E_{YB, D, nullptr, 0, 0, 1.f}; pg8::gemm_phase<pg8::EpiBf16<0>, pg8::MoeOrder, true, true>(F.lds, g_, S_, E_); } while (0)
#endif

    if (IN(0)) { prep_phase(F, x_in, args.in[I_MEM], XB, MEMB);
#if FAST_GEMM
        { int rot = 0; convert_small(F, args, WSM, rot); convert_moe(F, args.in[I_MG], args.in[I_MU], args.in[I_MD], WMOE, rot); fold_pool(F, args.in[I_CPOOLW], args.in[I_CPOOLS], args.in[I_CWOUT], WSM + OFF_COUT); }
#endif
        SEAM(0); }
    if (IN(1)) {
#if FAST_GEMM
        GEMM_BF16(MEMB, WSM + OFF_WKV, NB * ML, 512, D, MEMKV);
#else
        naive_gemm<1>(F, MEMB, D, args.in[I_WMEMKV], nullptr, 512, NB * ML, 512, D, NEpiBf16{MEMKV, 512}, nullptr, 0);
#endif
        SEAM(1); }

    if (IN(2)) {
#if FAST_GEMM
        GEMM_BF16(XB, WSM + OFF_AIN, T, 2560, D, Hb);
#else
        naive_gemm<1>(F, XB, D, args.in[I_AWIN], nullptr, 2560, T, 2560, D, NEpiBf16{Hb, 2560}, nullptr, 0);
#endif
        SEAM(2); }
    if (IN(3)) { mixA_phase(F, Hb, args.in[I_ACONV], CAT); memattn_naive(F, Hb, 2560, 2304, MEMKV, CAT, 1024, 768); SEAM(3); }
    if (IN(4)) {
#if FAST_GEMM
        GEMM_RESID(CAT, WSM + OFF_AOUT, 1024, x_in);
#else
        naive_gemm<1>(F, CAT, 1024, args.in[I_AWOUT], nullptr, D, T, D, 1024, NEpiResid{x_in, XR}, nullptr, 0);
#endif
        SEAM(4); }
    if (IN(5)) { ln_phase<false, false>(F, XR, XB, ln_g + 0 * D, ln_b + 0 * D, nullptr, nullptr, nullptr, nullptr, nullptr, nullptr); SEAM(5); }
    if (IN(6)) {
#if FAST_GEMM
        GEMM_SWIGLU(XB, WSM + OFF_FGU, T, FF, HID);
#else
        naive_gemm<2>(F, XB, D, args.in[I_FG], args.in[I_FU], FF, T, FF, D, NEpiSwiglu{HID, FF}, nullptr, 0);
#endif
        SEAM(6); }
    if (IN(7)) {
#if FAST_GEMM
        GEMM_RESID(HID, WSM + OFF_FD, FF, XR);
#else
        naive_gemm<1>(F, HID, FF, args.in[I_FD], nullptr, D, T, D, FF, NEpiResid{XR, XR}, nullptr, 0);
#endif
        SEAM(7); }
    if (IN(8)) { ln_phase<false, false>(F, XR, XB, ln_g + 1 * D, ln_b + 1 * D, nullptr, nullptr, nullptr, nullptr, nullptr, nullptr); SEAM(8); }

    if (IN(9)) {
#if FAST_GEMM
        GEMM_BF16(XB, WSM + OFF_BIN, T, 2560, D, Hb);
#else
        naive_gemm<1>(F, XB, D, args.in[I_BWIN], nullptr, 2560, T, 2560, D, NEpiBf16{Hb, 2560}, nullptr, 0);
#endif
        SEAM(9); }
    if (IN(10)) { dilattn_naive(F, Hb, CAT, 512); memattn_naive(F, Hb, 2560, 2304, MEMKV, CAT, 512, 256); SEAM(10); }
    if (IN(11)) { SEAM(11); }
    if (IN(12)) {
#if FAST_GEMM
        GEMM_RESID(CAT, WSM + OFF_BOUT, 512, XR);
#else
        naive_gemm<1>(F, CAT, 512, args.in[I_BWOUT], nullptr, D, T, D, 512, NEpiResid{XR, XR}, nullptr, 0);
#endif
        SEAM(12); }
    if (IN(13)) { ln_phase<true, false>(F, XR, XB, ln_g + 2 * D, ln_b + 2 * D, args.in[I_ROUTER], E01, W01, nullptr, nullptr, cntWG); SEAM(13); }
    if (IN(14)) { scatter_phase(F, cntWG, E01, DEST, XB, XS, tile_e, nMp); SEAM(14); }
    if (IN(15)) {
#if FAST_GEMM
        GEMM_MOE_GU();
#else
        const int nM = ld_i32_agent(nMp); naive_gemm<2>(F, XS, D, args.in[I_MG], args.in[I_MU], FFE, nM * 256, FFE, D, NEpiSwiglu{HS, FFE}, tile_e, (size_t)D * FFE);
#endif
        SEAM(15); }
    if (IN(16)) {
#if FAST_GEMM
        GEMM_MOE_D();
#else
        const int nM = ld_i32_agent(nMp); naive_gemm<1>(F, HS, FFE, args.in[I_MD], nullptr, D, nM * 256, D, FFE, NEpiBf16{YB, D}, tile_e, (size_t)FFE * D);
#endif
        SEAM(16); }
    if (IN(17)) { ln_phase<false, true>(F, XR, XB, ln_g + 3 * D, ln_b + 3 * D, nullptr, nullptr, W01, DEST, YB, nullptr); SEAM(17); }

    if (IN(18)) {
#if FAST_GEMM
        GEMM_BF16(XB, WSM + OFF_CIN, T, 1024, D, Hb);
#else
        naive_gemm<1>(F, XB, D, args.in[I_CWIN], nullptr, 1024, T, 1024, D, NEpiBf16{Hb, 1024}, nullptr, 0);
#endif
        SEAM(18); }
#if FAST_GEMM
    if (IN(19)) { poolC_phase(F, Hb, CAT, 1024); memattn_naive(F, Hb, 1024, 768, MEMKV, CAT, 1024, 768);
        { int rot = 0; convert_moe(F, args.in[I_MG] + (size_t)NE * D * FFE, args.in[I_MU] + (size_t)NE * D * FFE, args.in[I_MD] + (size_t)NE * FFE * D, WMOE, rot); }
        SEAM(19); }
    if (IN(20)) { SEAM(20); }
#else
    if (IN(19)) { poolC_phase(F, Hb, DIFF, 768); memattn_naive(F, Hb, 1024, 768, MEMKV, CAT, 1024, 768); SEAM(19); }
    if (IN(20)) {
#pragma unroll 1
        for (int g = 0; g < 4; ++g) naive_gemm<1>(F, DIFF + 192 * g, 768, args.in[I_CPOOLW] + (size_t)g * 192 * 192, nullptr, 192, T, 192, 192, NEpiScale{CAT, 1024, 192 * g, args.in[I_CPOOLS]}, nullptr, 0);
        SEAM(20); }
#endif
    if (IN(21)) {
#if FAST_GEMM
        GEMM_RESID(CAT, WSM + OFF_COUT, 1024, XR);
#else
        naive_gemm<1>(F, CAT, 1024, args.in[I_CWOUT], nullptr, D, T, D, 1024, NEpiResid{XR, XR}, nullptr, 0);
#endif
        SEAM(21); }
    if (IN(22)) { ln_phase<false, false>(F, XR, XB, ln_g + 4 * D, ln_b + 4 * D, nullptr, nullptr, nullptr, nullptr, nullptr, nullptr); SEAM(22); }
    if (IN(23)) {
#if FAST_GEMM
        GEMM_SWIGLU(XB, WSM + OFF_FGU + (size_t)2 * FF * D, T, FF, HID);
#else
        naive_gemm<2>(F, XB, D, args.in[I_FG] + (size_t)D * FF, args.in[I_FU] + (size_t)D * FF, FF, T, FF, D, NEpiSwiglu{HID, FF}, nullptr, 0);
#endif
        SEAM(23); }
    if (IN(24)) {
#if FAST_GEMM
        GEMM_RESID(HID, WSM + OFF_FD + (size_t)D * FF, FF, XR);
#else
        naive_gemm<1>(F, HID, FF, args.in[I_FD] + (size_t)FF * D, nullptr, D, T, D, FF, NEpiResid{XR, XR}, nullptr, 0);
#endif
        SEAM(24); }
    if (IN(25)) { ln_phase<false, false>(F, XR, XB, ln_g + 5 * D, ln_b + 5 * D, nullptr, nullptr, nullptr, nullptr, nullptr, nullptr); SEAM(25); }

    if (IN(26)) {
#if FAST_GEMM
        GEMM_BF16(XB, WSM + OFF_AIN + (size_t)2560 * D, T, 2560, D, Hb);
#else
        naive_gemm<1>(F, XB, D, args.in[I_AWIN] + (size_t)D * 2560, nullptr, 2560, T, 2560, D, NEpiBf16{Hb, 2560}, nullptr, 0);
#endif
        SEAM(26); }
    if (IN(27)) { mixA_phase(F, Hb, args.in[I_ACONV] + 3 * 768, CAT); memattn_naive(F, Hb, 2560, 2304, MEMKV, CAT, 1024, 768); SEAM(27); }
    if (IN(28)) {
#if FAST_GEMM
        GEMM_RESID(CAT, WSM + OFF_AOUT + (size_t)D * D, 1024, XR);
#else
        naive_gemm<1>(F, CAT, 1024, args.in[I_AWOUT] + (size_t)D * D, nullptr, D, T, D, 1024, NEpiResid{XR, XR}, nullptr, 0);
#endif
        SEAM(28); }
    if (IN(29)) { ln_phase<true, false>(F, XR, XB, ln_g + 6 * D, ln_b + 6 * D, args.in[I_ROUTER] + D * NE, E01, W01, nullptr, nullptr, cntWG); SEAM(29); }
    if (IN(30)) { scatter_phase(F, cntWG, E01, DEST, XB, XS, tile_e, nMp); SEAM(30); }
    if (IN(31)) {
#if FAST_GEMM
        GEMM_MOE_GU();
#else
        const int nM = ld_i32_agent(nMp); naive_gemm<2>(F, XS, D, args.in[I_MG] + (size_t)NE * D * FFE, args.in[I_MU] + (size_t)NE * D * FFE, FFE, nM * 256, FFE, D, NEpiSwiglu{HS, FFE}, tile_e, (size_t)D * FFE);
#endif
        SEAM(31); }
    if (IN(32)) {
#if FAST_GEMM
        GEMM_MOE_D();
#else
        const int nM = ld_i32_agent(nMp); naive_gemm<1>(F, HS, FFE, args.in[I_MD] + (size_t)NE * FFE * D, nullptr, D, nM * 256, D, FFE, NEpiBf16{YB, D}, tile_e, (size_t)FFE * D);
#endif
        SEAM(32); }
    if (IN(33)) { ln_phase<false, true>(F, XR, XB, ln_g + 7 * D, ln_b + 7 * D, nullptr, nullptr, W01, DEST, YB, nullptr); }
#undef IN
#undef SEAM
}

extern "C" void kernel_launch(void* const* d_in, const int* in_sizes, int n_in, void* d_out, int out_size, void* d_ws, size_t ws_size, hipStream_t stream) {
    static int ok = 0;
    if (ok == 0) {
        ok = 1;
        if (n_in != 21 || out_size != T * D || ws_size < WS_END) { fprintf(stderr, "kernel_launch: unexpected shapes (n_in %d, out %d, ws %zu < %zu)\n", n_in, out_size, ws_size, (size_t)WS_END); ok = -1; }
        if (ok > 0 && hipFuncSetAttribute((const void*)mega, hipFuncAttributeMaxDynamicSharedMemorySize, LDS_BYTES) != hipSuccess) { fprintf(stderr, "kernel_launch: hipFuncSetAttribute failed\n"); ok = -1; }
        int dev = 0, cus = 0; (void)hipGetDevice(&dev); (void)hipDeviceGetAttribute(&cus, hipDeviceAttributeMultiprocessorCount, dev);
        if (cus < GRID) { fprintf(stderr, "kernel_launch: %d CUs < %d\n", cus, GRID); ok = -1; }
        (void)hipGetLastError();
    }
    if (ok < 0) return;
    (void)hipMemsetAsync((char*)d_ws + WS_CTL, 0, CTL_ZERO_BYTES, stream);
    Args a{};
    for (int i = 0; i < 21; ++i) a.in[i] = (const float*)d_in[i];
    a.out = (float*)d_out; a.ws = (unsigned char*)d_ws;
#if MK_ONE_LAUNCH
    a.lo = 0; a.hi = NPHASE;
    hipLaunchKernelGGL(mega, dim3(GRID), dim3(NTHREADS), LDS_BYTES, stream, a);
#else
    for (int p = 0; p < NPHASE; ++p) { if (p == 11) continue; a.lo = p; a.hi = p + 1; hipLaunchKernelGGL(mega, dim3(GRID), dim3(NTHREADS), LDS_BYTES, stream, a); }
#endif
}
```

```cpp
#include <hip/hip_runtime.h>
#include <cstdio>
#include <cstdint>

#ifndef MK_ONE_LAUNCH
#define MK_ONE_LAUNCH 1
#endif
#ifndef FAST_GEMM
#define FAST_GEMM 1
#endif
#ifndef FAST_ATTN
#define FAST_ATTN 1
#endif

#define GAS __attribute__((address_space(1)))
#define LAS __attribute__((address_space(3)))
typedef unsigned short bf16;
typedef unsigned v4u __attribute__((ext_vector_type(4)));
typedef unsigned v2u __attribute__((ext_vector_type(2)));
typedef float f32x4 __attribute__((ext_vector_type(4)));
typedef float f32x2 __attribute__((ext_vector_type(2)));
typedef float f32x16 __attribute__((ext_vector_type(16)));
typedef short bf16x8 __attribute__((ext_vector_type(8)));
typedef short s16x4 __attribute__((ext_vector_type(4)));
#define RLX_AGENT __ATOMIC_RELAXED, __HIP_MEMORY_SCOPE_AGENT
#define LDS_WAIT() asm volatile("s_waitcnt lgkmcnt(0)" ::: "memory")
#define VM_WAIT() asm volatile("s_waitcnt vmcnt(0)" ::: "memory")

constexpr int NB = 16, SEQ = 2048, T = NB * SEQ, D = 1024, ML = 256, MEMW = 256, MIXW = 768, HD = 64;
constexpr int FF = 2816, FFE = 3584, NE = 8;
constexpr int RMAX = (2 * T / 256 + NE) * 256;
constexpr float ALPHA = 1.6817928305074290f;
constexpr float LN_EPS = 1e-5f;
constexpr int NWAVES = 8, NTHREADS = 512, GRID = 256, NGW = GRID * NWAVES;

constexpr size_t MiB = 1u << 20;
constexpr size_t WS_CTL = 0, CTL_ZERO_BYTES = 1 * MiB;
constexpr size_t WS_META = 1 * MiB;
constexpr size_t WS_TOK = 2 * MiB;
constexpr size_t WS_WS = 4 * MiB;
constexpr size_t WS_WMOE = 64 * MiB;
constexpr size_t WS_XB = 232 * MiB;
constexpr size_t WS_MEMB = 296 * MiB;
constexpr size_t WS_MEMKV = 304 * MiB;
constexpr size_t WS_SCR = 308 * MiB;
constexpr size_t SC_H = 0, SC_CAT = 160 * MiB, SC_OG = 224 * MiB, SC_LSE = 320 * MiB, SC_DIFF = 224 * MiB;
constexpr size_t SC_HID = 0;
constexpr size_t SC_XS = 0, SC_HS = 132 * MiB;
constexpr size_t WS_END = WS_SCR + SC_HS + (size_t)RMAX * FFE * 2;
static_assert(WS_END <= 903 * MiB, "ws map");
constexpr size_t OFF_WKV = 0, OFF_AIN = 524288, OFF_AOUT = 5767168, OFF_BIN = 7864320, OFF_BOUT = 10485760, OFF_CIN = 11010048,
                 OFF_COUT = 12058624, OFF_FGU = 13107200, OFF_FD = 24641536, OFF_WS_END = 30408704;
static_assert(OFF_WS_END * 2 <= 60 * MiB, "small weights");
constexpr size_t OFF_MGU = 0, OFF_MD = (size_t)NE * 2 * FFE * D;
constexpr int CW_BAR = 4096;

constexpr int RING_BYTES = 131072, LDSCTL_OFF = RING_BYTES, MISC_OFF = LDSCTL_OFF + 320, LDS_BYTES = 147456;

__device__ __forceinline__ unsigned f2bf(float f) { unsigned u = __builtin_bit_cast(unsigned, f); return (u + 0x7fffu + ((u >> 16) & 1u)) >> 16; }
__device__ __forceinline__ unsigned pk2(float lo, float hi) { return f2bf(lo) | (f2bf(hi) << 16); }
__device__ __forceinline__ float bf2f(unsigned b) { return __builtin_bit_cast(float, b << 16); }
__device__ __forceinline__ float bflo(unsigned w) { return __builtin_bit_cast(float, w << 16); }
__device__ __forceinline__ float bfhi(unsigned w) { return __builtin_bit_cast(float, w & 0xffff0000u); }
__device__ __forceinline__ float wave_sum(float v) {
#pragma unroll
    for (int o = 1; o < 64; o <<= 1) v += __shfl_xor(v, o);
    return v;
}
__device__ __forceinline__ int ld_i32_agent(const int* p) { return (int)__hip_atomic_load((const unsigned*)p, RLX_AGENT); }
__device__ __forceinline__ float ld_f32_agent(const float* p) { return __builtin_bit_cast(float, __hip_atomic_load((const unsigned*)p, RLX_AGENT)); }

#define XB_TMO      128
#define XB_XCNT(j)  (256  + 64 * (j))
#define XB_XSUB(j)  (1280 + 64 * (j))
#define XB_XGEN(j)  (2304 + 64 * (j))
#define XB_TOP      3328
#define XB_TOPGEN   3392
#define XCD_BAR_WORDS 3456
#define XB_SPIN_CAP (1u << 18)
__device__ __forceinline__ unsigned xb_ld(unsigned* p)              { return __hip_atomic_load(p, __ATOMIC_RELAXED, __HIP_MEMORY_SCOPE_AGENT); }
__device__ __forceinline__ unsigned xb_add(unsigned* p, unsigned v) { return __hip_atomic_fetch_add(p, v, __ATOMIC_RELAXED, __HIP_MEMORY_SCOPE_AGENT); }
__device__ __forceinline__ unsigned xb_xcc_id() { return (unsigned)__builtin_amdgcn_s_getreg((3 << 11) | 20) & 0xFu; }
#define XB_SPIN(cond, bar) do { unsigned _sp = 0; while (cond) { __builtin_amdgcn_s_sleep(1); \
    if ((++_sp & 255u) == 0u) { if (xb_ld(&(bar)[XB_TMO])) break; if (_sp > XB_SPIN_CAP) { atomicAdd(&(bar)[XB_TMO], 1u); break; } } } } while (0)
struct XcdBarrier { unsigned* bar; unsigned x; volatile LAS unsigned* st; };
__device__ __forceinline__ XcdBarrier xcd_barrier_post(unsigned* bar, volatile LAS unsigned* st) {
    XcdBarrier b; b.bar = bar; b.x = xb_xcc_id(); b.st = st;
    if (threadIdx.x == 0) (void)xb_add(&bar[XB_XCNT(b.x)], 1u);
    return b;
}
__device__ __forceinline__ void xcd_barrier_complete(unsigned* bar, unsigned x, unsigned& nloc, unsigned& nx) {
    const unsigned G = gridDim.x * gridDim.y * gridDim.z;
    unsigned sum, cnt, mine, sp = 0u;
    for (;;) {
        sum = 0u; cnt = 0u; mine = 0u;
#pragma unroll
        for (unsigned j = 0; j < 16; ++j) { const unsigned c = xb_ld(&bar[XB_XCNT(j)]); sum += c; cnt += (c > 0u) ? 1u : 0u; mine = (j == x) ? c : mine; }
        if (sum == G) break;
        __builtin_amdgcn_s_sleep(1);
        if ((++sp & 255u) == 0u) { if (xb_ld(&bar[XB_TMO])) break; if (sp > XB_SPIN_CAP) { atomicAdd(&bar[XB_TMO], 1u); break; } }
    }
    nloc = mine > 0u ? mine : 1u; nx = cnt > 0u ? cnt : 1u;
}
__device__ __forceinline__ void xcd_barrier(const XcdBarrier& b) {
    asm volatile("s_waitcnt vmcnt(0)" ::: "memory");
    __syncthreads();
    if (threadIdx.x == 0) {
        unsigned* bar = b.bar;
        __builtin_amdgcn_s_waitcnt(0);
        unsigned nloc = b.st[0], nx = b.st[1];
        if (nloc == 0u) { xcd_barrier_complete(bar, b.x, nloc, nx); b.st[0] = nloc; b.st[1] = nx; }
        const unsigned old = xb_add(&bar[XB_XSUB(b.x)], 1u);
        const unsigned gen = old / nloc;
        if (old + 1u == (gen + 1u) * nloc) {
            __builtin_amdgcn_fence(__ATOMIC_RELEASE, "agent");
            asm volatile("s_waitcnt vmcnt(0)" ::: "memory");
            const unsigned og = xb_add(&bar[XB_TOP], 1u);
            const unsigned tg = og / nx;
            if (og + 1u == (tg + 1u) * nx) xb_add(&bar[XB_TOPGEN], 1u);
            else XB_SPIN(xb_ld(&bar[XB_TOPGEN]) == tg, bar);
            __builtin_amdgcn_fence(__ATOMIC_ACQUIRE, "agent");
            xb_add(&bar[XB_XGEN(b.x)], 1u);
            asm volatile("s_waitcnt vmcnt(0)" ::: "memory");
        } else {
            XB_SPIN(xb_ld(&bar[XB_XGEN(b.x)]) == gen, bar);
            __builtin_amdgcn_fence(__ATOMIC_ACQUIRE, "agent");
            asm volatile("s_waitcnt vmcnt(0)" ::: "memory");
        }
    }
    __syncthreads();
}

namespace pg8 {
#define PG8_LAS __attribute__((address_space(3)))
typedef unsigned short bf16_t;
typedef short bf16x8 __attribute__((ext_vector_type(8)));
typedef float f32x4 __attribute__((ext_vector_type(4)));
typedef unsigned u32x4 __attribute__((ext_vector_type(4)));
constexpr int BM = 256, BK = 64, HALF = 128, HTB = HALF * BK * 2  , STAGE_BYTES = 8 * HTB, NXCD = 8, WGM = 8;

__host__ __device__ __forceinline__ int lds_byte(int r, int c) { const int st = (r >> 4) * 2 + (c >> 5), rr = r & 15, cc = c & 31, ob = rr * 64 + cc * 2; return st * 1024 + (ob ^ (((ob >> 9) & 1) << 5)); }
__host__ __device__ __forceinline__ void stage_rc(int b, int& R, int& C) { const int st = b / 1024, sb = b % 1024, swz = sb ^ (((sb >> 9) & 1) << 5); R = (st >> 1) * 16 + swz / 64; C = (st & 1) * 32 + (swz % 64) / 2; }
__host__ __device__ __forceinline__ int perm32(int rho) { const int n = rho >> 4, i = rho & 15; return 8 * (i >> 2) + 4 * n + (i & 3); }

struct Unit { int pm, pn; };
struct Gemm { const bf16_t* A; const bf16_t* Bt; int M, N, K; };

struct StaticOrder {
    int nM, nN, nwg, G, c;
    __host__ __device__ void init(int M, int N, int G_, int c_) { nM = M / BM; nN = N / BM; nwg = nM * nN; G = G_; c = c_; }
    __host__ __device__ bool next(int i, Unit& u) const {
        const long L = (long)i * G + c; if (L >= nwg) return false;
        int wgid = (int)L; { const int q = nwg / NXCD, r = nwg % NXCD, xcd = wgid % NXCD, off = wgid / NXCD; wgid = (xcd < r ? xcd * (q + 1) : r * (q + 1) + (xcd - r) * q) + off; }
        const int nig = WGM * nN, gid = wgid / nig, fm = gid * WGM, gsz = (nM - fm) < WGM ? (nM - fm) : WGM;
        u.pm = fm + ((wgid % nig) % gsz); u.pn = (wgid % nig) / gsz; return true;
    }
    __device__ __forceinline__ void a_ready(const Unit&) const {}
    __device__ __forceinline__ void done(const Unit&) const {}
    __device__ __forceinline__ size_t boff(const Unit&) const { return 0; }
};
struct MoeOrder : StaticOrder {
    const int* tile_e; size_t estride;
    __device__ __forceinline__ size_t boff(const Unit& u) const { return (size_t)__builtin_amdgcn_readfirstlane((int)__hip_atomic_load((const unsigned*)tile_e + u.pm, __ATOMIC_RELAXED, __HIP_MEMORY_SCOPE_AGENT)) * estride; }
};

__device__ __forceinline__ unsigned cvt_pk_bf16(float lo, float hi) { unsigned r; asm volatile("v_cvt_pk_bf16_f32 %0, %1, %2" : "=v"(r) : "v"(lo), "v"(hi)); return r; }
typedef float f32x2 __attribute__((ext_vector_type(2)));
template <int ACT  > struct EpiBf16 {
    static constexpr bool PERM = true, AFTER_DRAIN = false; static_assert(ACT == 0, "EpiBf16: ACT is 0");
    bf16_t* O; int ldc; const float* bias; int split_cols; size_t split_stride; float scale0;
    __device__ __forceinline__ void operator()(const f32x4 (&acc)[2][2][4][2], const Unit& u, int wr, int wc, int fr, int fq) const {
        const int row0 = u.pm * BM + wr * 64 + fr; int colt = u.pn * BM; bf16_t* base = O;
        float sc = 1.f; if (split_cols) { const int t = colt / split_cols; base += (size_t)t * split_stride; colt -= t * split_cols; if (t == 0) sc = scale0; }
        const int col0 = colt + wc * 32 + 8 * fq, bcol0 = u.pn * BM + wc * 32 + 8 * fq;
        f32x4 bv[2][2];
#pragma unroll
        for (int bj = 0; bj < 2; ++bj)
#pragma unroll
            for (int n = 0; n < 2; ++n) bv[bj][n] = bias ? *(const f32x4*)(bias + bcol0 + bj * HALF + 4 * n) : (f32x4){0.f, 0.f, 0.f, 0.f};
#pragma unroll
        for (int ai = 0; ai < 2; ++ai)
#pragma unroll
            for (int m = 0; m < 4; ++m) { bf16_t* rowp = base + (size_t)(row0 + ai * HALF + m * 16) * ldc + col0;
#pragma unroll
                for (int bj = 0; bj < 2; ++bj) { f32x4 v0 = acc[ai][bj][m][0] + bv[bj][0], v1 = acc[ai][bj][m][1] + bv[bj][1];
                    v0 = v0 * sc; v1 = v1 * sc; u32x4 w; w.x = cvt_pk_bf16(v0[0], v0[1]); w.y = cvt_pk_bf16(v0[2], v0[3]); w.z = cvt_pk_bf16(v1[0], v1[1]); w.w = cvt_pk_bf16(v1[2], v1[3]);
                    *(u32x4*)(rowp + bj * HALF) = w; } }
    }
};

struct EpiSwiglu {
    static constexpr bool PERM = true, AFTER_DRAIN = false;
    bf16_t* O; int ldc;
    __device__ __forceinline__ void operator()(const f32x4 (&acc)[2][2][4][2], const Unit& u, int wr, int wc, int fr, int fq) const {
        const int row0 = u.pm * BM + wr * 64 + fr, col0 = u.pn * HALF + wc * 32 + 8 * fq;
#pragma unroll
        for (int ai = 0; ai < 2; ++ai)
#pragma unroll
            for (int m = 0; m < 4; ++m) { bf16_t* rowp = O + (size_t)(row0 + ai * HALF + m * 16) * ldc + col0;
                float h[8];
#pragma unroll
                for (int n = 0; n < 2; ++n)
#pragma unroll
                    for (int j = 0; j < 4; ++j) { const float gte = acc[ai][0][m][n][j], up = acc[ai][1][m][n][j];
                        h[4 * n + j] = gte * __builtin_amdgcn_rcpf(1.0f + __builtin_amdgcn_exp2f(-1.4426950408889634f * gte)) * up; }
                u32x4 w; w.x = cvt_pk_bf16(h[0], h[1]); w.y = cvt_pk_bf16(h[2], h[3]); w.z = cvt_pk_bf16(h[4], h[5]); w.w = cvt_pk_bf16(h[6], h[7]);
                *(u32x4*)rowp = w; }
    }
};
struct EpiResid {
    static constexpr bool PERM = false, AFTER_DRAIN = false;
    const float* base; float* out; int ldc; float alpha;
    __device__ __forceinline__ void operator()(const f32x4 (&acc)[2][2][4][2], const Unit& u, int wr, int wc, int fr, int fq) const {
        const int row0 = u.pm * BM + wr * 64 + fr, col0 = u.pn * BM + wc * 32 + 4 * fq;
#pragma unroll
        for (int ai = 0; ai < 2; ++ai)
#pragma unroll
            for (int m = 0; m < 4; ++m) { const size_t ro = (size_t)(row0 + ai * HALF + m * 16) * ldc + col0;
                f32x4 bs[2][2];
#pragma unroll
                for (int bj = 0; bj < 2; ++bj)
#pragma unroll
                    for (int n = 0; n < 2; ++n) bs[bj][n] = *(const f32x4*)(base + ro + bj * HALF + n * 16);
#pragma unroll
                for (int bj = 0; bj < 2; ++bj)
#pragma unroll
                    for (int n = 0; n < 2; ++n) *(f32x4*)(out + ro + bj * HALF + n * 16) = bs[bj][n] * alpha + acc[ai][bj][m][n]; }
    }
};

template <class Epi, class Sched, bool ALIGN_EPI = false, bool SP2 = false>
__device__ __forceinline__ void gemm_phase(PG8_LAS unsigned char* lds, const Gemm g, const Sched& S, const Epi& E) {
    const int tid = threadIdx.x, wid = __builtin_amdgcn_readfirstlane(tid >> 6), lane = tid & 63, wr = wid >> 2, wc = wid & 3, fr = lane & 15, fq = lane >> 4;
    const int K = g.K, nt = K / BK;
    unsigned voffA[2], voffB[2];
#pragma unroll
    for (int i = 0; i < 2; ++i) { int R, C; stage_rc(tid * 16 + i * 8192, R, C); const int Rb = Epi::PERM ? ((R & ~31) + perm32(R & 31)) : R;
        voffA[i] = (unsigned)(R * K + C) * 2u; voffB[i] = (unsigned)(Rb * K + C) * 2u; }
    const size_t kstep = (size_t)(BK * 2);
    const size_t hstep = (size_t)HALF * K * 2;
    const size_t tstep = 2 * hstep;
    const unsigned ldsw = (unsigned)wid * 1024u;
    const int aoff = lds_byte(wr * 64 + fr, fq * 8), boff = lds_byte(wc * 32 + fr, fq * 8);
#define PG8_SA(b, h) (((b) * 2 + (h)) * HTB)
#define PG8_SB(b, h) ((4 + (b) * 2 + (h)) * HTB)
#define PG8_STAGE(bufoff, gbase, voff) do { _Pragma("unroll") for (int _i = 0; _i < 2; ++_i) \
        __builtin_amdgcn_global_load_lds((const unsigned*)((const char*)(gbase) + (voff)[_i]), (PG8_LAS unsigned*)(lds + (bufoff) + ldsw + _i * 8192), 16, 0, 0); } while (0)
#define PG8_LDA(dst, b, h) do { _Pragma("unroll") for (int m = 0; m < 4; ++m) _Pragma("unroll") for (int k = 0; k < 2; ++k) dst[m][k] = *(const PG8_LAS bf16x8*)(lds + PG8_SA(b, h) + aoff + m * 2048 + k * 1024); } while (0)
#define PG8_LDB(dst, b, h) do { _Pragma("unroll") for (int n = 0; n < 2; ++n) _Pragma("unroll") for (int k = 0; k < 2; ++k) dst[n][k] = *(const PG8_LAS bf16x8*)(lds + PG8_SB(b, h) + boff + n * 2048 + k * 1024); } while (0)
#define PG8_MMA(ai, bj, At, Bt) do { __builtin_amdgcn_s_setprio(1); _Pragma("unroll") for (int m = 0; m < 4; ++m) _Pragma("unroll") for (int n = 0; n < 2; ++n) _Pragma("unroll") for (int k = 0; k < 2; ++k) \
        acc[ai][bj][m][n] = __builtin_amdgcn_mfma_f32_16x16x32_bf16(Bt[n][k], At[m][k], acc[ai][bj][m][n], 0, 0, 0); __builtin_amdgcn_s_setprio(0); } while (0)
#define PG8_WAIT_V(n) asm volatile("s_waitcnt vmcnt(" #n ")" ::: "memory")
#define PG8_WAIT_L(n) asm volatile("s_waitcnt lgkmcnt(" #n ")" ::: "memory")
#define PG8_BAR __builtin_amdgcn_s_barrier()
#define PG8_SCHED __builtin_amdgcn_sched_barrier(0)
    Unit cur, nxt; int ui = 0;
    if (!S.next(0, cur)) return;
    f32x4 acc[2][2][4][2];
#pragma unroll
    for (int a = 0; a < 2; ++a)
#pragma unroll
        for (int b = 0; b < 2; ++b)
#pragma unroll
            for (int m = 0; m < 4; ++m)
#pragma unroll
                for (int n = 0; n < 2; ++n) acc[a][b][m][n] = (f32x4){0.f, 0.f, 0.f, 0.f};
    bf16x8 At[4][2], B0[2][2], B1[2][2];
    const char* cA = (const char*)g.A + (size_t)cur.pm * tstep; const char* cB = (const char*)g.Bt + S.boff(cur) * 2 + (size_t)cur.pn * tstep;
    S.a_ready(cur);
    if constexpr (SP2) {
        PG8_STAGE(PG8_SB(0, 0), cB, voffB); PG8_STAGE(PG8_SB(0, 1), cB + hstep, voffB); PG8_STAGE(PG8_SA(0, 0), cA, voffA); PG8_STAGE(PG8_SA(0, 1), cA + hstep, voffA);
        if (wr == 1) PG8_BAR;
        PG8_WAIT_V(2); PG8_BAR;
        PG8_STAGE(PG8_SB(1, 0), cB + kstep, voffB); PG8_STAGE(PG8_SA(1, 0), cA + kstep, voffA); PG8_STAGE(PG8_SB(1, 1), cB + hstep + kstep, voffB);
        PG8_WAIT_V(6); PG8_BAR;
    } else {
        PG8_STAGE(PG8_SB(0, 0), cB, voffB); PG8_STAGE(PG8_SA(0, 0), cA, voffA); PG8_STAGE(PG8_SB(0, 1), cB + hstep, voffB); PG8_STAGE(PG8_SA(0, 1), cA + hstep, voffA);
        if (wr == 1) PG8_BAR;
        PG8_WAIT_V(4); PG8_BAR;
        PG8_STAGE(PG8_SB(1, 0), cB + kstep, voffB); PG8_STAGE(PG8_SA(1, 0), cA + kstep, voffA); PG8_STAGE(PG8_SB(1, 1), cB + hstep + kstep, voffB);
        PG8_WAIT_V(6); PG8_BAR;
    }
    for (;;) {
        const bool has_next = S.next(ui + 1, nxt);
        const char* nA = has_next ? (const char*)g.A + (size_t)nxt.pm * tstep : cA; const char* nB = has_next ? (const char*)g.Bt + S.boff(nxt) * 2 + (size_t)nxt.pn * tstep : cB;
        for (int t = 0; t < nt; t += 2) {
            const bool last = (t == nt - 2);
            const char* a1 = cA + (size_t)(t + 1) * kstep;
            const char* a2 = last ? nA : cA + (size_t)(t + 2) * kstep; const char* b2 = last ? nB : cB + (size_t)(t + 2) * kstep;
            const char* a3 = a2 + kstep; const char* b3 = b2 + kstep;
            if (last && has_next) S.a_ready(nxt);
            if constexpr (SP2) {
            PG8_LDB(B0, 0, 0); PG8_LDB(B1, 0, 1); PG8_SCHED; PG8_LDA(At, 0, 0); PG8_STAGE(PG8_SA(1, 1), a1 + hstep, voffA);
            PG8_WAIT_V(8); PG8_WAIT_L(0); PG8_BAR; PG8_MMA(0, 0, At, B0); PG8_MMA(0, 1, At, B1); PG8_BAR; PG8_SCHED;
            PG8_LDA(At, 0, 1); PG8_STAGE(PG8_SB(0, 0), b2, voffB); PG8_STAGE(PG8_SB(0, 1), b2 + hstep, voffB); PG8_STAGE(PG8_SA(0, 0), a2, voffA);
            PG8_WAIT_V(8); PG8_WAIT_L(0); PG8_BAR; PG8_MMA(1, 0, At, B0); PG8_MMA(1, 1, At, B1); PG8_BAR; PG8_SCHED;
            PG8_LDB(B0, 1, 0); PG8_LDB(B1, 1, 1); PG8_SCHED; PG8_LDA(At, 1, 0); PG8_STAGE(PG8_SA(0, 1), a2 + hstep, voffA);
            PG8_WAIT_V(8); PG8_WAIT_L(0); PG8_BAR; PG8_MMA(0, 0, At, B0); PG8_MMA(0, 1, At, B1); PG8_BAR; PG8_SCHED;
            PG8_LDA(At, 1, 1); PG8_STAGE(PG8_SB(1, 0), b3, voffB); PG8_STAGE(PG8_SB(1, 1), b3 + hstep, voffB); PG8_STAGE(PG8_SA(1, 0), a3, voffA);
            PG8_WAIT_V(8); PG8_WAIT_L(0); PG8_BAR; PG8_MMA(1, 0, At, B0); PG8_MMA(1, 1, At, B1); PG8_BAR; PG8_SCHED;
            } else {
            PG8_LDB(B0, 0, 0); PG8_SCHED; PG8_LDA(At, 0, 0); PG8_STAGE(PG8_SA(1, 1), a1 + hstep, voffA);
            PG8_WAIT_L(8); PG8_BAR; PG8_WAIT_L(0); PG8_MMA(0, 0, At, B0); PG8_BAR; PG8_SCHED;
            PG8_LDB(B1, 0, 1); PG8_STAGE(PG8_SB(0, 0), b2, voffB);
            PG8_BAR; PG8_WAIT_L(0); PG8_MMA(0, 1, At, B1); PG8_BAR;
            PG8_LDA(At, 0, 1); PG8_STAGE(PG8_SA(0, 0), a2, voffA);
            PG8_BAR; PG8_WAIT_L(0); PG8_MMA(1, 0, At, B0); PG8_BAR; PG8_SCHED;
            PG8_STAGE(PG8_SB(0, 1), b2 + hstep, voffB);
            PG8_WAIT_V(6); PG8_BAR; PG8_MMA(1, 1, At, B1); PG8_BAR;
            PG8_LDB(B0, 1, 0); PG8_SCHED; PG8_LDA(At, 1, 0); PG8_STAGE(PG8_SA(0, 1), a2 + hstep, voffA);
            PG8_WAIT_L(8); PG8_BAR; PG8_WAIT_L(0); PG8_MMA(0, 0, At, B0); PG8_BAR; PG8_SCHED;
            PG8_LDB(B1, 1, 1); PG8_STAGE(PG8_SB(1, 0), b3, voffB);
            PG8_BAR; PG8_WAIT_L(0); PG8_MMA(0, 1, At, B1); PG8_BAR;
            PG8_LDA(At, 1, 1); PG8_STAGE(PG8_SA(1, 0), a3, voffA);
            PG8_BAR; PG8_WAIT_L(0); PG8_MMA(1, 0, At, B0); PG8_BAR; PG8_SCHED;
            PG8_STAGE(PG8_SB(1, 1), b3 + hstep, voffB);
            PG8_WAIT_V(6); PG8_BAR; PG8_MMA(1, 1, At, B1); PG8_BAR;
            }
        }
        if constexpr (ALIGN_EPI) { if (wr == 0) PG8_BAR; }
        if constexpr (!Epi::AFTER_DRAIN) { E(acc, cur, wr, wc, fr, fq); S.done(cur); }
        if (!has_next) break;
#pragma unroll
        for (int a = 0; a < 2; ++a)
#pragma unroll
            for (int b = 0; b < 2; ++b)
#pragma unroll
                for (int m = 0; m < 4; ++m)
#pragma unroll
                    for (int n = 0; n < 2; ++n) acc[a][b][m][n] = (f32x4){0.f, 0.f, 0.f, 0.f};
        cur = nxt; cA = nA; cB = nB; ++ui;
        if constexpr (ALIGN_EPI) { if (wr == 1) PG8_BAR; }
    }
    PG8_WAIT_V(0);
    if constexpr (!ALIGN_EPI) { if (wr == 0) PG8_BAR; }
    PG8_BAR;
    if constexpr (Epi::AFTER_DRAIN) { E.fused(acc, cur, wr, wc, fr, fq, lds, wid, lane); S.done(cur); }
#undef PG8_SA
#undef PG8_SB
#undef PG8_STAGE
#undef PG8_LDA
#undef PG8_LDB
#undef PG8_MMA
#undef PG8_WAIT_V
#undef PG8_WAIT_L
#undef PG8_BAR
#undef PG8_SCHED
}
}


struct Args { const float* in[21]; float* out; unsigned char* ws; int lo, hi; };
enum { I_X = 0, I_MEM, I_WMEMKV, I_AWIN, I_ACONV, I_AWOUT, I_BWIN, I_BWOUT, I_CWIN, I_CPOOLW, I_CPOOLS, I_CWOUT, I_LNG, I_LNB,
       I_FG, I_FU, I_FD, I_ROUTER, I_MG, I_MU, I_MD };
struct Frame { LAS unsigned char* lds; int tid, lane, wave, gw; };

template <int NWM, class Epi>
__device__ __forceinline__ void naive_gemm(const Frame& F, const bf16* A, int lda, const float* W0, const float* W1, int ldw, int M, int N, int K, const Epi& epi, const int* tile_e, size_t wstride) {
    const int lane = F.lane, r16 = lane & 15, q4 = lane >> 4;
    const int tn = N / 32, ntiles = (M / 32) * tn;
    for (int tile = F.gw; tile < ntiles; tile += NGW) {
        const int m0 = (tile / tn) * 32, n0 = (tile % tn) * 32;
        size_t woff = 0;
        if (tile_e) woff = (size_t)ld_i32_agent(tile_e + (m0 >> 8)) * wstride;
        const float* w0 = W0 + woff; const float* w1 = (NWM == 2) ? W1 + woff : nullptr;
        f32x4 acc[NWM][2][2];
#pragma unroll
        for (int w = 0; w < NWM; ++w)
#pragma unroll
            for (int i = 0; i < 2; ++i)
#pragma unroll
                for (int j = 0; j < 2; ++j) acc[w][i][j] = (f32x4){0.f, 0.f, 0.f, 0.f};
        for (int k0 = 0; k0 < K; k0 += 32) {
            bf16x8 a[2], b[NWM][2];
#pragma unroll
            for (int i = 0; i < 2; ++i) a[i] = *(const bf16x8*)(A + (size_t)(m0 + 16 * i + r16) * lda + k0 + 8 * q4);
#pragma unroll
            for (int w = 0; w < NWM; ++w)
#pragma unroll
                for (int jn = 0; jn < 2; ++jn) {
                    const float* wp = (w == 0 ? w0 : w1) + (size_t)(k0 + 8 * q4) * ldw + n0 + 16 * jn + r16;
#pragma unroll
                    for (int j = 0; j < 8; ++j) b[w][jn][j] = (short)f2bf(wp[(size_t)j * ldw]);
                }
#pragma unroll
            for (int w = 0; w < NWM; ++w)
#pragma unroll
                for (int i = 0; i < 2; ++i)
#pragma unroll
                    for (int jn = 0; jn < 2; ++jn) acc[w][i][jn] = __builtin_amdgcn_mfma_f32_16x16x32_bf16(a[i], b[w][jn], acc[w][i][jn], 0, 0, 0);
        }
#pragma unroll
        for (int i = 0; i < 2; ++i)
#pragma unroll
            for (int jn = 0; jn < 2; ++jn)
#pragma unroll
                for (int r = 0; r < 4; ++r) {
                    const int row = m0 + 16 * i + q4 * 4 + r, col = n0 + 16 * jn + r16;
                    if constexpr (NWM == 2) epi(row, col, acc[0][i][jn][r], acc[1][i][jn][r]); else epi(row, col, acc[0][i][jn][r], 0.f);
                }
    }
}
struct NEpiBf16 { bf16* O; int ldo; __device__ __forceinline__ void operator()(int r, int c, float v, float) const { O[(size_t)r * ldo + c] = (bf16)f2bf(v); } };
struct NEpiResid { const float* base; float* out; __device__ __forceinline__ void operator()(int r, int c, float v, float) const { const size_t o = (size_t)r * D + c; out[o] = ALPHA * base[o] + v; } };
struct NEpiSwiglu { bf16* O; int ldo; __device__ __forceinline__ void operator()(int r, int c, float g, float u) const { const float s = g / (1.f + __expf(-g)); O[(size_t)r * ldo + c] = (bf16)f2bf(s * u); } };
struct NEpiScale { bf16* O; int ldo; int coff; const float* scale; __device__ __forceinline__ void operator()(int r, int c, float v, float) const { O[(size_t)r * ldo + coff + c] = (bf16)f2bf(v * scale[coff + c]); } };

__device__ __forceinline__ void prep_phase(const Frame& F, const float* x, const float* mem, bf16* XB, bf16* MEMB) {
    const size_t gt = (size_t)blockIdx.x * NTHREADS + F.tid, NT = (size_t)GRID * NTHREADS;
    for (size_t i = gt; i < (size_t)T * D / 8; i += NT) { const f32x4 a = ((const f32x4*)x)[2 * i], b = ((const f32x4*)x)[2 * i + 1];
        v4u o; o.x = pk2(a.x, a.y); o.y = pk2(a.z, a.w); o.z = pk2(b.x, b.y); o.w = pk2(b.z, b.w); ((v4u*)XB)[i] = o; }
    for (size_t i = gt; i < (size_t)NB * ML * D / 8; i += NT) { const f32x4 a = ((const f32x4*)mem)[2 * i], b = ((const f32x4*)mem)[2 * i + 1];
        v4u o; o.x = pk2(a.x, a.y); o.y = pk2(a.z, a.w); o.z = pk2(b.x, b.y); o.w = pk2(b.z, b.w); ((v4u*)MEMB)[i] = o; }
}
__device__ __forceinline__ void unpack8(const v4u w, float (&f)[8]) { f[0] = bflo(w.x); f[1] = bfhi(w.x); f[2] = bflo(w.y); f[3] = bfhi(w.y); f[4] = bflo(w.z); f[5] = bfhi(w.z); f[6] = bflo(w.w); f[7] = bfhi(w.w); }
__device__ __forceinline__ v4u pack8(const float (&f)[8]) { v4u o; o.x = pk2(f[0], f[1]); o.y = pk2(f[2], f[3]); o.z = pk2(f[4], f[5]); o.w = pk2(f[6], f[7]); return o; }

__device__ __forceinline__ void mixA_phase(const Frame& F, const bf16* H, const float* convw, bf16* CAT) {
    const size_t gt = (size_t)blockIdx.x * NTHREADS + F.tid, NT = (size_t)GRID * NTHREADS;
    for (size_t it = gt; it < (size_t)T * 96; it += NT) {
        const int t = (int)(it / 96), c8 = (int)(it % 96) * 8, s = t & (SEQ - 1);
        const bf16* hr = H + (size_t)t * 2560 + c8;
        float gb[8], z0[8], z1[8], z2[8], a[8], b[8];
        unpack8(*(const v4u*)hr, gb);
        unpack8(*(const v4u*)(hr + 768), a); unpack8(*(const v4u*)(hr + 1536), b);
#pragma unroll
        for (int i = 0; i < 8; ++i) z1[i] = a[i] * b[i];
        if (s > 0) { unpack8(*(const v4u*)(hr - 2560 + 768), a); unpack8(*(const v4u*)(hr - 2560 + 1536), b);
#pragma unroll
            for (int i = 0; i < 8; ++i) z0[i] = a[i] * b[i]; }
        else {
#pragma unroll
            for (int i = 0; i < 8; ++i) z0[i] = 0.f; }
        if (s < SEQ - 1) { unpack8(*(const v4u*)(hr + 2560 + 768), a); unpack8(*(const v4u*)(hr + 2560 + 1536), b);
#pragma unroll
            for (int i = 0; i < 8; ++i) z2[i] = a[i] * b[i]; }
        else {
#pragma unroll
            for (int i = 0; i < 8; ++i) z2[i] = 0.f; }
        float o[8];
#pragma unroll
        for (int i = 0; i < 8; ++i) o[i] = gb[i] * (convw[c8 + i] * z0[i] + convw[768 + c8 + i] * z1[i] + convw[1536 + c8 + i] * z2[i]);
        *(v4u*)(CAT + (size_t)t * 1024 + c8) = pack8(o);
    }
}
__device__ __forceinline__ void poolC_phase(const Frame& F, const bf16* H, bf16* OUT, int ldo) {
    const size_t gt = (size_t)blockIdx.x * NTHREADS + F.tid, NT = (size_t)GRID * NTHREADS;
    for (size_t it = gt; it < (size_t)T * 96; it += NT) {
        const int t = (int)(it / 96), ch = (int)(it % 96), c8 = ch * 8, s = t & (SEQ - 1), g = ch / 24, w = 2 << g;
        int lo = s - w / 2; lo = lo < 0 ? 0 : lo; int hi = s + w / 2 - 1; hi = hi > SEQ - 1 ? SEQ - 1 : hi;
        const bf16* base = H + (size_t)(t - s) * 1024 + c8;
        float acc[8], u[8], v[8];
#pragma unroll
        for (int i = 0; i < 8; ++i) acc[i] = 0.f;
        for (int p = lo; p <= hi; ++p) { unpack8(*(const v4u*)(base + (size_t)p * 1024), v);
#pragma unroll
            for (int i = 0; i < 8; ++i) acc[i] += v[i]; }
        unpack8(*(const v4u*)(base + (size_t)s * 1024), u);
        const float inv = 1.f / (float)(hi - lo + 1);
        float o[8];
#pragma unroll
        for (int i = 0; i < 8; ++i) o[i] = acc[i] * inv - u[i];
        *(v4u*)(OUT + (size_t)t * ldo + c8) = pack8(o);
    }
}


__device__ __forceinline__ void tr_item(const float* W, int N, int k0, int n0, bf16* WT, int ldk, int drow0, LAS float* scr, int lane) {
#pragma unroll 8
    for (int i = 0; i < 32; ++i) { const int kk = 2 * i + (lane >> 5); scr[kk * 33 + (lane & 31)] = W[(size_t)(k0 + kk) * N + n0 + (lane & 31)]; }
    LDS_WAIT(); asm volatile("" ::: "memory");
    const int c = lane & 7;
#pragma unroll
    for (int j = 0; j < 4; ++j) { const int n = (lane >> 3) + 8 * j; const LAS float* sp = scr + (8 * c) * 33 + n;
        v4u o; o.x = pk2(sp[0 * 33], sp[1 * 33]); o.y = pk2(sp[2 * 33], sp[3 * 33]); o.z = pk2(sp[4 * 33], sp[5 * 33]); o.w = pk2(sp[6 * 33], sp[7 * 33]);
        *(v4u*)(WT + (size_t)(drow0 + n) * ldk + k0 + 8 * c) = o; }
    LDS_WAIT(); asm volatile("" ::: "memory");
}
template <int MODE>
__device__ __forceinline__ void tr_matrix(const Frame& F, const float* W, int K, int N, bf16* WT, int ldk, int& rot) {
    LAS float* scr = (LAS float*)(F.lds + F.wave * 16384);
    const int nblk = N / 32, nitems = (K / 64) * nblk;
    for (int it = (F.gw + NGW - (rot % NGW)) % NGW; it < nitems; it += NGW) {
        const int k0 = (it / nblk) * 64, n0 = (it % nblk) * 32;
        const int drow0 = MODE == 0 ? n0 : ((n0 >> 7) * 256 + (n0 & 127) + (MODE == 2 ? 128 : 0));
        tr_item(W, N, k0, n0, WT, ldk, drow0, scr, F.lane);
    }
    rot += nitems;
}
__device__ __forceinline__ void convert_moe(const Frame& F, const float* wg, const float* wu, const float* wd, bf16* WMOE, int& rot) {
#pragma unroll 1
    for (int e = 0; e < NE; ++e) {
        tr_matrix<1>(F, wg + (size_t)e * D * FFE, D, FFE, WMOE + OFF_MGU + (size_t)e * 2 * FFE * D, D, rot);
        tr_matrix<2>(F, wu + (size_t)e * D * FFE, D, FFE, WMOE + OFF_MGU + (size_t)e * 2 * FFE * D, D, rot);
        tr_matrix<0>(F, wd + (size_t)e * FFE * D, FFE, D, WMOE + OFF_MD + (size_t)e * D * FFE, FFE, rot);
    }
}
__device__ __forceinline__ void fold_pool(const Frame& F, const float* pw, const float* ps, const float* wout, bf16* WT) {
    const int item = blockIdx.x * NTHREADS + F.tid;
    if (item < 1024 * 96) {
        const int n = item & 1023, kc = item >> 10, g = kc / 24, c0 = kc * 8 - g * 192;
        float acc[8];
#pragma unroll
        for (int i = 0; i < 8; ++i) acc[i] = 0.f;
        const float* P = pw + (size_t)g * 192 * 192 + (size_t)c0 * 192;
        for (int d = 0; d < 192; ++d) { const float w = wout[(size_t)(g * 192 + d) * D + n] * ps[g * 192 + d];
#pragma unroll
            for (int i = 0; i < 8; ++i) acc[i] += P[i * 192 + d] * w; }
        *(v4u*)(WT + (size_t)n * D + kc * 8) = pack8(acc);
    }
}
__device__ __forceinline__ void convert_small(const Frame& F, const Args& a, bf16* WSM, int& rot) {
    tr_matrix<0>(F, a.in[I_WMEMKV], D, 512, WSM + OFF_WKV, D, rot);
    tr_matrix<0>(F, a.in[I_AWIN], D, 2560, WSM + OFF_AIN, D, rot);
    tr_matrix<0>(F, a.in[I_AWIN] + (size_t)D * 2560, D, 2560, WSM + OFF_AIN + (size_t)2560 * D, D, rot);
    tr_matrix<0>(F, a.in[I_AWOUT], D, D, WSM + OFF_AOUT, D, rot);
    tr_matrix<0>(F, a.in[I_AWOUT] + (size_t)D * D, D, D, WSM + OFF_AOUT + (size_t)D * D, D, rot);
    tr_matrix<0>(F, a.in[I_BWIN], D, 2560, WSM + OFF_BIN, D, rot);
    tr_matrix<0>(F, a.in[I_BWOUT], 512, D, WSM + OFF_BOUT, 512, rot);
    tr_matrix<0>(F, a.in[I_CWIN], D, D, WSM + OFF_CIN, D, rot);
    tr_matrix<0>(F, a.in[I_CWOUT] + (size_t)768 * D, 256, D, WSM + OFF_COUT + 768, D, rot);
#pragma unroll 1
    for (int f = 0; f < 2; ++f) {
        tr_matrix<1>(F, a.in[I_FG] + (size_t)f * D * FF, D, FF, WSM + OFF_FGU + (size_t)f * 2 * FF * D, D, rot);
        tr_matrix<2>(F, a.in[I_FU] + (size_t)f * D * FF, D, FF, WSM + OFF_FGU + (size_t)f * 2 * FF * D, D, rot);
        tr_matrix<0>(F, a.in[I_FD] + (size_t)f * FF * D, FF, D, WSM + OFF_FD + (size_t)f * D * FF, FF, rot);
    }
}

template <bool ROUTER, bool COMBINE>
__device__ __forceinline__ void ln_phase(const Frame& F, float* XR, bf16* XB, const float* g, const float* b, const float* router, int* E01, float* W01, const int* DEST, const bf16* YB, int* cntWG) {
    LAS int* cntL = (LAS int*)F.lds;
    if (ROUTER) { if (F.tid < 8) cntL[F.tid] = 0; __syncthreads(); }
    f32x4 gv[4], bv[4];
#pragma unroll
    for (int j = 0; j < 4; ++j) { gv[j] = ((const f32x4*)g)[F.lane + 64 * j]; bv[j] = ((const f32x4*)b)[F.lane + 64 * j]; }
    for (int i = 0; i < 16; ++i) {
        const int t = blockIdx.x * 128 + F.wave * 16 + i;
        f32x4* xr = (f32x4*)(XR + (size_t)t * D) + F.lane;
        f32x4 v[4]; float s = 0.f;
#pragma unroll
        for (int j = 0; j < 4; ++j) v[j] = xr[64 * j];
        if (COMBINE) {
            const int d0 = ld_i32_agent(DEST + 2 * t), d1 = ld_i32_agent(DEST + 2 * t + 1);
            const float w0 = ld_f32_agent(W01 + 2 * t), w1 = ld_f32_agent(W01 + 2 * t + 1);
            const v2u* y0 = (const v2u*)(YB + (size_t)d0 * D) + F.lane; const v2u* y1 = (const v2u*)(YB + (size_t)d1 * D) + F.lane;
#pragma unroll
            for (int j = 0; j < 4; ++j) { const v2u a = y0[64 * j], c = y1[64 * j];
                v[j].x = ALPHA * v[j].x + w0 * bflo(a.x) + w1 * bflo(c.x); v[j].y = ALPHA * v[j].y + w0 * bfhi(a.x) + w1 * bfhi(c.x);
                v[j].z = ALPHA * v[j].z + w0 * bflo(a.y) + w1 * bflo(c.y); v[j].w = ALPHA * v[j].w + w0 * bfhi(a.y) + w1 * bfhi(c.y); }
        }
#pragma unroll
        for (int j = 0; j < 4; ++j) s += (v[j].x + v[j].y) + (v[j].z + v[j].w);
        const float mean = wave_sum(s) * (1.f / D); float s2 = 0.f;
#pragma unroll
        for (int j = 0; j < 4; ++j) { v[j] = v[j] - mean; s2 += (v[j].x * v[j].x + v[j].y * v[j].y) + (v[j].z * v[j].z + v[j].w * v[j].w); }
        const float rstd = 1.f / sqrtf(wave_sum(s2) * (1.f / D) + LN_EPS);
        v2u* o8 = (v2u*)(XB + (size_t)t * D) + F.lane;
#pragma unroll
        for (int j = 0; j < 4; ++j) { v[j] = v[j] * rstd * gv[j] + bv[j]; xr[64 * j] = v[j]; v2u o; o.x = pk2(v[j].x, v[j].y); o.y = pk2(v[j].z, v[j].w); o8[64 * j] = o; }
        if (ROUTER) {
            float lg[8];
#pragma unroll
            for (int e = 0; e < 8; ++e) lg[e] = 0.f;
#pragma unroll
            for (int j = 0; j < 4; ++j)
#pragma unroll
                for (int q = 0; q < 4; ++q) { const int c = 4 * F.lane + 256 * j + q; const f32x4 r0 = ((const f32x4*)router)[2 * c], r1 = ((const f32x4*)router)[2 * c + 1]; const float xv = v[j][q];
                    lg[0] += xv * r0.x; lg[1] += xv * r0.y; lg[2] += xv * r0.z; lg[3] += xv * r0.w; lg[4] += xv * r1.x; lg[5] += xv * r1.y; lg[6] += xv * r1.z; lg[7] += xv * r1.w; }
#pragma unroll
            for (int e = 0; e < 8; ++e) lg[e] = wave_sum(lg[e]);
            float b0 = lg[0]; int i0 = 0;
#pragma unroll
            for (int e = 1; e < 8; ++e) if (lg[e] > b0) { b0 = lg[e]; i0 = e; }
            float b1 = -3.0e38f; int i1 = 0;
#pragma unroll
            for (int e = 0; e < 8; ++e) if (e != i0 && lg[e] > b1) { b1 = lg[e]; i1 = e; }
            const float w0 = 1.f / (1.f + __expf(b1 - b0));
            if (F.lane == 0) { E01[2 * t] = i0; E01[2 * t + 1] = i1; W01[2 * t] = w0; W01[2 * t + 1] = 1.f - w0; __hip_atomic_fetch_add(&cntL[i0], 1, __ATOMIC_RELAXED, __HIP_MEMORY_SCOPE_WORKGROUP); __hip_atomic_fetch_add(&cntL[i1], 1, __ATOMIC_RELAXED, __HIP_MEMORY_SCOPE_WORKGROUP); }
        }
    }
    if (ROUTER) { __syncthreads(); if (F.tid < 8) cntWG[blockIdx.x * 8 + F.tid] = cntL[F.tid]; }
}
__device__ __forceinline__ void scatter_phase(const Frame& F, const int* cntWG, const int* E01, int* DEST, const bf16* XB, bf16* XS, int* tile_e, int* nMp) {
    LAS int* L = (LAS int*)F.lds;
    if (F.tid < 8) { int tot = 0, base = 0; for (int w = 0; w < GRID; ++w) { const int c = ld_i32_agent(cntWG + w * 8 + F.tid); if (w < (int)blockIdx.x) base += c; tot += c; } L[F.tid] = base; L[8 + F.tid] = tot; }
    __syncthreads();
    if (F.tid == 0) { int ps = 0; for (int e = 0; e < 8; ++e) { L[16 + e] = ps; ps += (L[8 + e] + 255) / 256 * 256; } L[24] = ps; }
    __syncthreads();
    if (F.wave == 0) {
        const int tA = blockIdx.x * 128 + F.lane, tB = tA + 64;
        const int eA0 = ld_i32_agent(E01 + 2 * tA), eA1 = ld_i32_agent(E01 + 2 * tA + 1), eB0 = ld_i32_agent(E01 + 2 * tB), eB1 = ld_i32_agent(E01 + 2 * tB + 1);
        const unsigned long long lt = (1ull << F.lane) - 1ull;
        int dA0 = 0, dA1 = 0, dB0 = 0, dB1 = 0;
        for (int e = 0; e < 8; ++e) {
            const unsigned long long mA0 = __ballot(eA0 == e), mA1 = __ballot(eA1 == e), mB0 = __ballot(eB0 == e), mB1 = __ballot(eB1 == e);
            const int start = L[16 + e] + L[e];
            const int cA = __popcll(mA0 & lt) + __popcll(mA1 & lt), totA = __popcll(mA0) + __popcll(mA1), cB = totA + __popcll(mB0 & lt) + __popcll(mB1 & lt);
            if (eA0 == e) dA0 = start + cA; if (eA1 == e) dA1 = start + cA;
            if (eB0 == e) dB0 = start + cB; if (eB1 == e) dB1 = start + cB;
        }
        DEST[2 * tA] = dA0; DEST[2 * tA + 1] = dA1; DEST[2 * tB] = dB0; DEST[2 * tB + 1] = dB1;
        L[32 + 2 * F.lane] = dA0; L[32 + 2 * F.lane + 1] = dA1; L[32 + 2 * (F.lane + 64)] = dB0; L[32 + 2 * (F.lane + 64) + 1] = dB1;
    }
    __syncthreads();
    for (int i = 0; i < 16; ++i) {
        const int tl = F.wave * 16 + i, t = blockIdx.x * 128 + tl;
        const v4u* src = (const v4u*)(XB + (size_t)t * D) + F.lane; const v4u a = src[0], b = src[64];
#pragma unroll
        for (int k = 0; k < 2; ++k) { v4u* dst = (v4u*)(XS + (size_t)L[32 + 2 * tl + k] * D) + F.lane; dst[0] = a; dst[64] = b; }
    }
    if (blockIdx.x == 0) {
        const int nM = L[24] / 256;
        for (int i = F.tid; i < nM; i += NTHREADS) { int e = 0;
#pragma unroll
            for (int q = 1; q < 8; ++q) if (i * 256 >= L[16 + q]) e = q;
            tile_e[i] = e; }
        if (F.tid == 0) *nMp = nM;
    }
    __syncthreads();
}

__device__ __forceinline__ void memattn_naive(const Frame& F, const bf16* H, int ldh, int qoff, const bf16* MEMKV, bf16* CAT, int ldc, int coff) {
    const size_t gt = (size_t)blockIdx.x * NTHREADS + F.tid, NT = (size_t)GRID * NTHREADS;
    for (size_t it = gt; it < (size_t)T * 4; it += NT) {
        const int t = (int)(it >> 2), h = (int)(it & 3), bb = t / SEQ;
        float q[64], o[64];
#pragma unroll
        for (int c = 0; c < 8; ++c) { float f[8]; unpack8(*(const v4u*)(H + (size_t)t * ldh + qoff + 64 * h + 8 * c), f);
#pragma unroll
            for (int i = 0; i < 8; ++i) { q[8 * c + i] = f[i] * 0.125f; o[8 * c + i] = 0.f; } }
        float m = -3.0e38f, l = 0.f;
        for (int k = 0; k < ML; ++k) {
            const bf16* kr = MEMKV + (size_t)(bb * ML + k) * 512 + 64 * h;
            float sc = 0.f;
#pragma unroll
            for (int c = 0; c < 8; ++c) { float f[8]; unpack8(*(const v4u*)(kr + 8 * c), f);
#pragma unroll
                for (int i = 0; i < 8; ++i) sc += q[8 * c + i] * f[i]; }
            const float mn = fmaxf(m, sc), al = __expf(m - mn), p = __expf(sc - mn);
            l = l * al + p; m = mn;
#pragma unroll
            for (int c = 0; c < 8; ++c) { float f[8]; unpack8(*(const v4u*)(kr + 256 + 8 * c), f);
#pragma unroll
                for (int i = 0; i < 8; ++i) o[8 * c + i] = o[8 * c + i] * al + p * f[i]; }
        }
        const float inv = 1.f / l;
#pragma unroll
        for (int c = 0; c < 8; ++c) { float f[8];
#pragma unroll
            for (int i = 0; i < 8; ++i) f[i] = o[8 * c + i] * inv;
            *(v4u*)(CAT + (size_t)t * ldc + coff + 64 * h + 8 * c) = pack8(f); }
    }
}
__device__ __forceinline__ void dilattn_naive(const Frame& F, const bf16* H, bf16* CAT, int ldc) {
    const size_t gt = (size_t)blockIdx.x * NTHREADS + F.tid, NT = (size_t)GRID * NTHREADS;
    for (size_t it = gt; it < (size_t)T * 4; it += NT) {
        const int t = (int)(it >> 2), h = (int)(it & 3), s = t & (SEQ - 1);
        float q[64], o[64];
#pragma unroll
        for (int i = 0; i < 64; ++i) o[i] = 0.f;
        float m = -3.0e38f, l = 0.f;
        for (int g = 0; g < 3; ++g) {
            const int dl = 1 << (2 * g), nsub = SEQ / dl, j = s / dl, r = s % dl;
            const float slope = exp2f(-8.f * (float)(4 * g + h + 1) / 12.f) * (float)dl;
#pragma unroll
            for (int c = 0; c < 8; ++c) { float f[8]; unpack8(*(const v4u*)(H + (size_t)t * 2560 + 256 * g + 64 * h + 8 * c), f);
#pragma unroll
                for (int i = 0; i < 8; ++i) q[8 * c + i] = f[i] * 0.125f; }
            const int jlo = j - 64 < 0 ? 0 : j - 64, jhi = j + 64 > nsub - 1 ? nsub - 1 : j + 64;
            for (int jj = jlo; jj <= jhi; ++jj) {
                const bf16* kr = H + (size_t)(t - s + jj * dl + r) * 2560 + 768 + 256 * g + 64 * h;
                float sc = 0.f;
#pragma unroll
                for (int c = 0; c < 8; ++c) { float f[8]; unpack8(*(const v4u*)(kr + 8 * c), f);
#pragma unroll
                    for (int i = 0; i < 8; ++i) sc += q[8 * c + i] * f[i]; }
                const int ad = jj > j ? jj - j : j - jj;
                sc -= slope * (float)ad;
                const float mn = fmaxf(m, sc), al = __expf(m - mn), p = __expf(sc - mn);
                l = l * al + p; m = mn;
#pragma unroll
                for (int c = 0; c < 8; ++c) { float f[8]; unpack8(*(const v4u*)(kr + 768 + 8 * c), f);
#pragma unroll
                    for (int i = 0; i < 8; ++i) o[8 * c + i] = o[8 * c + i] * al + p * f[i]; }
            }
        }
        const float inv = 1.f / l;
#pragma unroll
        for (int c = 0; c < 8; ++c) { float f[8];
#pragma unroll
            for (int i = 0; i < 8; ++i) f[i] = o[8 * c + i] * inv;
            *(v4u*)(CAT + (size_t)t * ldc + 64 * h + 8 * c) = pack8(f); }
    }
}


typedef short v4i16_t __attribute__((ext_vector_type(4)));
__device__ __forceinline__ int crow(int r, int hi) { return (r & 3) + 8 * (r >> 2) + 4 * hi; }
__device__ __forceinline__ unsigned cvtpk(float lo, float hi) { unsigned r; asm volatile("s_nop 0\n\tv_cvt_pk_bf16_f32 %0, %1, %2" : "=v"(r) : "v"(lo), "v"(hi)); return r; }
__device__ __forceinline__ s16x4 vtr(const LAS unsigned char* p) { return __builtin_bit_cast(s16x4, __builtin_amdgcn_ds_read_tr16_b64_v4i16((LAS v4i16_t*)p)); }
constexpr int VROWB = 144;
constexpr float C2 = 0.125f * 1.4426950408889634f;
struct AttnP { const bf16* kbase; size_t kstride; int voff, j0, nsub; float slope2; };
struct AttnS { float m, l; f32x16 o0, o1; };
template <int NBLK, bool DIL>
__device__ __forceinline__ void attn_chunk(AttnS& st, const bf16x8 (&qf)[4], int kb0, const AttnP& P, LAS unsigned char* vl, int lane) {
    const int r32 = lane & 31, hh = lane >> 5;
    f32x16 sc[NBLK];
#pragma unroll
    for (int b = 0; b < NBLK; ++b) {
        int jk = P.j0 - 64 + 32 * (kb0 + b) + r32; jk = jk < 0 ? 0 : (jk > P.nsub - 1 ? P.nsub - 1 : jk);
        const bf16* kr = P.kbase + (size_t)jk * P.kstride + 8 * hh;
        bf16x8 kf[4];
#pragma unroll
        for (int ks = 0; ks < 4; ++ks) kf[ks] = *(const bf16x8*)(kr + 16 * ks);
        f32x16 a = {};
#pragma unroll
        for (int ks = 0; ks < 4; ++ks) a = __builtin_amdgcn_mfma_f32_32x32x16_bf16(kf[ks], qf[ks], a, 0, 0, 0);
        sc[b] = a;
    }
    float mc = -INFINITY;
    int dbase = 4 * hh - 64 - r32; asm volatile("" : "+v"(dbase));
    const int jbase = P.j0 + dbase + r32;
#pragma unroll
    for (int b = 0; b < NBLK; ++b)
#pragma unroll
        for (int r = 0; r < 16; ++r) {
            float v = sc[b][r] * C2;
            if (DIL) { const int kc = 32 * (kb0 + b) + (r & 3) + 8 * (r >> 2), df = dbase + kc, jk = jbase + kc, ad = df < 0 ? -df : df;
                v = (ad <= 64 && (unsigned)jk < (unsigned)P.nsub) ? v - P.slope2 * (float)ad : -INFINITY; }
            sc[b][r] = v; mc = fmaxf(mc, v);
        }
    mc = fmaxf(mc, __shfl_xor(mc, 32));
    const float mn = fmaxf(st.m, mc), alpha = __builtin_amdgcn_exp2f(st.m - mn); st.m = mn;
    float ps = 0.f;
#pragma unroll
    for (int b = 0; b < NBLK; ++b)
#pragma unroll
        for (int r = 0; r < 16; ++r) { const float pv = __builtin_amdgcn_exp2f(sc[b][r] - mn); sc[b][r] = pv; ps += pv; }
    ps += __shfl_xor(ps, 32);
    st.l = st.l * alpha + ps;
    st.o0 = st.o0 * alpha; st.o1 = st.o1 * alpha;
    const int G = lane >> 4, i16 = lane & 15;
    const LAS unsigned char* trb = vl + (4 * hh + (i16 >> 2)) * VROWB + (16 * (G & 1) + 4 * (i16 & 3)) * 2;
#pragma unroll
    for (int b = 0; b < NBLK; ++b) {
        v4u vv[4];
#pragma unroll
        for (int i = 0; i < 4; ++i) { const int row = (lane >> 3) + 8 * i; int jk = P.j0 - 64 + 32 * (kb0 + b) + row; jk = jk < 0 ? 0 : (jk > P.nsub - 1 ? P.nsub - 1 : jk);
            vv[i] = *(const v4u*)(P.kbase + (size_t)jk * P.kstride + P.voff + (lane & 7) * 8); }
#pragma unroll
        for (int i = 0; i < 4; ++i) *(LAS v4u*)(vl + ((lane >> 3) + 8 * i) * VROWB + (lane & 7) * 16) = vv[i];
        asm volatile("s_waitcnt lgkmcnt(0)" ::: "memory");
#pragma unroll
        for (int ss = 0; ss < 2; ++ss) {
            v4u pw; pw.x = cvtpk(sc[b][8 * ss + 0], sc[b][8 * ss + 1]); pw.y = cvtpk(sc[b][8 * ss + 2], sc[b][8 * ss + 3]); pw.z = cvtpk(sc[b][8 * ss + 4], sc[b][8 * ss + 5]); pw.w = cvtpk(sc[b][8 * ss + 6], sc[b][8 * ss + 7]);
            const bf16x8 pf = __builtin_bit_cast(bf16x8, pw);
            const s16x4 l0 = vtr(trb + (16 * ss) * VROWB), h0 = vtr(trb + (16 * ss + 8) * VROWB), l1 = vtr(trb + (16 * ss) * VROWB + 64), h1 = vtr(trb + (16 * ss + 8) * VROWB + 64);
            st.o0 = __builtin_amdgcn_mfma_f32_32x32x16_bf16((bf16x8){l0[0], l0[1], l0[2], l0[3], h0[0], h0[1], h0[2], h0[3]}, pf, st.o0, 0, 0, 0);
            st.o1 = __builtin_amdgcn_mfma_f32_32x32x16_bf16((bf16x8){l1[0], l1[1], l1[2], l1[3], h1[0], h1[1], h1[2], h1[3]}, pf, st.o1, 0, 0, 0);
        }
        asm volatile("" ::: "memory");
    }
}
__device__ __forceinline__ void memattn_fast(const Frame& F, const bf16* H, int ldh, int qoff, const bf16* MEMKV, bf16* CAT, int ldc, int coff) {
    LAS unsigned char* vl = F.lds + F.wave * 16384;
    const int lane = F.lane, r32 = lane & 31, hh = lane >> 5;
    for (int u = F.gw; u < NB * 4 * 64; u += NGW) {
        const int qb = u & 63, h = (u >> 6) & 3, bb = u >> 8, t = bb * SEQ + qb * 32 + r32;
        const bf16* qrow = H + (size_t)t * ldh + qoff + 64 * h + 8 * hh;
        bf16x8 qf[4];
#pragma unroll
        for (int ks = 0; ks < 4; ++ks) qf[ks] = *(const bf16x8*)(qrow + 16 * ks);
        AttnP P; P.kbase = MEMKV + (size_t)bb * ML * 512 + 64 * h; P.kstride = 512; P.voff = 256; P.j0 = 64; P.nsub = ML; P.slope2 = 0.f;
        AttnS st; st.m = -1.0e30f; st.l = 0.f; st.o0 = f32x16{}; st.o1 = f32x16{};
#pragma unroll 1
        for (int c = 0; c < 4; ++c) attn_chunk<2, false>(st, qf, 2 * c, P, vl, lane);
        const float inv = 1.f / st.l;
        bf16* orow = CAT + (size_t)t * ldc + coff + 64 * h + 4 * hh;
#pragma unroll
        for (int rg = 0; rg < 4; ++rg) {
            v2u a; a.x = cvtpk(st.o0[4 * rg] * inv, st.o0[4 * rg + 1] * inv); a.y = cvtpk(st.o0[4 * rg + 2] * inv, st.o0[4 * rg + 3] * inv); *(v2u*)(orow + 8 * rg) = a;
            v2u c; c.x = cvtpk(st.o1[4 * rg] * inv, st.o1[4 * rg + 1] * inv); c.y = cvtpk(st.o1[4 * rg + 2] * inv, st.o1[4 * rg + 3] * inv); *(v2u*)(orow + 32 + 8 * rg) = c;
        }
    }
}
__device__ __forceinline__ void dilattn_fast(const Frame& F, const bf16* H, float* OG, float* LSE) {
    LAS unsigned char* vl = F.lds + F.wave * 16384;
    const int lane = F.lane, r32 = lane & 31, hh = lane >> 5;
    for (int u = F.gw; u < NB * 4 * 3 * 64; u += NGW) {
        const int jr = u & 63, g = (u >> 6) % 3, bh = u / 192, h = bh & 3, bb = bh >> 2;
        const int dl = 1 << (2 * g), nsub = SEQ >> (2 * g), sh = 6 - 2 * g, r = jr >> sh, jblk = jr & ((1 << sh) - 1), j0 = 32 * jblk;
        const int t = bb * SEQ + (j0 + r32) * dl + r;
        const bf16* qrow = H + (size_t)t * 2560 + 256 * g + 64 * h + 8 * hh;
        bf16x8 qf[4];
#pragma unroll
        for (int ks = 0; ks < 4; ++ks) qf[ks] = *(const bf16x8*)(qrow + 16 * ks);
        AttnP P; P.kbase = H + (size_t)(bb * SEQ + r) * 2560 + 768 + 256 * g + 64 * h; P.kstride = (size_t)dl * 2560; P.voff = 768; P.j0 = j0; P.nsub = nsub;
        P.slope2 = exp2f(-8.f * (float)(4 * g + h + 1) / 12.f) * (float)dl * 1.4426950408889634f;
        AttnS st; st.m = -1.0e30f; st.l = 0.f; st.o0 = f32x16{}; st.o1 = f32x16{};
        attn_chunk<2, true>(st, qf, 0, P, vl, lane);
        attn_chunk<2, true>(st, qf, 2, P, vl, lane);
        attn_chunk<1, true>(st, qf, 4, P, vl, lane);
        const float inv = 1.f / st.l;
        float* orow = OG + ((size_t)g * T + t) * 256 + 64 * h + 4 * hh;
#pragma unroll
        for (int rg = 0; rg < 4; ++rg) {
            *(f32x4*)(orow + 8 * rg) = (f32x4){st.o0[4 * rg] * inv, st.o0[4 * rg + 1] * inv, st.o0[4 * rg + 2] * inv, st.o0[4 * rg + 3] * inv};
            *(f32x4*)(orow + 32 + 8 * rg) = (f32x4){st.o1[4 * rg] * inv, st.o1[4 * rg + 1] * inv, st.o1[4 * rg + 2] * inv, st.o1[4 * rg + 3] * inv};
        }
        if (hh == 0) LSE[((size_t)g * T + t) * 4 + h] = st.m + __builtin_amdgcn_logf(st.l);
    }
}
__device__ __forceinline__ void merge_phase(const Frame& F, const float* OG, const float* LSE, bf16* CAT) {
    const size_t gt = (size_t)blockIdx.x * NTHREADS + F.tid, NT = (size_t)GRID * NTHREADS;
    for (size_t it = gt; it < (size_t)T * 32; it += NT) {
        const int t = (int)(it >> 5), c8 = (int)(it & 31) * 8, h = c8 >> 6;
        const float l0 = LSE[(size_t)t * 4 + h], l1 = LSE[((size_t)T + t) * 4 + h], l2 = LSE[((size_t)2 * T + t) * 4 + h];
        const float mx = fmaxf(l0, fmaxf(l1, l2)); float w0 = __builtin_amdgcn_exp2f(l0 - mx), w1 = __builtin_amdgcn_exp2f(l1 - mx), w2 = __builtin_amdgcn_exp2f(l2 - mx);
        const float inv = 1.f / (w0 + w1 + w2); w0 *= inv; w1 *= inv; w2 *= inv;
        const f32x4* p0 = (const f32x4*)(OG + (size_t)t * 256 + c8); const f32x4* p1 = (const f32x4*)(OG + ((size_t)T + t) * 256 + c8); const f32x4* p2 = (const f32x4*)(OG + ((size_t)2 * T + t) * 256 + c8);
        const f32x4 a = p0[0] * w0 + p1[0] * w1 + p2[0] * w2, b = p0[1] * w0 + p1[1] * w1 + p2[1] * w2;
        v4u o; o.x = pk2(a.x, a.y); o.y = pk2(a.z, a.w); o.z = pk2(b.x, b.y); o.w = pk2(b.z, b.w);
        *(v4u*)(CAT + (size_t)t * 512 + c8) = o;
    }
}

constexpr int NPHASE = 34;
__global__ void __launch_bounds__(NTHREADS, 2) mega(Args args) {
    extern __shared__ __attribute__((aligned(16))) unsigned char lds[];
    Frame F; F.lds = (LAS unsigned char*)lds; F.tid = threadIdx.x; F.lane = F.tid & 63; F.wave = __builtin_amdgcn_readfirstlane(F.tid >> 6); F.gw = blockIdx.x * NWAVES + F.wave;
    volatile LAS unsigned* MISC = (volatile LAS unsigned*)(F.lds + MISC_OFF);
    unsigned char* ws = args.ws;
    unsigned* ctl = (unsigned*)(ws + WS_CTL);
    for (int u = F.tid; u < (LDS_BYTES - LDSCTL_OFF) / 4; u += NTHREADS) ((LAS unsigned*)(F.lds + LDSCTL_OFF))[u] = 0u;
    __syncthreads();
    const int lo = args.lo, hi = args.hi;
    XcdBarrier bar; bar.bar = ctl + CW_BAR; bar.x = 0; bar.st = nullptr;
    if (hi - lo > 1) bar = xcd_barrier_post(ctl + CW_BAR, MISC + 8);
#define IN(k) (lo <= (k) && (k) < hi)
#define SEAM(k) do { if (IN(k) && IN((k) + 1)) xcd_barrier(bar); else __syncthreads(); } while (0)
    const float* x_in = args.in[I_X]; float* XR = args.out;
    int* cntWG = (int*)(ws + WS_META); int* tile_e = (int*)(ws + WS_META + 16384); int* nMp = (int*)(ws + WS_META + 32768);
    int* E01 = (int*)(ws + WS_TOK); float* W01 = (float*)(ws + WS_TOK + 262144); int* DEST = (int*)(ws + WS_TOK + 524288);
    bf16* XB = (bf16*)(ws + WS_XB); bf16* MEMB = (bf16*)(ws + WS_MEMB); bf16* MEMKV = (bf16*)(ws + WS_MEMKV);
    bf16* Hb = (bf16*)(ws + WS_SCR + SC_H); bf16* CAT = (bf16*)(ws + WS_SCR + SC_CAT); bf16* DIFF = (bf16*)(ws + WS_SCR + SC_DIFF); float* OG = (float*)(ws + WS_SCR + SC_OG); float* LSE = (float*)(ws + WS_SCR + SC_LSE);
    bf16* HID = (bf16*)(ws + WS_SCR + SC_HID); bf16* XS = (bf16*)(ws + WS_SCR + SC_XS); bf16* HS = (bf16*)(ws + WS_SCR + SC_HS); bf16* YB = XS;
    const float* ln_g = args.in[I_LNG]; const float* ln_b = args.in[I_LNB];

    bf16* WSM = (bf16*)(ws + WS_WS); bf16* WMOE = (bf16*)(ws + WS_WMOE);
#if FAST_ATTN
#define MEMATTN memattn_fast
#else
#define MEMATTN memattn_naive
#endif
#if FAST_GEMM
#define GEMM_BF16(A_, B_, M_, N_, K_, O_) do { pg8::Gemm g_{A_, B_, M_, N_, K_}; pg8::StaticOrder S_; S_.init(M_, N_, GRID, (int)blockIdx.x); pg8::EpiBf16<0> E_{O_, N_, nullptr, 0, 0, 1.f}; \
        pg8::gemm_phase<pg8::EpiBf16<0>, pg8::StaticOrder, true, true>(F.lds, g_, S_, E_); } while (0)
#define GEMM_RESID(A_, B_, K_, BASE_) do { pg8::Gemm g_{A_, B_, T, D, K_}; pg8::StaticOrder S_; S_.init(T, D, GRID, (int)blockIdx.x); pg8::EpiResid E_{BASE_, XR, D, ALPHA}; \
        pg8::gemm_phase<pg8::EpiResid, pg8::StaticOrder, true, true>(F.lds, g_, S_, E_); } while (0)
#define GEMM_SWIGLU(A_, B_, M_, NH_, O_) do { pg8::Gemm g_{A_, B_, M_, 2 * (NH_), D}; pg8::StaticOrder S_; S_.init(M_, 2 * (NH_), GRID, (int)blockIdx.x); pg8::EpiSwiglu E_{O_, NH_}; \
        pg8::gemm_phase<pg8::EpiSwiglu, pg8::StaticOrder, true, true>(F.lds, g_, S_, E_); } while (0)
#define GEMM_MOE_GU() do { const int nM_ = ld_i32_agent(nMp); pg8::Gemm g_{XS, WMOE + OFF_MGU, nM_ * 256, 2 * FFE, D}; pg8::MoeOrder S_; S_.init(nM_ * 256, 2 * FFE, GRID, (int)blockIdx.x); S_.tile_e = tile_e; S_.estride = (size_t)2 * FFE * D; \
        pg8::EpiSwiglu E_{HS, FFE}; pg8::gemm_phase<pg8::EpiSwiglu, pg8::MoeOrder, true, true>(F.lds, g_, S_, E_); } while (0)
#define GEMM_MOE_D() do { const int nM_ = ld_i32_agent(nMp); pg8::Gemm g_{HS, WMOE + OFF_MD, nM_ * 256, D, FFE}; pg8::MoeOrder S_; S_.init(nM_ * 256, D, GRID, (int)blockIdx.x); S_.tile_e = tile_e; S_.estride = (size_t)D * FFE; \
        pg8::EpiBf16<0> E_{YB, D, nullptr, 0, 0, 1.f}; pg8::gemm_phase<pg8::EpiBf16<0>, pg8::MoeOrder, true, true>(F.lds, g_, S_, E_); } while (0)
#endif

    if (IN(0)) { prep_phase(F, x_in, args.in[I_MEM], XB, MEMB);
#if FAST_GEMM
        { int rot = 0; convert_small(F, args, WSM, rot); convert_moe(F, args.in[I_MG], args.in[I_MU], args.in[I_MD], WMOE, rot); fold_pool(F, args.in[I_CPOOLW], args.in[I_CPOOLS], args.in[I_CWOUT], WSM + OFF_COUT); }
#endif
        SEAM(0); }
    if (IN(1)) {
#if FAST_GEMM
        GEMM_BF16(MEMB, WSM + OFF_WKV, NB * ML, 512, D, MEMKV);
#else
        naive_gemm<1>(F, MEMB, D, args.in[I_WMEMKV], nullptr, 512, NB * ML, 512, D, NEpiBf16{MEMKV, 512}, nullptr, 0);
#endif
        SEAM(1); }

    if (IN(2)) {
#if FAST_GEMM
        GEMM_BF16(XB, WSM + OFF_AIN, T, 2560, D, Hb);
#else
        naive_gemm<1>(F, XB, D, args.in[I_AWIN], nullptr, 2560, T, 2560, D, NEpiBf16{Hb, 2560}, nullptr, 0);
#endif
        SEAM(2); }
    if (IN(3)) { mixA_phase(F, Hb, args.in[I_ACONV], CAT); MEMATTN(F, Hb, 2560, 2304, MEMKV, CAT, 1024, 768); SEAM(3); }
    if (IN(4)) {
#if FAST_GEMM
        GEMM_RESID(CAT, WSM + OFF_AOUT, 1024, x_in);
#else
        naive_gemm<1>(F, CAT, 1024, args.in[I_AWOUT], nullptr, D, T, D, 1024, NEpiResid{x_in, XR}, nullptr, 0);
#endif
        SEAM(4); }
    if (IN(5)) { ln_phase<false, false>(F, XR, XB, ln_g + 0 * D, ln_b + 0 * D, nullptr, nullptr, nullptr, nullptr, nullptr, nullptr); SEAM(5); }
    if (IN(6)) {
#if FAST_GEMM
        GEMM_SWIGLU(XB, WSM + OFF_FGU, T, FF, HID);
#else
        naive_gemm<2>(F, XB, D, args.in[I_FG], args.in[I_FU], FF, T, FF, D, NEpiSwiglu{HID, FF}, nullptr, 0);
#endif
        SEAM(6); }
    if (IN(7)) {
#if FAST_GEMM
        GEMM_RESID(HID, WSM + OFF_FD, FF, XR);
#else
        naive_gemm<1>(F, HID, FF, args.in[I_FD], nullptr, D, T, D, FF, NEpiResid{XR, XR}, nullptr, 0);
#endif
        SEAM(7); }
    if (IN(8)) { ln_phase<false, false>(F, XR, XB, ln_g + 1 * D, ln_b + 1 * D, nullptr, nullptr, nullptr, nullptr, nullptr, nullptr); SEAM(8); }

    if (IN(9)) {
#if FAST_GEMM
        GEMM_BF16(XB, WSM + OFF_BIN, T, 2560, D, Hb);
#else
        naive_gemm<1>(F, XB, D, args.in[I_BWIN], nullptr, 2560, T, 2560, D, NEpiBf16{Hb, 2560}, nullptr, 0);
#endif
        SEAM(9); }
#if FAST_ATTN
    if (IN(10)) { dilattn_fast(F, Hb, OG, LSE); MEMATTN(F, Hb, 2560, 2304, MEMKV, CAT, 512, 256); SEAM(10); }
    if (IN(11)) { merge_phase(F, OG, LSE, CAT); SEAM(11); }
#else
    if (IN(10)) { dilattn_naive(F, Hb, CAT, 512); MEMATTN(F, Hb, 2560, 2304, MEMKV, CAT, 512, 256); SEAM(10); }
    if (IN(11)) { SEAM(11); }
#endif
    if (IN(12)) {
#if FAST_GEMM
        GEMM_RESID(CAT, WSM + OFF_BOUT, 512, XR);
#else
        naive_gemm<1>(F, CAT, 512, args.in[I_BWOUT], nullptr, D, T, D, 512, NEpiResid{XR, XR}, nullptr, 0);
#endif
        SEAM(12); }
    if (IN(13)) { ln_phase<true, false>(F, XR, XB, ln_g + 2 * D, ln_b + 2 * D, args.in[I_ROUTER], E01, W01, nullptr, nullptr, cntWG); SEAM(13); }
    if (IN(14)) { scatter_phase(F, cntWG, E01, DEST, XB, XS, tile_e, nMp); SEAM(14); }
    if (IN(15)) {
#if FAST_GEMM
        GEMM_MOE_GU();
#else
        const int nM = ld_i32_agent(nMp); naive_gemm<2>(F, XS, D, args.in[I_MG], args.in[I_MU], FFE, nM * 256, FFE, D, NEpiSwiglu{HS, FFE}, tile_e, (size_t)D * FFE);
#endif
        SEAM(15); }
    if (IN(16)) {
#if FAST_GEMM
        GEMM_MOE_D();
#else
        const int nM = ld_i32_agent(nMp); naive_gemm<1>(F, HS, FFE, args.in[I_MD], nullptr, D, nM * 256, D, FFE, NEpiBf16{YB, D}, tile_e, (size_t)FFE * D);
#endif
        SEAM(16); }
    if (IN(17)) { ln_phase<false, true>(F, XR, XB, ln_g + 3 * D, ln_b + 3 * D, nullptr, nullptr, W01, DEST, YB, nullptr); SEAM(17); }

    if (IN(18)) {
#if FAST_GEMM
        GEMM_BF16(XB, WSM + OFF_CIN, T, 1024, D, Hb);
#else
        naive_gemm<1>(F, XB, D, args.in[I_CWIN], nullptr, 1024, T, 1024, D, NEpiBf16{Hb, 1024}, nullptr, 0);
#endif
        SEAM(18); }
#if FAST_GEMM
    if (IN(19)) { poolC_phase(F, Hb, CAT, 1024); MEMATTN(F, Hb, 1024, 768, MEMKV, CAT, 1024, 768);
        { int rot = 0; convert_moe(F, args.in[I_MG] + (size_t)NE * D * FFE, args.in[I_MU] + (size_t)NE * D * FFE, args.in[I_MD] + (size_t)NE * FFE * D, WMOE, rot); }
        SEAM(19); }
    if (IN(20)) { SEAM(20); }
#else
    if (IN(19)) { poolC_phase(F, Hb, DIFF, 768); MEMATTN(F, Hb, 1024, 768, MEMKV, CAT, 1024, 768); SEAM(19); }
    if (IN(20)) {
#pragma unroll 1
        for (int g = 0; g < 4; ++g) naive_gemm<1>(F, DIFF + 192 * g, 768, args.in[I_CPOOLW] + (size_t)g * 192 * 192, nullptr, 192, T, 192, 192, NEpiScale{CAT, 1024, 192 * g, args.in[I_CPOOLS]}, nullptr, 0);
        SEAM(20); }
#endif
    if (IN(21)) {
#if FAST_GEMM
        GEMM_RESID(CAT, WSM + OFF_COUT, 1024, XR);
#else
        naive_gemm<1>(F, CAT, 1024, args.in[I_CWOUT], nullptr, D, T, D, 1024, NEpiResid{XR, XR}, nullptr, 0);
#endif
        SEAM(21); }
    if (IN(22)) { ln_phase<false, false>(F, XR, XB, ln_g + 4 * D, ln_b + 4 * D, nullptr, nullptr, nullptr, nullptr, nullptr, nullptr); SEAM(22); }
    if (IN(23)) {
#if FAST_GEMM
        GEMM_SWIGLU(XB, WSM + OFF_FGU + (size_t)2 * FF * D, T, FF, HID);
#else
        naive_gemm<2>(F, XB, D, args.in[I_FG] + (size_t)D * FF, args.in[I_FU] + (size_t)D * FF, FF, T, FF, D, NEpiSwiglu{HID, FF}, nullptr, 0);
#endif
        SEAM(23); }
    if (IN(24)) {
#if FAST_GEMM
        GEMM_RESID(HID, WSM + OFF_FD + (size_t)D * FF, FF, XR);
#else
        naive_gemm<1>(F, HID, FF, args.in[I_FD] + (size_t)FF * D, nullptr, D, T, D, FF, NEpiResid{XR, XR}, nullptr, 0);
#endif
        SEAM(24); }
    if (IN(25)) { ln_phase<false, false>(F, XR, XB, ln_g + 5 * D, ln_b + 5 * D, nullptr, nullptr, nullptr, nullptr, nullptr, nullptr); SEAM(25); }

    if (IN(26)) {
#if FAST_GEMM
        GEMM_BF16(XB, WSM + OFF_AIN + (size_t)2560 * D, T, 2560, D, Hb);
#else
        naive_gemm<1>(F, XB, D, args.in[I_AWIN] + (size_t)D * 2560, nullptr, 2560, T, 2560, D, NEpiBf16{Hb, 2560}, nullptr, 0);
#endif
        SEAM(26); }
    if (IN(27)) { mixA_phase(F, Hb, args.in[I_ACONV] + 3 * 768, CAT); MEMATTN(F, Hb, 2560, 2304, MEMKV, CAT, 1024, 768); SEAM(27); }
    if (IN(28)) {
#if FAST_GEMM
        GEMM_RESID(CAT, WSM + OFF_AOUT + (size_t)D * D, 1024, XR);
#else
        naive_gemm<1>(F, CAT, 1024, args.in[I_AWOUT] + (size_t)D * D, nullptr, D, T, D, 1024, NEpiResid{XR, XR}, nullptr, 0);
#endif
        SEAM(28); }
    if (IN(29)) { ln_phase<true, false>(F, XR, XB, ln_g + 6 * D, ln_b + 6 * D, args.in[I_ROUTER] + D * NE, E01, W01, nullptr, nullptr, cntWG); SEAM(29); }
    if (IN(30)) { scatter_phase(F, cntWG, E01, DEST, XB, XS, tile_e, nMp); SEAM(30); }
    if (IN(31)) {
#if FAST_GEMM
        GEMM_MOE_GU();
#else
        const int nM = ld_i32_agent(nMp); naive_gemm<2>(F, XS, D, args.in[I_MG] + (size_t)NE * D * FFE, args.in[I_MU] + (size_t)NE * D * FFE, FFE, nM * 256, FFE, D, NEpiSwiglu{HS, FFE}, tile_e, (size_t)D * FFE);
#endif
        SEAM(31); }
    if (IN(32)) {
#if FAST_GEMM
        GEMM_MOE_D();
#else
        const int nM = ld_i32_agent(nMp); naive_gemm<1>(F, HS, FFE, args.in[I_MD] + (size_t)NE * FFE * D, nullptr, D, nM * 256, D, FFE, NEpiBf16{YB, D}, tile_e, (size_t)FFE * D);
#endif
        SEAM(32); }
    if (IN(33)) { ln_phase<false, true>(F, XR, XB, ln_g + 7 * D, ln_b + 7 * D, nullptr, nullptr, W01, DEST, YB, nullptr); }
#undef IN
#undef SEAM
}

extern "C" void kernel_launch(void* const* d_in, const int* in_sizes, int n_in, void* d_out, int out_size, void* d_ws, size_t ws_size, hipStream_t stream) {
    static int ok = 0;
    if (ok == 0) {
        ok = 1;
        if (n_in != 21 || out_size != T * D || ws_size < WS_END) { fprintf(stderr, "kernel_launch: unexpected shapes (n_in %d, out %d, ws %zu < %zu)\n", n_in, out_size, ws_size, (size_t)WS_END); ok = -1; }
        if (ok > 0 && hipFuncSetAttribute((const void*)mega, hipFuncAttributeMaxDynamicSharedMemorySize, LDS_BYTES) != hipSuccess) { fprintf(stderr, "kernel_launch: hipFuncSetAttribute failed\n"); ok = -1; }
        int dev = 0, cus = 0; (void)hipGetDevice(&dev); (void)hipDeviceGetAttribute(&cus, hipDeviceAttributeMultiprocessorCount, dev);
        if (cus < GRID) { fprintf(stderr, "kernel_launch: %d CUs < %d\n", cus, GRID); ok = -1; }
        (void)hipGetLastError();
    }
    if (ok < 0) return;
    (void)hipMemsetAsync((char*)d_ws + WS_CTL, 0, CTL_ZERO_BYTES, stream);
    Args a{};
    for (int i = 0; i < 21; ++i) a.in[i] = (const float*)d_in[i];
    a.out = (float*)d_out; a.ws = (unsigned char*)d_ws;
#if MK_ONE_LAUNCH
    a.lo = 0; a.hi = NPHASE;
    hipLaunchKernelGGL(mega, dim3(GRID), dim3(NTHREADS), LDS_BYTES, stream, a);
#else
    for (int p = 0; p < NPHASE; ++p) { if (p == 11) continue; a.lo = p; a.hi = p + 1; hipLaunchKernelGGL(mega, dim3(GRID), dim3(NTHREADS), LDS_BYTES, stream, a); }
#endif
}
```

```cpp
#include <hip/hip_runtime.h>
#include <cstdio>
#include <cstdint>

#ifndef MK_ONE_LAUNCH
#define MK_ONE_LAUNCH 1
#endif
#ifndef FAST_GEMM
#define FAST_GEMM 1
#endif
#ifndef FAST_ATTN
#define FAST_ATTN 1
#endif

#ifndef PROBE
#define PROBE 0
#endif

#ifndef FP8_MOE
#define FP8_MOE 1
#endif
#define FP8_GU (FP8_MOE == 1 || FP8_MOE == 2)
#define FP8_D  (FP8_MOE == 1 || FP8_MOE == 3)
#ifndef EMU_FP8
#define EMU_FP8 0
#endif

#define GAS __attribute__((address_space(1)))
#define LAS __attribute__((address_space(3)))
typedef unsigned short bf16;
typedef unsigned v4u __attribute__((ext_vector_type(4)));
typedef unsigned v2u __attribute__((ext_vector_type(2)));
typedef float f32x4 __attribute__((ext_vector_type(4)));
typedef float f32x2 __attribute__((ext_vector_type(2)));
typedef float f32x16 __attribute__((ext_vector_type(16)));
typedef short bf16x8 __attribute__((ext_vector_type(8)));
typedef short s16x4 __attribute__((ext_vector_type(4)));
#define RLX_AGENT __ATOMIC_RELAXED, __HIP_MEMORY_SCOPE_AGENT
#define LDS_WAIT() asm volatile("s_waitcnt lgkmcnt(0)" ::: "memory")
#define VM_WAIT() asm volatile("s_waitcnt vmcnt(0)" ::: "memory")

constexpr int NB = 16, SEQ = 2048, T = NB * SEQ, D = 1024, ML = 256, MEMW = 256, MIXW = 768, HD = 64;
constexpr int FF = 2816, FFE = 3584, NE = 8;
constexpr int RMAX = (2 * T / 256 + NE) * 256;
constexpr float ALPHA = 1.6817928305074290f;
constexpr float LN_EPS = 1e-5f;
constexpr int NWAVES = 8, NTHREADS = 512, GRID = 256, NGW = GRID * NWAVES;

constexpr size_t MiB = 1u << 20;
constexpr size_t WS_CTL = 0, CTL_ZERO_BYTES = 1 * MiB;
constexpr size_t WS_META = 1 * MiB;
constexpr size_t WS_TOK = 2 * MiB;
constexpr size_t WS_WS = 4 * MiB;
constexpr size_t WS_WMOE = 64 * MiB;
constexpr size_t WS_XB = 232 * MiB;
constexpr size_t WS_MEMB = 296 * MiB;
constexpr size_t WS_MEMKV = 304 * MiB;
constexpr size_t WS_SCR = 308 * MiB;
constexpr size_t SC_H = 0, SC_CAT = 160 * MiB, SC_OG = 224 * MiB, SC_LSE = 320 * MiB, SC_DIFF = 224 * MiB;
constexpr size_t SC_HID = 0;
constexpr size_t SC_XS = 0, SC_HS = 132 * MiB;
constexpr size_t WS_END = WS_SCR + SC_HS + (size_t)RMAX * FFE * 2;
static_assert(WS_END <= 903 * MiB, "ws map");
constexpr size_t OFF_WKV = 0, OFF_AIN = 524288, OFF_AOUT = 5767168, OFF_BIN = 7864320, OFF_BOUT = 10485760, OFF_CIN = 11010048,
                 OFF_COUT = 12058624, OFF_FGU = 13107200, OFF_FD = 24641536, OFF_WS_END = 30408704;
static_assert(OFF_WS_END * 2 <= 60 * MiB, "small weights");
constexpr size_t OFF_MGU = 0, OFF_MD = (size_t)NE * 2 * FFE * D;
constexpr int CW_BAR = 4096;

constexpr int RING_BYTES = 131072, LDSCTL_OFF = RING_BYTES, MISC_OFF = LDSCTL_OFF + 320, LDS_BYTES = 147456;

__device__ __forceinline__ unsigned f2bf(float f) { unsigned u = __builtin_bit_cast(unsigned, f); return (u + 0x7fffu + ((u >> 16) & 1u)) >> 16; }
__device__ __forceinline__ float q8(float x) { const float ax = fabsf(x); if (ax < 0.015625f) return copysignf(rintf(ax * 512.f) * (1.f / 512.f), x); if (ax > 448.f) return copysignf(448.f, x);
    unsigned u = __builtin_bit_cast(unsigned, x); u += 0x7FFFFu + ((u >> 20) & 1u); u &= 0xFFF00000u; return __builtin_bit_cast(float, u); }
__device__ __forceinline__ unsigned pk2(float lo, float hi) { return f2bf(lo) | (f2bf(hi) << 16); }
__device__ __forceinline__ float bf2f(unsigned b) { return __builtin_bit_cast(float, b << 16); }
__device__ __forceinline__ float bflo(unsigned w) { return __builtin_bit_cast(float, w << 16); }
__device__ __forceinline__ float bfhi(unsigned w) { return __builtin_bit_cast(float, w & 0xffff0000u); }
__device__ __forceinline__ float wave_sum(float v) {
#pragma unroll
    for (int o = 1; o < 64; o <<= 1) v += __shfl_xor(v, o);
    return v;
}
__device__ __forceinline__ int ld_i32_agent(const int* p) { return (int)__hip_atomic_load((const unsigned*)p, RLX_AGENT); }
__device__ __forceinline__ float ld_f32_agent(const float* p) { return __builtin_bit_cast(float, __hip_atomic_load((const unsigned*)p, RLX_AGENT)); }

#define XB_TMO      128
#define XB_XCNT(j)  (256  + 64 * (j))
#define XB_XSUB(j)  (1280 + 64 * (j))
#define XB_XGEN(j)  (2304 + 64 * (j))
#define XB_TOP      3328
#define XB_TOPGEN   3392
#define XCD_BAR_WORDS 3456
#define XB_SPIN_CAP (1u << 18)
__device__ __forceinline__ unsigned xb_ld(unsigned* p)              { return __hip_atomic_load(p, __ATOMIC_RELAXED, __HIP_MEMORY_SCOPE_AGENT); }
__device__ __forceinline__ unsigned xb_add(unsigned* p, unsigned v) { return __hip_atomic_fetch_add(p, v, __ATOMIC_RELAXED, __HIP_MEMORY_SCOPE_AGENT); }
__device__ __forceinline__ unsigned xb_xcc_id() { return (unsigned)__builtin_amdgcn_s_getreg((3 << 11) | 20) & 0xFu; }
#define XB_SPIN(cond, bar) do { unsigned _sp = 0; while (cond) { __builtin_amdgcn_s_sleep(1); \
    if ((++_sp & 255u) == 0u) { if (xb_ld(&(bar)[XB_TMO])) break; if (_sp > XB_SPIN_CAP) { atomicAdd(&(bar)[XB_TMO], 1u); break; } } } } while (0)
struct XcdBarrier { unsigned* bar; unsigned x; volatile LAS unsigned* st; };
__device__ __forceinline__ XcdBarrier xcd_barrier_post(unsigned* bar, volatile LAS unsigned* st) {
    XcdBarrier b; b.bar = bar; b.x = xb_xcc_id(); b.st = st;
    if (threadIdx.x == 0) (void)xb_add(&bar[XB_XCNT(b.x)], 1u);
    return b;
}
__device__ __forceinline__ void xcd_barrier_complete(unsigned* bar, unsigned x, unsigned& nloc, unsigned& nx) {
    const unsigned G = gridDim.x * gridDim.y * gridDim.z;
    unsigned sum, cnt, mine, sp = 0u;
    for (;;) {
        sum = 0u; cnt = 0u; mine = 0u;
#pragma unroll
        for (unsigned j = 0; j < 16; ++j) { const unsigned c = xb_ld(&bar[XB_XCNT(j)]); sum += c; cnt += (c > 0u) ? 1u : 0u; mine = (j == x) ? c : mine; }
        if (sum == G) break;
        __builtin_amdgcn_s_sleep(1);
        if ((++sp & 255u) == 0u) { if (xb_ld(&bar[XB_TMO])) break; if (sp > XB_SPIN_CAP) { atomicAdd(&bar[XB_TMO], 1u); break; } }
    }
    nloc = mine > 0u ? mine : 1u; nx = cnt > 0u ? cnt : 1u;
}
__device__ __forceinline__ void xcd_barrier(const XcdBarrier& b) {
    asm volatile("s_waitcnt vmcnt(0)" ::: "memory");
    __syncthreads();
    if (threadIdx.x == 0) {
        unsigned* bar = b.bar;
        __builtin_amdgcn_s_waitcnt(0);
        unsigned nloc = b.st[0], nx = b.st[1];
        if (nloc == 0u) { xcd_barrier_complete(bar, b.x, nloc, nx); b.st[0] = nloc; b.st[1] = nx; }
        const unsigned old = xb_add(&bar[XB_XSUB(b.x)], 1u);
        const unsigned gen = old / nloc;
        if (old + 1u == (gen + 1u) * nloc) {
            __builtin_amdgcn_fence(__ATOMIC_RELEASE, "agent");
            asm volatile("s_waitcnt vmcnt(0)" ::: "memory");
            const unsigned og = xb_add(&bar[XB_TOP], 1u);
            const unsigned tg = og / nx;
            if (og + 1u == (tg + 1u) * nx) xb_add(&bar[XB_TOPGEN], 1u);
            else XB_SPIN(xb_ld(&bar[XB_TOPGEN]) == tg, bar);
            __builtin_amdgcn_fence(__ATOMIC_ACQUIRE, "agent");
            xb_add(&bar[XB_XGEN(b.x)], 1u);
            asm volatile("s_waitcnt vmcnt(0)" ::: "memory");
        } else {
            XB_SPIN(xb_ld(&bar[XB_XGEN(b.x)]) == gen, bar);
            __builtin_amdgcn_fence(__ATOMIC_ACQUIRE, "agent");
            asm volatile("s_waitcnt vmcnt(0)" ::: "memory");
        }
    }
    __syncthreads();
}

namespace pg8 {
#define PG8_LAS __attribute__((address_space(3)))
typedef unsigned short bf16_t;
typedef short bf16x8 __attribute__((ext_vector_type(8)));
typedef float f32x4 __attribute__((ext_vector_type(4)));
typedef unsigned u32x4 __attribute__((ext_vector_type(4)));
constexpr int BM = 256, BK = 64, HALF = 128, HTB = HALF * BK * 2  , STAGE_BYTES = 8 * HTB, NXCD = 8, WGM = 8;

__host__ __device__ __forceinline__ int lds_byte(int r, int c) { const int st = (r >> 4) * 2 + (c >> 5), rr = r & 15, cc = c & 31, ob = rr * 64 + cc * 2; return st * 1024 + (ob ^ (((ob >> 9) & 1) << 5)); }
__host__ __device__ __forceinline__ void stage_rc(int b, int& R, int& C) { const int st = b / 1024, sb = b % 1024, swz = sb ^ (((sb >> 9) & 1) << 5); R = (st >> 1) * 16 + swz / 64; C = (st & 1) * 32 + (swz % 64) / 2; }
__host__ __device__ __forceinline__ int perm32(int rho) { const int n = rho >> 4, i = rho & 15; return 8 * (i >> 2) + 4 * n + (i & 3); }

struct Unit { int pm, pn; };
struct Gemm { const bf16_t* A; const bf16_t* Bt; int M, N, K; int wscale; };
typedef int v8i __attribute__((ext_vector_type(8)));
typedef int v4i __attribute__((ext_vector_type(4)));
__device__ __forceinline__ void mfma8(f32x4& acc, const v8i& a, const v8i& b, int sa, int sb) {
    asm volatile("s_nop 1\n\tv_mfma_scale_f32_16x16x128_f8f6f4 %0, %1, %2, %0, %3, %4 op_sel_hi:[0,0,0]" : "+v"(acc) : "v"(a), "v"(b), "v"(sa), "v"(sb)); }
__device__ __forceinline__ bf16x8 lo8(const v8i v) { const v4i t = __builtin_shufflevector(v, v, 0, 1, 2, 3); return __builtin_bit_cast(bf16x8, t); }
__device__ __forceinline__ bf16x8 hi8(const v8i v) { const v4i t = __builtin_shufflevector(v, v, 4, 5, 6, 7); return __builtin_bit_cast(bf16x8, t); }
__device__ __forceinline__ v8i cat8(bf16x8 a, bf16x8 b) { return __builtin_shufflevector(__builtin_bit_cast(v4i, a), __builtin_bit_cast(v4i, b), 0, 1, 2, 3, 4, 5, 6, 7); }

struct StaticOrder {
    int nM, nN, nwg, G, c;
    __host__ __device__ void init(int M, int N, int G_, int c_) { nM = M / BM; nN = N / BM; nwg = nM * nN; G = G_; c = c_; }
    __host__ __device__ bool next(int i, Unit& u) const {
        const long L = (long)i * G + c; if (L >= nwg) return false;
        int wgid = (int)L; { const int q = nwg / NXCD, r = nwg % NXCD, xcd = wgid % NXCD, off = wgid / NXCD; wgid = (xcd < r ? xcd * (q + 1) : r * (q + 1) + (xcd - r) * q) + off; }
        const int nig = WGM * nN, gid = wgid / nig, fm = gid * WGM, gsz = (nM - fm) < WGM ? (nM - fm) : WGM;
        u.pm = fm + ((wgid % nig) % gsz); u.pn = (wgid % nig) / gsz; return true;
    }
    __device__ __forceinline__ void a_ready(const Unit&) const {}
    __device__ __forceinline__ void done(const Unit&) const {}
    __device__ __forceinline__ size_t boff(const Unit&) const { return 0; }
};
struct MoeOrder : StaticOrder {
    const int* tile_e; size_t estride;
    __device__ __forceinline__ size_t boff(const Unit& u) const { return (size_t)__builtin_amdgcn_readfirstlane((int)__hip_atomic_load((const unsigned*)tile_e + u.pm, __ATOMIC_RELAXED, __HIP_MEMORY_SCOPE_AGENT)) * estride; }
};

__device__ __forceinline__ unsigned cvt_pk_bf16(float lo, float hi) { unsigned r; asm volatile("v_cvt_pk_bf16_f32 %0, %1, %2" : "=v"(r) : "v"(lo), "v"(hi)); return r; }
typedef float f32x2 __attribute__((ext_vector_type(2)));
template <int ACT  > struct EpiBf16 {
    static constexpr bool PERM = true, AFTER_DRAIN = false; static_assert(ACT == 0, "EpiBf16: ACT is 0");
    bf16_t* O; int ldc; const float* bias; int split_cols; size_t split_stride; float scale0;
    __device__ __forceinline__ void operator()(const f32x4 (&acc)[2][2][4][2], const Unit& u, int wr, int wc, int fr, int fq) const {
        const int row0 = u.pm * BM + wr * 64 + fr; int colt = u.pn * BM; bf16_t* base = O;
        float sc = scale0; if (split_cols) { const int t = colt / split_cols; base += (size_t)t * split_stride; colt -= t * split_cols; if (t != 0) sc = 1.f; }
        const int col0 = colt + wc * 32 + 8 * fq, bcol0 = u.pn * BM + wc * 32 + 8 * fq;
        f32x4 bv[2][2];
#pragma unroll
        for (int bj = 0; bj < 2; ++bj)
#pragma unroll
            for (int n = 0; n < 2; ++n) bv[bj][n] = bias ? *(const f32x4*)(bias + bcol0 + bj * HALF + 4 * n) : (f32x4){0.f, 0.f, 0.f, 0.f};
#pragma unroll
        for (int ai = 0; ai < 2; ++ai)
#pragma unroll
            for (int m = 0; m < 4; ++m) { bf16_t* rowp = base + (size_t)(row0 + ai * HALF + m * 16) * ldc + col0;
#pragma unroll
                for (int bj = 0; bj < 2; ++bj) { f32x4 v0 = acc[ai][bj][m][0] + bv[bj][0], v1 = acc[ai][bj][m][1] + bv[bj][1];
                    v0 = v0 * sc; v1 = v1 * sc; u32x4 w; w.x = cvt_pk_bf16(v0[0], v0[1]); w.y = cvt_pk_bf16(v0[2], v0[3]); w.z = cvt_pk_bf16(v1[0], v1[1]); w.w = cvt_pk_bf16(v1[2], v1[3]);
                    *(u32x4*)(rowp + bj * HALF) = w; } }
    }
};

struct EpiSwiglu {
    static constexpr bool PERM = true, AFTER_DRAIN = false;
    bf16_t* O; int ldc; int quant; float sc;
    __device__ __forceinline__ void operator()(const f32x4 (&acc)[2][2][4][2], const Unit& u, int wr, int wc, int fr, int fq) const {
        const int row0 = u.pm * BM + wr * 64 + fr, col0 = u.pn * HALF + wc * 32 + 8 * fq;
#pragma unroll
        for (int ai = 0; ai < 2; ++ai)
#pragma unroll
            for (int m = 0; m < 4; ++m) { bf16_t* rowp = O + (size_t)(row0 + ai * HALF + m * 16) * ldc + col0;
                float h[8];
#pragma unroll
                for (int n = 0; n < 2; ++n)
#pragma unroll
                    for (int j = 0; j < 4; ++j) { const float gte = acc[ai][0][m][n][j] * sc, up = acc[ai][1][m][n][j] * sc;
                        h[4 * n + j] = gte * __builtin_amdgcn_rcpf(1.0f + __builtin_amdgcn_exp2f(-1.4426950408889634f * gte)) * up; if (quant) h[4 * n + j] = q8(h[4 * n + j]); }
                u32x4 w; w.x = cvt_pk_bf16(h[0], h[1]); w.y = cvt_pk_bf16(h[2], h[3]); w.z = cvt_pk_bf16(h[4], h[5]); w.w = cvt_pk_bf16(h[6], h[7]);
                *(u32x4*)rowp = w; }
    }
};

struct EpiSwiglu8 {
    static constexpr bool PERM = true, AFTER_DRAIN = false;
    unsigned char* O; int ldc; float sc;
    __device__ __forceinline__ void operator()(const f32x4 (&acc)[2][2][4][2], const Unit& u, int wr, int wc, int fr, int fq) const {
        const int row0 = u.pm * BM + wr * 64 + fr, col0 = u.pn * HALF + wc * 32 + 8 * fq;
#pragma unroll
        for (int ai = 0; ai < 2; ++ai)
#pragma unroll
            for (int m = 0; m < 4; ++m) { unsigned char* rowp = O + (size_t)(row0 + ai * HALF + m * 16) * ldc + col0;
                float h[8];
#pragma unroll
                for (int n = 0; n < 2; ++n)
#pragma unroll
                    for (int j = 0; j < 4; ++j) { const float gte = acc[ai][0][m][n][j] * sc, up = acc[ai][1][m][n][j] * sc;
                        h[4 * n + j] = gte * __builtin_amdgcn_rcpf(1.0f + __builtin_amdgcn_exp2f(-1.4426950408889634f * gte)) * up; }
                int p0 = 0, p1 = 0;
                p0 = __builtin_amdgcn_cvt_pk_fp8_f32(h[0], h[1], p0, false); p0 = __builtin_amdgcn_cvt_pk_fp8_f32(h[2], h[3], p0, true);
                p1 = __builtin_amdgcn_cvt_pk_fp8_f32(h[4], h[5], p1, false); p1 = __builtin_amdgcn_cvt_pk_fp8_f32(h[6], h[7], p1, true);
                typedef int i32x2 __attribute__((ext_vector_type(2)));
                *(i32x2*)rowp = (i32x2){p0, p1}; }
    }
};
struct EpiResid {
    static constexpr bool PERM = false, AFTER_DRAIN = false;
    const float* base; float* out; int ldc; float alpha;
    __device__ __forceinline__ void operator()(const f32x4 (&acc)[2][2][4][2], const Unit& u, int wr, int wc, int fr, int fq) const {
        const int row0 = u.pm * BM + wr * 64 + fr, col0 = u.pn * BM + wc * 32 + 4 * fq;
#pragma unroll
        for (int ai = 0; ai < 2; ++ai)
#pragma unroll
            for (int m = 0; m < 4; ++m) { const size_t ro = (size_t)(row0 + ai * HALF + m * 16) * ldc + col0;
                f32x4 bs[2][2];
#pragma unroll
                for (int bj = 0; bj < 2; ++bj)
#pragma unroll
                    for (int n = 0; n < 2; ++n) bs[bj][n] = *(const f32x4*)(base + ro + bj * HALF + n * 16);
#pragma unroll
                for (int bj = 0; bj < 2; ++bj)
#pragma unroll
                    for (int n = 0; n < 2; ++n) *(f32x4*)(out + ro + bj * HALF + n * 16) = bs[bj][n] * alpha + acc[ai][bj][m][n]; }
    }
};

template <class Epi, class Sched, bool ALIGN_EPI = false, bool SP2 = false, bool F8 = false>
__device__ __forceinline__ void gemm_phase(PG8_LAS unsigned char* lds, const Gemm g, const Sched& S, const Epi& E) {
    const int tid = threadIdx.x, wid = __builtin_amdgcn_readfirstlane(tid >> 6), lane = tid & 63, wr = wid >> 2, wc = wid & 3, fr = lane & 15, fq = lane >> 4;
    const int K = g.K, nt = K / BK; const int wsc = g.wscale;
    unsigned voffA[2], voffB[2];
#pragma unroll
    for (int i = 0; i < 2; ++i) { int R, C; stage_rc(tid * 16 + i * 8192, R, C); const int Rb = Epi::PERM ? ((R & ~31) + perm32(R & 31)) : R;
        voffA[i] = (unsigned)(R * K + C) * 2u; voffB[i] = (unsigned)(Rb * K + C) * 2u; }
    const size_t kstep = (size_t)(BK * 2);
    const size_t hstep = (size_t)HALF * K * 2;
    const size_t tstep = 2 * hstep;
    const unsigned ldsw = (unsigned)wid * 1024u;
    const int aoff = lds_byte(wr * 64 + fr, fq * 8), boff = lds_byte(wc * 32 + fr, fq * 8);
#define PG8_SA(b, h) (((b) * 2 + (h)) * HTB)
#define PG8_SB(b, h) ((4 + (b) * 2 + (h)) * HTB)
#define PG8_STAGE(bufoff, gbase, voff) do { _Pragma("unroll") for (int _i = 0; _i < 2; ++_i) \
        __builtin_amdgcn_global_load_lds((const unsigned*)((const char*)(gbase) + (voff)[_i]), (PG8_LAS unsigned*)(lds + (bufoff) + ldsw + _i * 8192), 16, 0, 0); } while (0)
#define PG8_LDA(dst, b, h) do { _Pragma("unroll") for (int m = 0; m < 4; ++m) dst[m] = cat8(*(const PG8_LAS bf16x8*)(lds + PG8_SA(b, h) + aoff + m * 2048), *(const PG8_LAS bf16x8*)(lds + PG8_SA(b, h) + aoff + m * 2048 + 1024)); } while (0)
#define PG8_LDB(dst, b, h) do { _Pragma("unroll") for (int n = 0; n < 2; ++n) dst[n] = cat8(*(const PG8_LAS bf16x8*)(lds + PG8_SB(b, h) + boff + n * 2048), *(const PG8_LAS bf16x8*)(lds + PG8_SB(b, h) + boff + n * 2048 + 1024)); } while (0)
#define PG8_MMA(ai, bj, At, Bt) do { __builtin_amdgcn_s_setprio(1); _Pragma("unroll") for (int m = 0; m < 4; ++m) _Pragma("unroll") for (int n = 0; n < 2; ++n) { \
        if constexpr (F8) mfma8(acc[ai][bj][m][n], Bt[n], At[m], wsc, 0x7F7F7F7F); \
        else { acc[ai][bj][m][n] = __builtin_amdgcn_mfma_f32_16x16x32_bf16(lo8(Bt[n]), lo8(At[m]), acc[ai][bj][m][n], 0, 0, 0); \
               acc[ai][bj][m][n] = __builtin_amdgcn_mfma_f32_16x16x32_bf16(hi8(Bt[n]), hi8(At[m]), acc[ai][bj][m][n], 0, 0, 0); } } __builtin_amdgcn_s_setprio(0); } while (0)
#define PG8_WAIT_V(n) asm volatile("s_waitcnt vmcnt(" #n ")" ::: "memory")
#define PG8_WAIT_L(n) asm volatile("s_waitcnt lgkmcnt(" #n ")" ::: "memory")
#define PG8_BAR __builtin_amdgcn_s_barrier()
#define PG8_SCHED __builtin_amdgcn_sched_barrier(0)
    Unit cur, nxt; int ui = 0;
    if (!S.next(0, cur)) return;
    f32x4 acc[2][2][4][2];
#pragma unroll
    for (int a = 0; a < 2; ++a)
#pragma unroll
        for (int b = 0; b < 2; ++b)
#pragma unroll
            for (int m = 0; m < 4; ++m)
#pragma unroll
                for (int n = 0; n < 2; ++n) acc[a][b][m][n] = (f32x4){0.f, 0.f, 0.f, 0.f};
    v8i At[4], B0[2], B1[2];
    const char* cA = (const char*)g.A + (size_t)cur.pm * tstep; const char* cB = (const char*)g.Bt + S.boff(cur) * 2 + (size_t)cur.pn * tstep;
    S.a_ready(cur);
    if constexpr (SP2) {
        PG8_STAGE(PG8_SB(0, 0), cB, voffB); PG8_STAGE(PG8_SB(0, 1), cB + hstep, voffB); PG8_STAGE(PG8_SA(0, 0), cA, voffA); PG8_STAGE(PG8_SA(0, 1), cA + hstep, voffA);
        if (wr == 1) PG8_BAR;
        PG8_WAIT_V(2); PG8_BAR;
        PG8_STAGE(PG8_SB(1, 0), cB + kstep, voffB); PG8_STAGE(PG8_SA(1, 0), cA + kstep, voffA); PG8_STAGE(PG8_SB(1, 1), cB + hstep + kstep, voffB);
        PG8_WAIT_V(6); PG8_BAR;
    } else {
        PG8_STAGE(PG8_SB(0, 0), cB, voffB); PG8_STAGE(PG8_SA(0, 0), cA, voffA); PG8_STAGE(PG8_SB(0, 1), cB + hstep, voffB); PG8_STAGE(PG8_SA(0, 1), cA + hstep, voffA);
        if (wr == 1) PG8_BAR;
        PG8_WAIT_V(4); PG8_BAR;
        PG8_STAGE(PG8_SB(1, 0), cB + kstep, voffB); PG8_STAGE(PG8_SA(1, 0), cA + kstep, voffA); PG8_STAGE(PG8_SB(1, 1), cB + hstep + kstep, voffB);
        PG8_WAIT_V(6); PG8_BAR;
    }
    for (;;) {
        const bool has_next = S.next(ui + 1, nxt);
        const char* nA = has_next ? (const char*)g.A + (size_t)nxt.pm * tstep : cA; const char* nB = has_next ? (const char*)g.Bt + S.boff(nxt) * 2 + (size_t)nxt.pn * tstep : cB;
#pragma unroll 1
        for (int t = 0; t < nt; t += 2) {
            const bool last = (t == nt - 2);
            const char* a1 = cA + (size_t)(t + 1) * kstep;
            const char* a2 = last ? nA : cA + (size_t)(t + 2) * kstep; const char* b2 = last ? nB : cB + (size_t)(t + 2) * kstep;
            const char* a3 = a2 + kstep; const char* b3 = b2 + kstep;
            if (last && has_next) S.a_ready(nxt);
            if constexpr (SP2) {
            PG8_LDB(B0, 0, 0); PG8_LDB(B1, 0, 1); PG8_SCHED; PG8_LDA(At, 0, 0); PG8_STAGE(PG8_SA(1, 1), a1 + hstep, voffA);
            PG8_WAIT_V(8); PG8_WAIT_L(0); PG8_BAR; PG8_MMA(0, 0, At, B0); PG8_MMA(0, 1, At, B1); PG8_BAR; PG8_SCHED;
            PG8_LDA(At, 0, 1); PG8_STAGE(PG8_SB(0, 0), b2, voffB); PG8_STAGE(PG8_SB(0, 1), b2 + hstep, voffB); PG8_STAGE(PG8_SA(0, 0), a2, voffA);
            PG8_WAIT_V(8); PG8_WAIT_L(0); PG8_BAR; PG8_MMA(1, 0, At, B0); PG8_MMA(1, 1, At, B1); PG8_BAR; PG8_SCHED;
            PG8_LDB(B0, 1, 0); PG8_LDB(B1, 1, 1); PG8_SCHED; PG8_LDA(At, 1, 0); PG8_STAGE(PG8_SA(0, 1), a2 + hstep, voffA);
            PG8_WAIT_V(8); PG8_WAIT_L(0); PG8_BAR; PG8_MMA(0, 0, At, B0); PG8_MMA(0, 1, At, B1); PG8_BAR; PG8_SCHED;
            PG8_LDA(At, 1, 1); PG8_STAGE(PG8_SB(1, 0), b3, voffB); PG8_STAGE(PG8_SB(1, 1), b3 + hstep, voffB); PG8_STAGE(PG8_SA(1, 0), a3, voffA);
            PG8_WAIT_V(8); PG8_WAIT_L(0); PG8_BAR; PG8_MMA(1, 0, At, B0); PG8_MMA(1, 1, At, B1); PG8_BAR; PG8_SCHED;
            } else {
            PG8_LDB(B0, 0, 0); PG8_SCHED; PG8_LDA(At, 0, 0); PG8_STAGE(PG8_SA(1, 1), a1 + hstep, voffA);
            PG8_WAIT_L(8); PG8_BAR; PG8_WAIT_L(0); PG8_MMA(0, 0, At, B0); PG8_BAR; PG8_SCHED;
            PG8_LDB(B1, 0, 1); PG8_STAGE(PG8_SB(0, 0), b2, voffB);
            PG8_BAR; PG8_WAIT_L(0); PG8_MMA(0, 1, At, B1); PG8_BAR;
            PG8_LDA(At, 0, 1); PG8_STAGE(PG8_SA(0, 0), a2, voffA);
            PG8_BAR; PG8_WAIT_L(0); PG8_MMA(1, 0, At, B0); PG8_BAR; PG8_SCHED;
            PG8_STAGE(PG8_SB(0, 1), b2 + hstep, voffB);
            PG8_WAIT_V(6); PG8_BAR; PG8_MMA(1, 1, At, B1); PG8_BAR;
            PG8_LDB(B0, 1, 0); PG8_SCHED; PG8_LDA(At, 1, 0); PG8_STAGE(PG8_SA(0, 1), a2 + hstep, voffA);
            PG8_WAIT_L(8); PG8_BAR; PG8_WAIT_L(0); PG8_MMA(0, 0, At, B0); PG8_BAR; PG8_SCHED;
            PG8_LDB(B1, 1, 1); PG8_STAGE(PG8_SB(1, 0), b3, voffB);
            PG8_BAR; PG8_WAIT_L(0); PG8_MMA(0, 1, At, B1); PG8_BAR;
            PG8_LDA(At, 1, 1); PG8_STAGE(PG8_SA(1, 0), a3, voffA);
            PG8_BAR; PG8_WAIT_L(0); PG8_MMA(1, 0, At, B0); PG8_BAR; PG8_SCHED;
            PG8_STAGE(PG8_SB(1, 1), b3 + hstep, voffB);
            PG8_WAIT_V(6); PG8_BAR; PG8_MMA(1, 1, At, B1); PG8_BAR;
            }
        }
        if constexpr (F8) asm volatile("s_nop 15\n\ts_nop 15" ::: "memory");
        if constexpr (ALIGN_EPI) { if (wr == 0) PG8_BAR; }
        if constexpr (!Epi::AFTER_DRAIN) { E(acc, cur, wr, wc, fr, fq); S.done(cur); }
        if (!has_next) break;
#pragma unroll
        for (int a = 0; a < 2; ++a)
#pragma unroll
            for (int b = 0; b < 2; ++b)
#pragma unroll
                for (int m = 0; m < 4; ++m)
#pragma unroll
                    for (int n = 0; n < 2; ++n) acc[a][b][m][n] = (f32x4){0.f, 0.f, 0.f, 0.f};
        cur = nxt; cA = nA; cB = nB; ++ui;
        if constexpr (ALIGN_EPI) { if (wr == 1) PG8_BAR; }
    }
    PG8_WAIT_V(0);
    if constexpr (!ALIGN_EPI) { if (wr == 0) PG8_BAR; }
    PG8_BAR;
    if constexpr (Epi::AFTER_DRAIN) { E.fused(acc, cur, wr, wc, fr, fq, lds, wid, lane); S.done(cur); }
#undef PG8_SA
#undef PG8_SB
#undef PG8_STAGE
#undef PG8_LDA
#undef PG8_LDB
#undef PG8_MMA
#undef PG8_WAIT_V
#undef PG8_WAIT_L
#undef PG8_BAR
#undef PG8_SCHED
}
}


struct Args { const float* in[21]; float* out; unsigned char* ws; int lo, hi; };
enum { I_X = 0, I_MEM, I_WMEMKV, I_AWIN, I_ACONV, I_AWOUT, I_BWIN, I_BWOUT, I_CWIN, I_CPOOLW, I_CPOOLS, I_CWOUT, I_LNG, I_LNB,
       I_FG, I_FU, I_FD, I_ROUTER, I_MG, I_MU, I_MD };
struct Frame { LAS unsigned char* lds; int tid, lane, wave, gw; };

template <int NWM, class Epi>
__device__ __forceinline__ void naive_gemm(const Frame& F, const bf16* A, int lda, const float* W0, const float* W1, int ldw, int M, int N, int K, const Epi& epi, const int* tile_e, size_t wstride) {
    const int lane = F.lane, r16 = lane & 15, q4 = lane >> 4;
    const int tn = N / 32, ntiles = (M / 32) * tn;
    for (int tile = F.gw; tile < ntiles; tile += NGW) {
        const int m0 = (tile / tn) * 32, n0 = (tile % tn) * 32;
        size_t woff = 0;
        if (tile_e) woff = (size_t)ld_i32_agent(tile_e + (m0 >> 8)) * wstride;
        const float* w0 = W0 + woff; const float* w1 = (NWM == 2) ? W1 + woff : nullptr;
        f32x4 acc[NWM][2][2];
#pragma unroll
        for (int w = 0; w < NWM; ++w)
#pragma unroll
            for (int i = 0; i < 2; ++i)
#pragma unroll
                for (int j = 0; j < 2; ++j) acc[w][i][j] = (f32x4){0.f, 0.f, 0.f, 0.f};
        for (int k0 = 0; k0 < K; k0 += 32) {
            bf16x8 a[2], b[NWM][2];
#pragma unroll
            for (int i = 0; i < 2; ++i) a[i] = *(const bf16x8*)(A + (size_t)(m0 + 16 * i + r16) * lda + k0 + 8 * q4);
#pragma unroll
            for (int w = 0; w < NWM; ++w)
#pragma unroll
                for (int jn = 0; jn < 2; ++jn) {
                    const float* wp = (w == 0 ? w0 : w1) + (size_t)(k0 + 8 * q4) * ldw + n0 + 16 * jn + r16;
#pragma unroll
                    for (int j = 0; j < 8; ++j) b[w][jn][j] = (short)f2bf(wp[(size_t)j * ldw]);
                }
#pragma unroll
            for (int w = 0; w < NWM; ++w)
#pragma unroll
                for (int i = 0; i < 2; ++i)
#pragma unroll
                    for (int jn = 0; jn < 2; ++jn) acc[w][i][jn] = __builtin_amdgcn_mfma_f32_16x16x32_bf16(a[i], b[w][jn], acc[w][i][jn], 0, 0, 0);
        }
#pragma unroll
        for (int i = 0; i < 2; ++i)
#pragma unroll
            for (int jn = 0; jn < 2; ++jn)
#pragma unroll
                for (int r = 0; r < 4; ++r) {
                    const int row = m0 + 16 * i + q4 * 4 + r, col = n0 + 16 * jn + r16;
                    if constexpr (NWM == 2) epi(row, col, acc[0][i][jn][r], acc[1][i][jn][r]); else epi(row, col, acc[0][i][jn][r], 0.f);
                }
    }
}
struct NEpiBf16 { bf16* O; int ldo; __device__ __forceinline__ void operator()(int r, int c, float v, float) const { O[(size_t)r * ldo + c] = (bf16)f2bf(v); } };
struct NEpiResid { const float* base; float* out; __device__ __forceinline__ void operator()(int r, int c, float v, float) const { const size_t o = (size_t)r * D + c; out[o] = ALPHA * base[o] + v; } };
struct NEpiSwiglu { bf16* O; int ldo; __device__ __forceinline__ void operator()(int r, int c, float g, float u) const { const float s = g / (1.f + __expf(-g)); O[(size_t)r * ldo + c] = (bf16)f2bf(s * u); } };
struct NEpiScale { bf16* O; int ldo; int coff; const float* scale; __device__ __forceinline__ void operator()(int r, int c, float v, float) const { O[(size_t)r * ldo + coff + c] = (bf16)f2bf(v * scale[coff + c]); } };

__device__ __forceinline__ void prep_phase(const Frame& F, const float* x, const float* mem, bf16* XB, bf16* MEMB) {
    const size_t gt = (size_t)blockIdx.x * NTHREADS + F.tid, NT = (size_t)GRID * NTHREADS;
    for (size_t i = gt; i < (size_t)T * D / 8; i += NT) { const f32x4 a = ((const f32x4*)x)[2 * i], b = ((const f32x4*)x)[2 * i + 1];
        v4u o; o.x = pk2(a.x, a.y); o.y = pk2(a.z, a.w); o.z = pk2(b.x, b.y); o.w = pk2(b.z, b.w); ((v4u*)XB)[i] = o; }
    for (size_t i = gt; i < (size_t)NB * ML * D / 8; i += NT) { const f32x4 a = ((const f32x4*)mem)[2 * i], b = ((const f32x4*)mem)[2 * i + 1];
        v4u o; o.x = pk2(a.x, a.y); o.y = pk2(a.z, a.w); o.z = pk2(b.x, b.y); o.w = pk2(b.z, b.w); ((v4u*)MEMB)[i] = o; }
}
__device__ __forceinline__ void unpack8(const v4u w, float (&f)[8]) { f[0] = bflo(w.x); f[1] = bfhi(w.x); f[2] = bflo(w.y); f[3] = bfhi(w.y); f[4] = bflo(w.z); f[5] = bfhi(w.z); f[6] = bflo(w.w); f[7] = bfhi(w.w); }
__device__ __forceinline__ v4u pack8(const float (&f)[8]) { v4u o; o.x = pk2(f[0], f[1]); o.y = pk2(f[2], f[3]); o.z = pk2(f[4], f[5]); o.w = pk2(f[6], f[7]); return o; }

__device__ __forceinline__ void mixA_phase(const Frame& F, const bf16* H, const float* convw, bf16* CAT) {
    const size_t gt = (size_t)blockIdx.x * NTHREADS + F.tid, NT = (size_t)GRID * NTHREADS;
    for (size_t it = gt; it < (size_t)T * 96; it += NT) {
        const int t = (int)(it / 96), c8 = (int)(it % 96) * 8, s = t & (SEQ - 1);
        const bf16* hr = H + (size_t)t * 2560 + c8;
        float gb[8], z0[8], z1[8], z2[8], a[8], b[8];
        unpack8(*(const v4u*)hr, gb);
        unpack8(*(const v4u*)(hr + 768), a); unpack8(*(const v4u*)(hr + 1536), b);
#pragma unroll
        for (int i = 0; i < 8; ++i) z1[i] = a[i] * b[i];
        if (s > 0) { unpack8(*(const v4u*)(hr - 2560 + 768), a); unpack8(*(const v4u*)(hr - 2560 + 1536), b);
#pragma unroll
            for (int i = 0; i < 8; ++i) z0[i] = a[i] * b[i]; }
        else {
#pragma unroll
            for (int i = 0; i < 8; ++i) z0[i] = 0.f; }
        if (s < SEQ - 1) { unpack8(*(const v4u*)(hr + 2560 + 768), a); unpack8(*(const v4u*)(hr + 2560 + 1536), b);
#pragma unroll
            for (int i = 0; i < 8; ++i) z2[i] = a[i] * b[i]; }
        else {
#pragma unroll
            for (int i = 0; i < 8; ++i) z2[i] = 0.f; }
        float o[8];
#pragma unroll
        for (int i = 0; i < 8; ++i) o[i] = gb[i] * (convw[c8 + i] * z0[i] + convw[768 + c8 + i] * z1[i] + convw[1536 + c8 + i] * z2[i]);
        *(v4u*)(CAT + (size_t)t * 1024 + c8) = pack8(o);
    }
}
__device__ __forceinline__ void poolC_phase(const Frame& F, const bf16* H, bf16* OUT, int ldo) {
    const size_t gt = (size_t)blockIdx.x * NTHREADS + F.tid, NT = (size_t)GRID * NTHREADS;
    for (size_t it = gt; it < (size_t)T * 96; it += NT) {
        const int t = (int)(it / 96), ch = (int)(it % 96), c8 = ch * 8, s = t & (SEQ - 1), g = ch / 24, w = 2 << g;
        int lo = s - w / 2; lo = lo < 0 ? 0 : lo; int hi = s + w / 2 - 1; hi = hi > SEQ - 1 ? SEQ - 1 : hi;
        const bf16* base = H + (size_t)(t - s) * 1024 + c8;
        float acc[8], u[8], v[8];
#pragma unroll
        for (int i = 0; i < 8; ++i) acc[i] = 0.f;
        for (int p = lo; p <= hi; ++p) { unpack8(*(const v4u*)(base + (size_t)p * 1024), v);
#pragma unroll
            for (int i = 0; i < 8; ++i) acc[i] += v[i]; }
        unpack8(*(const v4u*)(base + (size_t)s * 1024), u);
        const float inv = 1.f / (float)(hi - lo + 1);
        float o[8];
#pragma unroll
        for (int i = 0; i < 8; ++i) o[i] = acc[i] * inv - u[i];
        *(v4u*)(OUT + (size_t)t * ldo + c8) = pack8(o);
    }
}


__device__ __forceinline__ void tr_item(const float* W, int N, int k0, int n0, bf16* WT, int ldk, int drow0, LAS float* scr, int lane, float qs = 0.f) {
    float v[32];
    const float* wp = W + (size_t)(k0 + (lane >> 5)) * N + n0 + (lane & 31);
#pragma unroll
    for (int i = 0; i < 32; ++i) v[i] = wp[(size_t)(2 * i) * N];
#pragma unroll
    for (int i = 0; i < 32; ++i) scr[(2 * i + (lane >> 5)) * 33 + (lane & 31)] = (qs != 0.f) ? q8(v[i] * qs) / qs : v[i];
    LDS_WAIT(); asm volatile("" ::: "memory");
    const int c = lane & 7;
#pragma unroll
    for (int j = 0; j < 4; ++j) { const int n = (lane >> 3) + 8 * j; const LAS float* sp = scr + (8 * c) * 33 + n;
        v4u o; o.x = pk2(sp[0 * 33], sp[1 * 33]); o.y = pk2(sp[2 * 33], sp[3 * 33]); o.z = pk2(sp[4 * 33], sp[5 * 33]); o.w = pk2(sp[6 * 33], sp[7 * 33]);
        *(v4u*)(WT + (size_t)(drow0 + n) * ldk + k0 + 8 * c) = o; }
    LDS_WAIT(); asm volatile("" ::: "memory");
}
template <int MODE>
__device__ __forceinline__ void tr_matrix(const Frame& F, const float* W, int K, int N, bf16* WT, int ldk, int& rot, float qs = 0.f) {
    LAS float* scr = (LAS float*)(F.lds + F.wave * 16384);
    const int nblk = N / 32, nitems = (K / 64) * nblk;
    for (int it = (F.gw + NGW - (rot % NGW)) % NGW; it < nitems; it += NGW) {
        const int k0 = (it / nblk) * 64, n0 = (it % nblk) * 32;
        const int drow0 = MODE == 0 ? n0 : ((n0 >> 7) * 256 + (n0 & 127) + (MODE == 2 ? 128 : 0));
        tr_item(W, N, k0, n0, WT, ldk, drow0, scr, F.lane, qs);
    }
    rot += nitems;
}
__device__ __forceinline__ void convert_moe(const Frame& F, const float* wg, const float* wu, const float* wd, bf16* WMOE, int& rot) {
#pragma unroll 1
    for (int e = 0; e < NE; ++e) {
        tr_matrix<1>(F, wg + (size_t)e * D * FFE, D, FFE, WMOE + OFF_MGU + (size_t)e * 2 * FFE * D, D, rot, EMU_FP8 ? 32.f : 0.f);
        tr_matrix<2>(F, wu + (size_t)e * D * FFE, D, FFE, WMOE + OFF_MGU + (size_t)e * 2 * FFE * D, D, rot, EMU_FP8 ? 32.f : 0.f);
        tr_matrix<0>(F, wd + (size_t)e * FFE * D, FFE, D, WMOE + OFF_MD + (size_t)e * D * FFE, FFE, rot, EMU_FP8 ? 128.f : 0.f);
    }
}

__device__ __forceinline__ void tr_item8(const float* W, int N, int k0, int n0, unsigned char* WT, int ldk, int drow0, LAS float* scr, int lane, float qs) {
    float v[32];
    const float* wp = W + (size_t)(k0 + (lane >> 5)) * N + n0 + (lane & 31);
#pragma unroll
    for (int i = 0; i < 32; ++i) v[i] = wp[(size_t)(2 * i) * N];
#pragma unroll
    for (int i = 0; i < 32; ++i) scr[(2 * i + (lane >> 5)) * 33 + (lane & 31)] = v[i] * qs;
    LDS_WAIT(); asm volatile("" ::: "memory");
    const int c = lane & 7;
#pragma unroll
    for (int j = 0; j < 4; ++j) { const int n = (lane >> 3) + 8 * j; const LAS float* sp = scr + (8 * c) * 33 + n;
        int p0 = 0, p1 = 0;
        p0 = __builtin_amdgcn_cvt_pk_fp8_f32(sp[0 * 33], sp[1 * 33], p0, false); p0 = __builtin_amdgcn_cvt_pk_fp8_f32(sp[2 * 33], sp[3 * 33], p0, true);
        p1 = __builtin_amdgcn_cvt_pk_fp8_f32(sp[4 * 33], sp[5 * 33], p1, false); p1 = __builtin_amdgcn_cvt_pk_fp8_f32(sp[6 * 33], sp[7 * 33], p1, true);
        v2u o; o.x = (unsigned)p0; o.y = (unsigned)p1;
        *(v2u*)(WT + (size_t)(drow0 + n) * ldk + k0 + 8 * c) = o; }
    LDS_WAIT(); asm volatile("" ::: "memory");
}
template <int MODE>
__device__ __forceinline__ void tr_matrix8(const Frame& F, const float* W, int K, int N, unsigned char* WT, int ldk, int& rot, float qs) {
    LAS float* scr = (LAS float*)(F.lds + F.wave * 16384);
    const int nblk = N / 32, nitems = (K / 64) * nblk;
    for (int it = (F.gw + NGW - (rot % NGW)) % NGW; it < nitems; it += NGW) {
        const int k0 = (it / nblk) * 64, n0 = (it % nblk) * 32;
        const int drow0 = MODE == 0 ? n0 : ((n0 >> 7) * 256 + (n0 & 127) + (MODE == 2 ? 128 : 0));
        tr_item8(W, N, k0, n0, WT, ldk, drow0, scr, F.lane, qs);
    }
    rot += nitems;
}
constexpr float QS_GU = 32.f, QS_D = 128.f;
constexpr int WSC_GU = 0x7A7A7A7A, WSC_D = 0x78787878;
constexpr size_t OFF8_MGU = 0, OFF8_MD = (size_t)NE * 2 * FFE * D;
__device__ __forceinline__ void convert_moe8(const Frame& F, const float* wg, const float* wu, const float* wd, unsigned char* WMOE8, bf16* WMOE, int& rot) {
#pragma unroll 1
    for (int e = 0; e < NE; ++e) {
#if FP8_GU
        tr_matrix8<1>(F, wg + (size_t)e * D * FFE, D, FFE, WMOE8 + OFF8_MGU + (size_t)e * 2 * FFE * D, D, rot, QS_GU);
        tr_matrix8<2>(F, wu + (size_t)e * D * FFE, D, FFE, WMOE8 + OFF8_MGU + (size_t)e * 2 * FFE * D, D, rot, QS_GU);
#else
        tr_matrix<1>(F, wg + (size_t)e * D * FFE, D, FFE, WMOE + OFF_MGU + (size_t)e * 2 * FFE * D, D, rot);
        tr_matrix<2>(F, wu + (size_t)e * D * FFE, D, FFE, WMOE + OFF_MGU + (size_t)e * 2 * FFE * D, D, rot);
#endif
#if FP8_D
        tr_matrix8<0>(F, wd + (size_t)e * FFE * D, FFE, D, WMOE8 + (FP8_GU ? OFF8_MD : 2 * OFF_MD) + (size_t)e * D * FFE, FFE, rot, QS_D);
#else
        tr_matrix<0>(F, wd + (size_t)e * FFE * D, FFE, D, WMOE + OFF_MD + (size_t)e * D * FFE, FFE, rot);
#endif
    }
}
__device__ __forceinline__ void fold_pool(const Frame& F, const float* pw, const float* ps, const float* wout, bf16* WT) {
    const int item = blockIdx.x * NTHREADS + F.tid;
    if (item < 1024 * 96) {
        const int n = item & 1023, kc = item >> 10, g = kc / 24, c0 = kc * 8 - g * 192;
        float acc[8];
#pragma unroll
        for (int i = 0; i < 8; ++i) acc[i] = 0.f;
        const float* P = pw + (size_t)g * 192 * 192 + (size_t)c0 * 192;
        for (int d = 0; d < 192; ++d) { const float w = wout[(size_t)(g * 192 + d) * D + n] * ps[g * 192 + d];
#pragma unroll
            for (int i = 0; i < 8; ++i) acc[i] += P[i * 192 + d] * w; }
        *(v4u*)(WT + (size_t)n * D + kc * 8) = pack8(acc);
    }
}
__device__ __forceinline__ void convert_small(const Frame& F, const Args& a, bf16* WSM, int& rot) {
    tr_matrix<0>(F, a.in[I_WMEMKV], D, 512, WSM + OFF_WKV, D, rot);
    tr_matrix<0>(F, a.in[I_AWIN], D, 2560, WSM + OFF_AIN, D, rot);
    tr_matrix<0>(F, a.in[I_AWIN] + (size_t)D * 2560, D, 2560, WSM + OFF_AIN + (size_t)2560 * D, D, rot);
    tr_matrix<0>(F, a.in[I_AWOUT], D, D, WSM + OFF_AOUT, D, rot);
    tr_matrix<0>(F, a.in[I_AWOUT] + (size_t)D * D, D, D, WSM + OFF_AOUT + (size_t)D * D, D, rot);
    tr_matrix<0>(F, a.in[I_BWIN], D, 2560, WSM + OFF_BIN, D, rot);
    tr_matrix<0>(F, a.in[I_BWOUT], 512, D, WSM + OFF_BOUT, 512, rot);
    tr_matrix<0>(F, a.in[I_CWIN], D, D, WSM + OFF_CIN, D, rot);
    tr_matrix<0>(F, a.in[I_CWOUT] + (size_t)768 * D, 256, D, WSM + OFF_COUT + 768, D, rot);
#pragma unroll 1
    for (int f = 0; f < 2; ++f) {
        tr_matrix<1>(F, a.in[I_FG] + (size_t)f * D * FF, D, FF, WSM + OFF_FGU + (size_t)f * 2 * FF * D, D, rot, EMU_FP8 == 2 ? 32.f : 0.f);
        tr_matrix<2>(F, a.in[I_FU] + (size_t)f * D * FF, D, FF, WSM + OFF_FGU + (size_t)f * 2 * FF * D, D, rot, EMU_FP8 == 2 ? 32.f : 0.f);
        tr_matrix<0>(F, a.in[I_FD] + (size_t)f * FF * D, FF, D, WSM + OFF_FD + (size_t)f * D * FF, FF, rot, EMU_FP8 == 2 ? 64.f : 0.f);
    }
}

template <bool ROUTER, bool COMBINE>
__device__ __forceinline__ void ln_phase(const Frame& F, const float* XRi, float* XR, bf16* XB, const float* g, const float* b, const float* router, int* E01, float* W01, const int* DEST, const bf16* YB, int* cntWG) {
    LAS int* cntL = (LAS int*)F.lds;
    if (ROUTER) { if (F.tid < 8) cntL[F.tid] = 0; __syncthreads(); }
    f32x4 gv[4], bv[4];
#pragma unroll
    for (int j = 0; j < 4; ++j) { gv[j] = ((const f32x4*)g)[F.lane + 64 * j]; bv[j] = ((const f32x4*)b)[F.lane + 64 * j]; }
    for (int i = 0; i < 16; ++i) {
        const int t = blockIdx.x * 128 + F.wave * 16 + i;
        f32x4* xr = (f32x4*)(XR + (size_t)t * D) + F.lane; const f32x4* xi = (const f32x4*)(XRi + (size_t)t * D) + F.lane;
        f32x4 v[4]; float s = 0.f;
#pragma unroll
        for (int j = 0; j < 4; ++j) v[j] = xi[64 * j];
        if (COMBINE) {
            const int d0 = ld_i32_agent(DEST + 2 * t), d1 = ld_i32_agent(DEST + 2 * t + 1);
            const float w0 = ld_f32_agent(W01 + 2 * t), w1 = ld_f32_agent(W01 + 2 * t + 1);
            const v2u* y0 = (const v2u*)(YB + (size_t)d0 * D) + F.lane; const v2u* y1 = (const v2u*)(YB + (size_t)d1 * D) + F.lane;
#pragma unroll
            for (int j = 0; j < 4; ++j) { const v2u a = y0[64 * j], c = y1[64 * j];
                v[j].x = ALPHA * v[j].x + w0 * bflo(a.x) + w1 * bflo(c.x); v[j].y = ALPHA * v[j].y + w0 * bfhi(a.x) + w1 * bfhi(c.x);
                v[j].z = ALPHA * v[j].z + w0 * bflo(a.y) + w1 * bflo(c.y); v[j].w = ALPHA * v[j].w + w0 * bfhi(a.y) + w1 * bfhi(c.y); }
        }
#pragma unroll
        for (int j = 0; j < 4; ++j) s += (v[j].x + v[j].y) + (v[j].z + v[j].w);
        const float mean = wave_sum(s) * (1.f / D); float s2 = 0.f;
#pragma unroll
        for (int j = 0; j < 4; ++j) { v[j] = v[j] - mean; s2 += (v[j].x * v[j].x + v[j].y * v[j].y) + (v[j].z * v[j].z + v[j].w * v[j].w); }
        const float rstd = 1.f / sqrtf(wave_sum(s2) * (1.f / D) + LN_EPS);
        v2u* o8 = (v2u*)(XB + (size_t)t * D) + F.lane;
#pragma unroll
        for (int j = 0; j < 4; ++j) { v[j] = v[j] * rstd * gv[j] + bv[j]; xr[64 * j] = v[j]; v2u o; o.x = pk2(v[j].x, v[j].y); o.y = pk2(v[j].z, v[j].w); o8[64 * j] = o; }
        if (ROUTER) {
            float lg[8];
#pragma unroll
            for (int e = 0; e < 8; ++e) lg[e] = 0.f;
#pragma unroll
            for (int j = 0; j < 4; ++j)
#pragma unroll
                for (int q = 0; q < 4; ++q) { const int c = 4 * F.lane + 256 * j + q; const f32x4 r0 = ((const f32x4*)router)[2 * c], r1 = ((const f32x4*)router)[2 * c + 1]; const float xv = v[j][q];
                    lg[0] += xv * r0.x; lg[1] += xv * r0.y; lg[2] += xv * r0.z; lg[3] += xv * r0.w; lg[4] += xv * r1.x; lg[5] += xv * r1.y; lg[6] += xv * r1.z; lg[7] += xv * r1.w; }
#pragma unroll
            for (int e = 0; e < 8; ++e) lg[e] = wave_sum(lg[e]);
            float b0 = lg[0]; int i0 = 0;
#pragma unroll
            for (int e = 1; e < 8; ++e) if (lg[e] > b0) { b0 = lg[e]; i0 = e; }
            float b1 = -3.0e38f; int i1 = 0;
#pragma unroll
            for (int e = 0; e < 8; ++e) if (e != i0 && lg[e] > b1) { b1 = lg[e]; i1 = e; }
            const float w0 = 1.f / (1.f + __expf(b1 - b0));
            if (F.lane == 0) { E01[2 * t] = i0; E01[2 * t + 1] = i1; W01[2 * t] = w0; W01[2 * t + 1] = 1.f - w0; __hip_atomic_fetch_add(&cntL[i0], 1, __ATOMIC_RELAXED, __HIP_MEMORY_SCOPE_WORKGROUP); __hip_atomic_fetch_add(&cntL[i1], 1, __ATOMIC_RELAXED, __HIP_MEMORY_SCOPE_WORKGROUP); }
        }
    }
    if (ROUTER) { __syncthreads(); if (F.tid < 8) cntWG[blockIdx.x * 8 + F.tid] = cntL[F.tid]; }
}
__device__ __forceinline__ void scatter_phase(const Frame& F, const int* cntWG, const int* E01, int* DEST, const bf16* XB, bf16* XS, int* tile_e, int* nMp) {
    LAS int* L = (LAS int*)F.lds;
    if (F.tid < 8) { int tot = 0, base = 0; for (int w = 0; w < GRID; ++w) { const int c = ld_i32_agent(cntWG + w * 8 + F.tid); if (w < (int)blockIdx.x) base += c; tot += c; } L[F.tid] = base; L[8 + F.tid] = tot; }
    __syncthreads();
    if (F.tid == 0) { int ps = 0; for (int e = 0; e < 8; ++e) { L[16 + e] = ps; ps += (L[8 + e] + 255) / 256 * 256; } L[24] = ps; }
    __syncthreads();
    if (F.wave == 0) {
        const int tA = blockIdx.x * 128 + F.lane, tB = tA + 64;
        const int eA0 = ld_i32_agent(E01 + 2 * tA), eA1 = ld_i32_agent(E01 + 2 * tA + 1), eB0 = ld_i32_agent(E01 + 2 * tB), eB1 = ld_i32_agent(E01 + 2 * tB + 1);
        const unsigned long long lt = (1ull << F.lane) - 1ull;
        int dA0 = 0, dA1 = 0, dB0 = 0, dB1 = 0;
        for (int e = 0; e < 8; ++e) {
            const unsigned long long mA0 = __ballot(eA0 == e), mA1 = __ballot(eA1 == e), mB0 = __ballot(eB0 == e), mB1 = __ballot(eB1 == e);
            const int start = L[16 + e] + L[e];
            const int cA = __popcll(mA0 & lt) + __popcll(mA1 & lt), totA = __popcll(mA0) + __popcll(mA1), cB = totA + __popcll(mB0 & lt) + __popcll(mB1 & lt);
            if (eA0 == e) dA0 = start + cA; if (eA1 == e) dA1 = start + cA;
            if (eB0 == e) dB0 = start + cB; if (eB1 == e) dB1 = start + cB;
        }
        DEST[2 * tA] = dA0; DEST[2 * tA + 1] = dA1; DEST[2 * tB] = dB0; DEST[2 * tB + 1] = dB1;
        L[32 + 2 * F.lane] = dA0; L[32 + 2 * F.lane + 1] = dA1; L[32 + 2 * (F.lane + 64)] = dB0; L[32 + 2 * (F.lane + 64) + 1] = dB1;
    }
    __syncthreads();
    for (int i = 0; i < 16; ++i) {
        const int tl = F.wave * 16 + i, t = blockIdx.x * 128 + tl;
        const v4u* src = (const v4u*)(XB + (size_t)t * D) + F.lane; v4u a = src[0], b = src[64];
#if EMU_FP8
        { float f[8]; unpack8(a, f);
#pragma unroll
          for (int q = 0; q < 8; ++q) f[q] = q8(f[q]);
          a = pack8(f); unpack8(b, f);
#pragma unroll
          for (int q = 0; q < 8; ++q) f[q] = q8(f[q]);
          b = pack8(f); }
#endif
#if FP8_GU
        v2u a8, b8;
        { float f[8]; int p0 = 0, p1 = 0; unpack8(a, f);
          p0 = __builtin_amdgcn_cvt_pk_fp8_f32(f[0], f[1], p0, false); p0 = __builtin_amdgcn_cvt_pk_fp8_f32(f[2], f[3], p0, true); p1 = __builtin_amdgcn_cvt_pk_fp8_f32(f[4], f[5], p1, false); p1 = __builtin_amdgcn_cvt_pk_fp8_f32(f[6], f[7], p1, true);
          a8.x = (unsigned)p0; a8.y = (unsigned)p1; p0 = 0; p1 = 0; unpack8(b, f);
          p0 = __builtin_amdgcn_cvt_pk_fp8_f32(f[0], f[1], p0, false); p0 = __builtin_amdgcn_cvt_pk_fp8_f32(f[2], f[3], p0, true); p1 = __builtin_amdgcn_cvt_pk_fp8_f32(f[4], f[5], p1, false); p1 = __builtin_amdgcn_cvt_pk_fp8_f32(f[6], f[7], p1, true);
          b8.x = (unsigned)p0; b8.y = (unsigned)p1; }
#pragma unroll
        for (int k = 0; k < 2; ++k) { v2u* dst = (v2u*)((unsigned char*)XS + (size_t)L[32 + 2 * tl + k] * D) + F.lane; dst[0] = a8; dst[64] = b8; }
#else
#pragma unroll
        for (int k = 0; k < 2; ++k) { v4u* dst = (v4u*)(XS + (size_t)L[32 + 2 * tl + k] * D) + F.lane; dst[0] = a; dst[64] = b; }
#endif
    }
    if (blockIdx.x == 0) {
        const int nM = L[24] / 256;
        for (int i = F.tid; i < nM; i += NTHREADS) { int e = 0;
#pragma unroll
            for (int q = 1; q < 8; ++q) if (i * 256 >= L[16 + q]) e = q;
            tile_e[i] = e; }
        if (F.tid == 0) *nMp = nM;
    }
    __syncthreads();
}

__device__ __forceinline__ void memattn_naive(const Frame& F, const bf16* H, int ldh, int qoff, const bf16* MEMKV, bf16* CAT, int ldc, int coff) {
    const size_t gt = (size_t)blockIdx.x * NTHREADS + F.tid, NT = (size_t)GRID * NTHREADS;
    for (size_t it = gt; it < (size_t)T * 4; it += NT) {
        const int t = (int)(it >> 2), h = (int)(it & 3), bb = t / SEQ;
        float q[64], o[64];
#pragma unroll
        for (int c = 0; c < 8; ++c) { float f[8]; unpack8(*(const v4u*)(H + (size_t)t * ldh + qoff + 64 * h + 8 * c), f);
#pragma unroll
            for (int i = 0; i < 8; ++i) { q[8 * c + i] = f[i] * 0.125f; o[8 * c + i] = 0.f; } }
        float m = -3.0e38f, l = 0.f;
        for (int k = 0; k < ML; ++k) {
            const bf16* kr = MEMKV + (size_t)(bb * ML + k) * 512 + 64 * h;
            float sc = 0.f;
#pragma unroll
            for (int c = 0; c < 8; ++c) { float f[8]; unpack8(*(const v4u*)(kr + 8 * c), f);
#pragma unroll
                for (int i = 0; i < 8; ++i) sc += q[8 * c + i] * f[i]; }
            const float mn = fmaxf(m, sc), al = __expf(m - mn), p = __expf(sc - mn);
            l = l * al + p; m = mn;
#pragma unroll
            for (int c = 0; c < 8; ++c) { float f[8]; unpack8(*(const v4u*)(kr + 256 + 8 * c), f);
#pragma unroll
                for (int i = 0; i < 8; ++i) o[8 * c + i] = o[8 * c + i] * al + p * f[i]; }
        }
        const float inv = 1.f / l;
#pragma unroll
        for (int c = 0; c < 8; ++c) { float f[8];
#pragma unroll
            for (int i = 0; i < 8; ++i) f[i] = o[8 * c + i] * inv;
            *(v4u*)(CAT + (size_t)t * ldc + coff + 64 * h + 8 * c) = pack8(f); }
    }
}
__device__ __forceinline__ void dilattn_naive(const Frame& F, const bf16* H, bf16* CAT, int ldc) {
    const size_t gt = (size_t)blockIdx.x * NTHREADS + F.tid, NT = (size_t)GRID * NTHREADS;
    for (size_t it = gt; it < (size_t)T * 4; it += NT) {
        const int t = (int)(it >> 2), h = (int)(it & 3), s = t & (SEQ - 1);
        float q[64], o[64];
#pragma unroll
        for (int i = 0; i < 64; ++i) o[i] = 0.f;
        float m = -3.0e38f, l = 0.f;
        for (int g = 0; g < 3; ++g) {
            const int dl = 1 << (2 * g), nsub = SEQ / dl, j = s / dl, r = s % dl;
            const float slope = exp2f(-8.f * (float)(4 * g + h + 1) / 12.f) * (float)dl;
#pragma unroll
            for (int c = 0; c < 8; ++c) { float f[8]; unpack8(*(const v4u*)(H + (size_t)t * 2560 + 256 * g + 64 * h + 8 * c), f);
#pragma unroll
                for (int i = 0; i < 8; ++i) q[8 * c + i] = f[i] * 0.125f; }
            const int jlo = j - 64 < 0 ? 0 : j - 64, jhi = j + 64 > nsub - 1 ? nsub - 1 : j + 64;
            for (int jj = jlo; jj <= jhi; ++jj) {
                const bf16* kr = H + (size_t)(t - s + jj * dl + r) * 2560 + 768 + 256 * g + 64 * h;
                float sc = 0.f;
#pragma unroll
                for (int c = 0; c < 8; ++c) { float f[8]; unpack8(*(const v4u*)(kr + 8 * c), f);
#pragma unroll
                    for (int i = 0; i < 8; ++i) sc += q[8 * c + i] * f[i]; }
                const int ad = jj > j ? jj - j : j - jj;
                sc -= slope * (float)ad;
                const float mn = fmaxf(m, sc), al = __expf(m - mn), p = __expf(sc - mn);
                l = l * al + p; m = mn;
#pragma unroll
                for (int c = 0; c < 8; ++c) { float f[8]; unpack8(*(const v4u*)(kr + 768 + 8 * c), f);
#pragma unroll
                    for (int i = 0; i < 8; ++i) o[8 * c + i] = o[8 * c + i] * al + p * f[i]; }
            }
        }
        const float inv = 1.f / l;
#pragma unroll
        for (int c = 0; c < 8; ++c) { float f[8];
#pragma unroll
            for (int i = 0; i < 8; ++i) f[i] = o[8 * c + i] * inv;
            *(v4u*)(CAT + (size_t)t * ldc + 64 * h + 8 * c) = pack8(f); }
    }
}


typedef short v4i16_t __attribute__((ext_vector_type(4)));
__device__ __forceinline__ int crow(int r, int hi) { return (r & 3) + 8 * (r >> 2) + 4 * hi; }
__device__ __forceinline__ unsigned cvtpk(float lo, float hi) { unsigned r; asm volatile("s_nop 0\n\tv_cvt_pk_bf16_f32 %0, %1, %2" : "=v"(r) : "v"(lo), "v"(hi)); return r; }
__device__ __forceinline__ s16x4 vtr(const LAS unsigned char* p) { return __builtin_bit_cast(s16x4, __builtin_amdgcn_ds_read_tr16_b64_v4i16((LAS v4i16_t*)p)); }
constexpr int VROWB = 144;
constexpr float C2 = 0.125f * 1.4426950408889634f;
struct AttnP { const bf16* kbase; size_t kstride; int voff, j0, nsub; float slope2; };
struct AttnS { float m, l; f32x16 o0, o1; };
template <int NBLK, bool DIL>
__device__ __forceinline__ void attn_chunk(AttnS& st, const bf16x8 (&qf)[4], int kb0, const AttnP& P, LAS unsigned char* vl, int lane) {
    const int r32 = lane & 31, hh = lane >> 5;
    f32x16 sc[NBLK];
#pragma unroll
    for (int b = 0; b < NBLK; ++b) {
        int jk = P.j0 - 64 + 32 * (kb0 + b) + r32; jk = jk < 0 ? 0 : (jk > P.nsub - 1 ? P.nsub - 1 : jk);
        const bf16* kr = P.kbase + (size_t)jk * P.kstride + 8 * hh;
        bf16x8 kf[4];
#pragma unroll
        for (int ks = 0; ks < 4; ++ks) kf[ks] = *(const bf16x8*)(kr + 16 * ks);
        f32x16 a = {};
#pragma unroll
        for (int ks = 0; ks < 4; ++ks) a = __builtin_amdgcn_mfma_f32_32x32x16_bf16(kf[ks], qf[ks], a, 0, 0, 0);
        sc[b] = a;
    }
    float mc = -INFINITY;
    int dbase = 4 * hh - 64 - r32; asm volatile("" : "+v"(dbase));
    const int jbase = P.j0 + dbase + r32;
#pragma unroll
    for (int b = 0; b < NBLK; ++b)
#pragma unroll
        for (int r = 0; r < 16; ++r) {
            float v = sc[b][r] * C2;
            if (DIL) { const int kc = 32 * (kb0 + b) + (r & 3) + 8 * (r >> 2), df = dbase + kc, jk = jbase + kc, ad = df < 0 ? -df : df;
                v = (ad <= 64 && (unsigned)jk < (unsigned)P.nsub) ? v - P.slope2 * (float)ad : -INFINITY; }
            sc[b][r] = v; mc = fmaxf(mc, v);
        }
    mc = fmaxf(mc, __shfl_xor(mc, 32));
    const float mn = fmaxf(st.m, mc), alpha = __builtin_amdgcn_exp2f(st.m - mn); st.m = mn;
    float ps = 0.f;
#pragma unroll
    for (int b = 0; b < NBLK; ++b)
#pragma unroll
        for (int r = 0; r < 16; ++r) { const float pv = __builtin_amdgcn_exp2f(sc[b][r] - mn); sc[b][r] = pv; ps += pv; }
    ps += __shfl_xor(ps, 32);
    st.l = st.l * alpha + ps;
    st.o0 = st.o0 * alpha; st.o1 = st.o1 * alpha;
    const int G = lane >> 4, i16 = lane & 15;
    const LAS unsigned char* trb = vl + (4 * hh + (i16 >> 2)) * VROWB + (16 * (G & 1) + 4 * (i16 & 3)) * 2;
#pragma unroll
    for (int b = 0; b < NBLK; ++b) {
        v4u vv[4];
#pragma unroll
        for (int i = 0; i < 4; ++i) { const int row = (lane >> 3) + 8 * i; int jk = P.j0 - 64 + 32 * (kb0 + b) + row; jk = jk < 0 ? 0 : (jk > P.nsub - 1 ? P.nsub - 1 : jk);
            vv[i] = *(const v4u*)(P.kbase + (size_t)jk * P.kstride + P.voff + (lane & 7) * 8); }
#pragma unroll
        for (int i = 0; i < 4; ++i) *(LAS v4u*)(vl + ((lane >> 3) + 8 * i) * VROWB + (lane & 7) * 16) = vv[i];
        asm volatile("s_waitcnt lgkmcnt(0)" ::: "memory");
#pragma unroll
        for (int ss = 0; ss < 2; ++ss) {
            v4u pw; pw.x = cvtpk(sc[b][8 * ss + 0], sc[b][8 * ss + 1]); pw.y = cvtpk(sc[b][8 * ss + 2], sc[b][8 * ss + 3]); pw.z = cvtpk(sc[b][8 * ss + 4], sc[b][8 * ss + 5]); pw.w = cvtpk(sc[b][8 * ss + 6], sc[b][8 * ss + 7]);
            const bf16x8 pf = __builtin_bit_cast(bf16x8, pw);
            const s16x4 l0 = vtr(trb + (16 * ss) * VROWB), h0 = vtr(trb + (16 * ss + 8) * VROWB), l1 = vtr(trb + (16 * ss) * VROWB + 64), h1 = vtr(trb + (16 * ss + 8) * VROWB + 64);
            st.o0 = __builtin_amdgcn_mfma_f32_32x32x16_bf16((bf16x8){l0[0], l0[1], l0[2], l0[3], h0[0], h0[1], h0[2], h0[3]}, pf, st.o0, 0, 0, 0);
            st.o1 = __builtin_amdgcn_mfma_f32_32x32x16_bf16((bf16x8){l1[0], l1[1], l1[2], l1[3], h1[0], h1[1], h1[2], h1[3]}, pf, st.o1, 0, 0, 0);
        }
        asm volatile("" ::: "memory");
    }
}
__device__ __forceinline__ void memattn_fast(const Frame& F, const bf16* H, int ldh, int qoff, const bf16* MEMKV, bf16* CAT, int ldc, int coff) {
    LAS unsigned char* vl = F.lds + F.wave * 16384;
    const int lane = F.lane, r32 = lane & 31, hh = lane >> 5;
    for (int u = F.gw; u < NB * 4 * 64; u += NGW) {
        const int qb = u & 63, h = (u >> 6) & 3, bb = u >> 8, t = bb * SEQ + qb * 32 + r32;
        const bf16* qrow = H + (size_t)t * ldh + qoff + 64 * h + 8 * hh;
        bf16x8 qf[4];
#pragma unroll
        for (int ks = 0; ks < 4; ++ks) qf[ks] = *(const bf16x8*)(qrow + 16 * ks);
        AttnP P; P.kbase = MEMKV + (size_t)bb * ML * 512 + 64 * h; P.kstride = 512; P.voff = 256; P.j0 = 64; P.nsub = ML; P.slope2 = 0.f;
        AttnS st; st.m = -1.0e30f; st.l = 0.f; st.o0 = f32x16{}; st.o1 = f32x16{};
#pragma unroll 1
        for (int c = 0; c < 4; ++c) attn_chunk<2, false>(st, qf, 2 * c, P, vl, lane);
        const float inv = 1.f / st.l;
        bf16* orow = CAT + (size_t)t * ldc + coff + 64 * h + 4 * hh;
#pragma unroll
        for (int rg = 0; rg < 4; ++rg) {
            v2u a; a.x = cvtpk(st.o0[4 * rg] * inv, st.o0[4 * rg + 1] * inv); a.y = cvtpk(st.o0[4 * rg + 2] * inv, st.o0[4 * rg + 3] * inv); *(v2u*)(orow + 8 * rg) = a;
            v2u c; c.x = cvtpk(st.o1[4 * rg] * inv, st.o1[4 * rg + 1] * inv); c.y = cvtpk(st.o1[4 * rg + 2] * inv, st.o1[4 * rg + 3] * inv); *(v2u*)(orow + 32 + 8 * rg) = c;
        }
    }
}
__device__ __forceinline__ void dilattn_fast(const Frame& F, const bf16* H, float* OG, float* LSE) {
    LAS unsigned char* vl = F.lds + F.wave * 16384;
    const int lane = F.lane, r32 = lane & 31, hh = lane >> 5;
    for (int u = F.gw; u < NB * 4 * 3 * 64; u += NGW) {
        const int jr = u & 63, g = (u >> 6) % 3, bh = u / 192, h = bh & 3, bb = bh >> 2;
        const int dl = 1 << (2 * g), nsub = SEQ >> (2 * g), sh = 6 - 2 * g, r = jr >> sh, jblk = jr & ((1 << sh) - 1), j0 = 32 * jblk;
        const int t = bb * SEQ + (j0 + r32) * dl + r;
        const bf16* qrow = H + (size_t)t * 2560 + 256 * g + 64 * h + 8 * hh;
        bf16x8 qf[4];
#pragma unroll
        for (int ks = 0; ks < 4; ++ks) qf[ks] = *(const bf16x8*)(qrow + 16 * ks);
        AttnP P; P.kbase = H + (size_t)(bb * SEQ + r) * 2560 + 768 + 256 * g + 64 * h; P.kstride = (size_t)dl * 2560; P.voff = 768; P.j0 = j0; P.nsub = nsub;
        P.slope2 = exp2f(-8.f * (float)(4 * g + h + 1) / 12.f) * (float)dl * 1.4426950408889634f;
        AttnS st; st.m = -1.0e30f; st.l = 0.f; st.o0 = f32x16{}; st.o1 = f32x16{};
        attn_chunk<2, true>(st, qf, 0, P, vl, lane);
        attn_chunk<2, true>(st, qf, 2, P, vl, lane);
        attn_chunk<1, true>(st, qf, 4, P, vl, lane);
        const float inv = 1.f / st.l;
        float* orow = OG + ((size_t)g * T + t) * 256 + 64 * h + 4 * hh;
#pragma unroll
        for (int rg = 0; rg < 4; ++rg) {
            *(f32x4*)(orow + 8 * rg) = (f32x4){st.o0[4 * rg] * inv, st.o0[4 * rg + 1] * inv, st.o0[4 * rg + 2] * inv, st.o0[4 * rg + 3] * inv};
            *(f32x4*)(orow + 32 + 8 * rg) = (f32x4){st.o1[4 * rg] * inv, st.o1[4 * rg + 1] * inv, st.o1[4 * rg + 2] * inv, st.o1[4 * rg + 3] * inv};
        }
        if (hh == 0) LSE[((size_t)g * T + t) * 4 + h] = st.m + __builtin_amdgcn_logf(st.l);
    }
}
__device__ __forceinline__ void merge_phase(const Frame& F, const float* OG, const float* LSE, bf16* CAT) {
    const size_t gt = (size_t)blockIdx.x * NTHREADS + F.tid, NT = (size_t)GRID * NTHREADS;
    for (size_t it = gt; it < (size_t)T * 32; it += NT) {
        const int t = (int)(it >> 5), c8 = (int)(it & 31) * 8, h = c8 >> 6;
        const float l0 = LSE[(size_t)t * 4 + h], l1 = LSE[((size_t)T + t) * 4 + h], l2 = LSE[((size_t)2 * T + t) * 4 + h];
        const float mx = fmaxf(l0, fmaxf(l1, l2)); float w0 = __builtin_amdgcn_exp2f(l0 - mx), w1 = __builtin_amdgcn_exp2f(l1 - mx), w2 = __builtin_amdgcn_exp2f(l2 - mx);
        const float inv = 1.f / (w0 + w1 + w2); w0 *= inv; w1 *= inv; w2 *= inv;
        const f32x4* p0 = (const f32x4*)(OG + (size_t)t * 256 + c8); const f32x4* p1 = (const f32x4*)(OG + ((size_t)T + t) * 256 + c8); const f32x4* p2 = (const f32x4*)(OG + ((size_t)2 * T + t) * 256 + c8);
        const f32x4 a = p0[0] * w0 + p1[0] * w1 + p2[0] * w2, b = p0[1] * w0 + p1[1] * w1 + p2[1] * w2;
        v4u o; o.x = pk2(a.x, a.y); o.y = pk2(a.z, a.w); o.z = pk2(b.x, b.y); o.w = pk2(b.z, b.w);
        *(v4u*)(CAT + (size_t)t * 512 + c8) = o;
    }
}

constexpr int NPHASE = 34;
__global__ void __launch_bounds__(NTHREADS, 2) mega(Args args) {
    extern __shared__ __attribute__((aligned(16))) unsigned char lds[];
    Frame F; F.lds = (LAS unsigned char*)lds; F.tid = threadIdx.x; F.lane = F.tid & 63; F.wave = __builtin_amdgcn_readfirstlane(F.tid >> 6); F.gw = blockIdx.x * NWAVES + F.wave;
    volatile LAS unsigned* MISC = (volatile LAS unsigned*)(F.lds + MISC_OFF);
    unsigned char* ws = args.ws;
    unsigned* ctl = (unsigned*)(ws + WS_CTL);
    for (int u = F.tid; u < (LDS_BYTES - LDSCTL_OFF) / 4; u += NTHREADS) ((LAS unsigned*)(F.lds + LDSCTL_OFF))[u] = 0u;
    __syncthreads();
    const int lo = args.lo, hi = args.hi;
    XcdBarrier bar; bar.bar = ctl + CW_BAR; bar.x = 0; bar.st = nullptr;
    if (hi - lo > 1) bar = xcd_barrier_post(ctl + CW_BAR, MISC + 8);
#define IN(k) (lo <= (k) && (k) < hi)
#if PROBE == 6
#define SEAM(k) do { if (IN(k) && IN((k) + 1)) { xcd_barrier(bar); xcd_barrier(bar); } else __syncthreads(); } while (0)
#else
#define SEAM(k) do { if (IN(k) && IN((k) + 1)) xcd_barrier(bar); else __syncthreads(); } while (0)
#endif
    const float* x_in = args.in[I_X]; float* XR = args.out;
    int* cntWG = (int*)(ws + WS_META); int* tile_e = (int*)(ws + WS_META + 16384); int* nMp = (int*)(ws + WS_META + 32768);
    int* E01 = (int*)(ws + WS_TOK); float* W01 = (float*)(ws + WS_TOK + 262144); int* DEST = (int*)(ws + WS_TOK + 524288);
    bf16* XB = (bf16*)(ws + WS_XB); bf16* MEMB = (bf16*)(ws + WS_MEMB); bf16* MEMKV = (bf16*)(ws + WS_MEMKV);
    bf16* Hb = (bf16*)(ws + WS_SCR + SC_H); bf16* CAT = (bf16*)(ws + WS_SCR + SC_CAT); bf16* DIFF = (bf16*)(ws + WS_SCR + SC_DIFF); float* OG = (float*)(ws + WS_SCR + SC_OG); float* LSE = (float*)(ws + WS_SCR + SC_LSE);
    bf16* HID = (bf16*)(ws + WS_SCR + SC_HID); bf16* XS = (bf16*)(ws + WS_SCR + SC_XS); bf16* HS = (bf16*)(ws + WS_SCR + SC_HS); bf16* YB = XS;
    const float* ln_g = args.in[I_LNG]; const float* ln_b = args.in[I_LNB];

    bf16* WSM = (bf16*)(ws + WS_WS); bf16* WMOE = (bf16*)(ws + WS_WMOE);
#if FAST_ATTN && PROBE == 2
#define MEMATTN(...) do { memattn_fast(__VA_ARGS__); memattn_fast(__VA_ARGS__); } while (0)
#elif FAST_ATTN
#define MEMATTN memattn_fast
#else
#define MEMATTN memattn_naive
#endif
#if FP8_MOE
#define CONVERT_MOE(F_, g_, u_, d_, r_) convert_moe8(F_, g_, u_, d_, (unsigned char*)WMOE, WMOE, r_)
#else
#define CONVERT_MOE(F_, g_, u_, d_, r_) convert_moe(F_, g_, u_, d_, WMOE, r_)
#endif
#if FAST_GEMM
#define GEMM_BF16(A_, B_, M_, N_, K_, O_) do { pg8::Gemm g_{A_, B_, M_, N_, K_, 0}; pg8::StaticOrder S_; S_.init(M_, N_, GRID, (int)blockIdx.x); pg8::EpiBf16<0> E_{O_, N_, nullptr, 0, 0, 1.f}; \
        pg8::gemm_phase<pg8::EpiBf16<0>, pg8::StaticOrder, true, true>(F.lds, g_, S_, E_); } while (0)
#define GEMM_RESID(A_, B_, K_, BASE_) do { pg8::Gemm g_{A_, B_, T, D, K_, 0}; pg8::StaticOrder S_; S_.init(T, D, GRID, (int)blockIdx.x); pg8::EpiResid E_{BASE_, XR, D, ALPHA}; \
        pg8::gemm_phase<pg8::EpiResid, pg8::StaticOrder, true, true>(F.lds, g_, S_, E_); } while (0)
#define GEMM_SWIGLU(A_, B_, M_, NH_, O_) do { pg8::Gemm g_{A_, B_, M_, 2 * (NH_), D, 0}; pg8::StaticOrder S_; S_.init(M_, 2 * (NH_), GRID, (int)blockIdx.x); pg8::EpiSwiglu E_{O_, NH_, EMU_FP8 == 2, 1.f}; \
        pg8::gemm_phase<pg8::EpiSwiglu, pg8::StaticOrder, true, true>(F.lds, g_, S_, E_); } while (0)
#if FP8_D && !FP8_GU
constexpr size_t WB_MD8 = 2 * OFF_MD;
#else
constexpr size_t WB_MD8 = OFF8_MD;
#endif
#if FP8_GU
#define MOE_GU_GEMM pg8::Gemm g_{XS, WMOE + OFF8_MGU / 2, nM_ * 256, 2 * FFE, D / 2, 0x7F7F7F7F}; const size_t es_ = (size_t)FFE * D; constexpr bool f8_ = true; const float sc_ = 1.f / QS_GU
#else
#define MOE_GU_GEMM pg8::Gemm g_{XS, WMOE + OFF_MGU, nM_ * 256, 2 * FFE, D, 0}; const size_t es_ = (size_t)2 * FFE * D; constexpr bool f8_ = false; const float sc_ = 1.f
#endif
#if FP8_D
#define GEMM_MOE_GU() do { const int nM_ = ld_i32_agent(nMp); MOE_GU_GEMM; pg8::MoeOrder S_; S_.init(nM_ * 256, 2 * FFE, GRID, (int)blockIdx.x); S_.tile_e = tile_e; S_.estride = es_; \
        pg8::EpiSwiglu8 E_{(unsigned char*)HS, FFE, sc_}; pg8::gemm_phase<pg8::EpiSwiglu8, pg8::MoeOrder, true, true, f8_>(F.lds, g_, S_, E_); } while (0)
#define GEMM_MOE_D() do { const int nM_ = ld_i32_agent(nMp); pg8::Gemm g_{HS, WMOE + WB_MD8 / 2, nM_ * 256, D, FFE / 2, 0x7F7F7F7F}; pg8::MoeOrder S_; S_.init(nM_ * 256, D, GRID, (int)blockIdx.x); S_.tile_e = tile_e; S_.estride = (size_t)D * FFE / 2; \
        pg8::EpiBf16<0> E_{YB, D, nullptr, 0, 0, 1.f / QS_D}; pg8::gemm_phase<pg8::EpiBf16<0>, pg8::MoeOrder, true, true, true>(F.lds, g_, S_, E_); } while (0)
#else
#define GEMM_MOE_GU() do { const int nM_ = ld_i32_agent(nMp); MOE_GU_GEMM; pg8::MoeOrder S_; S_.init(nM_ * 256, 2 * FFE, GRID, (int)blockIdx.x); S_.tile_e = tile_e; S_.estride = es_; \
        pg8::EpiSwiglu E_{HS, FFE, EMU_FP8 != 0, sc_}; pg8::gemm_phase<pg8::EpiSwiglu, pg8::MoeOrder, true, true, f8_>(F.lds, g_, S_, E_); } while (0)
#define GEMM_MOE_D() do { const int nM_ = ld_i32_agent(nMp); pg8::Gemm g_{HS, WMOE + OFF_MD, nM_ * 256, D, FFE, 0}; pg8::MoeOrder S_; S_.init(nM_ * 256, D, GRID, (int)blockIdx.x); S_.tile_e = tile_e; S_.estride = (size_t)D * FFE; \
        pg8::EpiBf16<0> E_{YB, D, nullptr, 0, 0, 1.f}; pg8::gemm_phase<pg8::EpiBf16<0>, pg8::MoeOrder, true, true>(F.lds, g_, S_, E_); } while (0)
#endif
#endif

    if (IN(0)) { prep_phase(F, x_in, args.in[I_MEM], XB, MEMB);
#if FAST_GEMM
        { int rot = 0; convert_small(F, args, WSM, rot); CONVERT_MOE(F, args.in[I_MG], args.in[I_MU], args.in[I_MD], rot); fold_pool(F, args.in[I_CPOOLW], args.in[I_CPOOLS], args.in[I_CWOUT], WSM + OFF_COUT); }
#if PROBE == 1
        { int rot = 0; convert_small(F, args, WSM, rot); CONVERT_MOE(F, args.in[I_MG], args.in[I_MU], args.in[I_MD], rot); fold_pool(F, args.in[I_CPOOLW], args.in[I_CPOOLS], args.in[I_CWOUT], WSM + OFF_COUT); }
#endif
#if PROBE == 7
        prep_phase(F, x_in, args.in[I_MEM], XB, MEMB);
#endif
#endif
        SEAM(0); }
    if (IN(1)) {
#if FAST_GEMM
        GEMM_BF16(MEMB, WSM + OFF_WKV, NB * ML, 512, D, MEMKV);
#else
        naive_gemm<1>(F, MEMB, D, args.in[I_WMEMKV], nullptr, 512, NB * ML, 512, D, NEpiBf16{MEMKV, 512}, nullptr, 0);
#endif
        SEAM(1); }

    if (IN(2)) {
#if FAST_GEMM
        GEMM_BF16(XB, WSM + OFF_AIN, T, 2560, D, Hb);
#else
        naive_gemm<1>(F, XB, D, args.in[I_AWIN], nullptr, 2560, T, 2560, D, NEpiBf16{Hb, 2560}, nullptr, 0);
#endif
        SEAM(2); }
    if (IN(3)) { mixA_phase(F, Hb, args.in[I_ACONV], CAT);
#if PROBE == 4
        mixA_phase(F, Hb, args.in[I_ACONV], CAT);
#endif
 MEMATTN(F, Hb, 2560, 2304, MEMKV, CAT, 1024, 768); SEAM(3); }
    if (IN(4)) {
#if FAST_GEMM
        GEMM_RESID(CAT, WSM + OFF_AOUT, 1024, x_in);
#else
        naive_gemm<1>(F, CAT, 1024, args.in[I_AWOUT], nullptr, D, T, D, 1024, NEpiResid{x_in, XR}, nullptr, 0);
#endif
        SEAM(4); }
    if (IN(5)) {
#if PROBE == 3
        ln_phase<false, false>(F, XR, (float*)HS, HS + (size_t)64 * MiB, ln_g + 0 * D, ln_b + 0 * D, nullptr, nullptr, nullptr, nullptr, nullptr, nullptr);
#endif
        ln_phase<false, false>(F, XR, XR, XB, ln_g + 0 * D, ln_b + 0 * D, nullptr, nullptr, nullptr, nullptr, nullptr, nullptr); SEAM(5); }
    if (IN(6)) {
#if FAST_GEMM
        GEMM_SWIGLU(XB, WSM + OFF_FGU, T, FF, HID);
#else
        naive_gemm<2>(F, XB, D, args.in[I_FG], args.in[I_FU], FF, T, FF, D, NEpiSwiglu{HID, FF}, nullptr, 0);
#endif
        SEAM(6); }
    if (IN(7)) {
#if FAST_GEMM
        GEMM_RESID(HID, WSM + OFF_FD, FF, XR);
#else
        naive_gemm<1>(F, HID, FF, args.in[I_FD], nullptr, D, T, D, FF, NEpiResid{XR, XR}, nullptr, 0);
#endif
        SEAM(7); }
    if (IN(8)) {
#if PROBE == 3
        ln_phase<false, false>(F, XR, (float*)HS, HS + (size_t)64 * MiB, ln_g + 1 * D, ln_b + 1 * D, nullptr, nullptr, nullptr, nullptr, nullptr, nullptr);
#endif
        ln_phase<false, false>(F, XR, XR, XB, ln_g + 1 * D, ln_b + 1 * D, nullptr, nullptr, nullptr, nullptr, nullptr, nullptr); SEAM(8); }

    if (IN(9)) {
#if FAST_GEMM
        GEMM_BF16(XB, WSM + OFF_BIN, T, 2560, D, Hb);
#else
        naive_gemm<1>(F, XB, D, args.in[I_BWIN], nullptr, 2560, T, 2560, D, NEpiBf16{Hb, 2560}, nullptr, 0);
#endif
        SEAM(9); }
#if FAST_ATTN
    if (IN(10)) { dilattn_fast(F, Hb, OG, LSE);
#if PROBE == 2
        dilattn_fast(F, Hb, OG, LSE);
#endif
        MEMATTN(F, Hb, 2560, 2304, MEMKV, CAT, 512, 256); SEAM(10); }
    if (IN(11)) { merge_phase(F, OG, LSE, CAT);
#if PROBE == 2
        merge_phase(F, OG, LSE, CAT);
#endif
        SEAM(11); }
#else
    if (IN(10)) { dilattn_naive(F, Hb, CAT, 512); MEMATTN(F, Hb, 2560, 2304, MEMKV, CAT, 512, 256); SEAM(10); }
    if (IN(11)) { SEAM(11); }
#endif
    if (IN(12)) {
#if FAST_GEMM
        GEMM_RESID(CAT, WSM + OFF_BOUT, 512, XR);
#else
        naive_gemm<1>(F, CAT, 512, args.in[I_BWOUT], nullptr, D, T, D, 512, NEpiResid{XR, XR}, nullptr, 0);
#endif
        SEAM(12); }
    if (IN(13)) { ln_phase<true, false>(F, XR, XR, XB, ln_g + 2 * D, ln_b + 2 * D, args.in[I_ROUTER], E01, W01, nullptr, nullptr, cntWG); SEAM(13); }
    if (IN(14)) { scatter_phase(F, cntWG, E01, DEST, XB, XS, tile_e, nMp);
#if PROBE == 5
        scatter_phase(F, cntWG, E01, DEST, XB, XS, tile_e, nMp);
#endif
        SEAM(14); }
    if (IN(15)) {
#if FAST_GEMM
        GEMM_MOE_GU();
#else
        const int nM = ld_i32_agent(nMp); naive_gemm<2>(F, XS, D, args.in[I_MG], args.in[I_MU], FFE, nM * 256, FFE, D, NEpiSwiglu{HS, FFE}, tile_e, (size_t)D * FFE);
#endif
        SEAM(15); }
    if (IN(16)) {
#if FAST_GEMM
        GEMM_MOE_D();
#else
        const int nM = ld_i32_agent(nMp); naive_gemm<1>(F, HS, FFE, args.in[I_MD], nullptr, D, nM * 256, D, FFE, NEpiBf16{YB, D}, tile_e, (size_t)FFE * D);
#endif
        SEAM(16); }
    if (IN(17)) { ln_phase<false, true>(F, XR, XR, XB, ln_g + 3 * D, ln_b + 3 * D, nullptr, nullptr, W01, DEST, YB, nullptr); SEAM(17); }

    if (IN(18)) {
#if FAST_GEMM
        GEMM_BF16(XB, WSM + OFF_CIN, T, 1024, D, Hb);
#else
        naive_gemm<1>(F, XB, D, args.in[I_CWIN], nullptr, 1024, T, 1024, D, NEpiBf16{Hb, 1024}, nullptr, 0);
#endif
        SEAM(18); }
#if FAST_GEMM
    if (IN(19)) { poolC_phase(F, Hb, CAT, 1024);
#if PROBE == 4
        poolC_phase(F, Hb, CAT, 1024);
#endif
        MEMATTN(F, Hb, 1024, 768, MEMKV, CAT, 1024, 768);
        { int rot = 0; CONVERT_MOE(F, args.in[I_MG] + (size_t)NE * D * FFE, args.in[I_MU] + (size_t)NE * D * FFE, args.in[I_MD] + (size_t)NE * FFE * D, rot); }
#if PROBE == 1
        { int rot = 0; CONVERT_MOE(F, args.in[I_MG] + (size_t)NE * D * FFE, args.in[I_MU] + (size_t)NE * D * FFE, args.in[I_MD] + (size_t)NE * FFE * D, rot); }
#endif
        SEAM(19); }
#else
    if (IN(19)) { poolC_phase(F, Hb, DIFF, 768); MEMATTN(F, Hb, 1024, 768, MEMKV, CAT, 1024, 768); SEAM(19); }
    if (IN(20)) {
#pragma unroll 1
        for (int g = 0; g < 4; ++g) naive_gemm<1>(F, DIFF + 192 * g, 768, args.in[I_CPOOLW] + (size_t)g * 192 * 192, nullptr, 192, T, 192, 192, NEpiScale{CAT, 1024, 192 * g, args.in[I_CPOOLS]}, nullptr, 0);
        SEAM(20); }
#endif
    if (IN(21)) {
#if FAST_GEMM
        GEMM_RESID(CAT, WSM + OFF_COUT, 1024, XR);
#else
        naive_gemm<1>(F, CAT, 1024, args.in[I_CWOUT], nullptr, D, T, D, 1024, NEpiResid{XR, XR}, nullptr, 0);
#endif
        SEAM(21); }
    if (IN(22)) {
#if PROBE == 3
        ln_phase<false, false>(F, XR, (float*)HS, HS + (size_t)64 * MiB, ln_g + 4 * D, ln_b + 4 * D, nullptr, nullptr, nullptr, nullptr, nullptr, nullptr);
#endif
        ln_phase<false, false>(F, XR, XR, XB, ln_g + 4 * D, ln_b + 4 * D, nullptr, nullptr, nullptr, nullptr, nullptr, nullptr); SEAM(22); }
    if (IN(23)) {
#if FAST_GEMM
        GEMM_SWIGLU(XB, WSM + OFF_FGU + (size_t)2 * FF * D, T, FF, HID);
#else
        naive_gemm<2>(F, XB, D, args.in[I_FG] + (size_t)D * FF, args.in[I_FU] + (size_t)D * FF, FF, T, FF, D, NEpiSwiglu{HID, FF}, nullptr, 0);
#endif
        SEAM(23); }
    if (IN(24)) {
#if FAST_GEMM
        GEMM_RESID(HID, WSM + OFF_FD + (size_t)D * FF, FF, XR);
#else
        naive_gemm<1>(F, HID, FF, args.in[I_FD] + (size_t)FF * D, nullptr, D, T, D, FF, NEpiResid{XR, XR}, nullptr, 0);
#endif
        SEAM(24); }
    if (IN(25)) {
#if PROBE == 3
        ln_phase<false, false>(F, XR, (float*)HS, HS + (size_t)64 * MiB, ln_g + 5 * D, ln_b + 5 * D, nullptr, nullptr, nullptr, nullptr, nullptr, nullptr);
#endif
        ln_phase<false, false>(F, XR, XR, XB, ln_g + 5 * D, ln_b + 5 * D, nullptr, nullptr, nullptr, nullptr, nullptr, nullptr); SEAM(25); }

    if (IN(26)) {
#if FAST_GEMM
        GEMM_BF16(XB, WSM + OFF_AIN + (size_t)2560 * D, T, 2560, D, Hb);
#else
        naive_gemm<1>(F, XB, D, args.in[I_AWIN] + (size_t)D * 2560, nullptr, 2560, T, 2560, D, NEpiBf16{Hb, 2560}, nullptr, 0);
#endif
        SEAM(26); }
    if (IN(27)) { mixA_phase(F, Hb, args.in[I_ACONV] + 3 * 768, CAT);
#if PROBE == 4
        mixA_phase(F, Hb, args.in[I_ACONV] + 3 * 768, CAT);
#endif
 MEMATTN(F, Hb, 2560, 2304, MEMKV, CAT, 1024, 768); SEAM(27); }
    if (IN(28)) {
#if FAST_GEMM
        GEMM_RESID(CAT, WSM + OFF_AOUT + (size_t)D * D, 1024, XR);
#else
        naive_gemm<1>(F, CAT, 1024, args.in[I_AWOUT] + (size_t)D * D, nullptr, D, T, D, 1024, NEpiResid{XR, XR}, nullptr, 0);
#endif
        SEAM(28); }
    if (IN(29)) { ln_phase<true, false>(F, XR, XR, XB, ln_g + 6 * D, ln_b + 6 * D, args.in[I_ROUTER] + D * NE, E01, W01, nullptr, nullptr, cntWG); SEAM(29); }
    if (IN(30)) { scatter_phase(F, cntWG, E01, DEST, XB, XS, tile_e, nMp);
#if PROBE == 5
        scatter_phase(F, cntWG, E01, DEST, XB, XS, tile_e, nMp);
#endif
        SEAM(30); }
    if (IN(31)) {
#if FAST_GEMM
        GEMM_MOE_GU();
#else
        const int nM = ld_i32_agent(nMp); naive_gemm<2>(F, XS, D, args.in[I_MG] + (size_t)NE * D * FFE, args.in[I_MU] + (size_t)NE * D * FFE, FFE, nM * 256, FFE, D, NEpiSwiglu{HS, FFE}, tile_e, (size_t)D * FFE);
#endif
        SEAM(31); }
    if (IN(32)) {
#if FAST_GEMM
        GEMM_MOE_D();
#else
        const int nM = ld_i32_agent(nMp); naive_gemm<1>(F, HS, FFE, args.in[I_MD] + (size_t)NE * FFE * D, nullptr, D, nM * 256, D, FFE, NEpiBf16{YB, D}, tile_e, (size_t)FFE * D);
#endif
        SEAM(32); }
    if (IN(33)) { ln_phase<false, true>(F, XR, XR, XB, ln_g + 7 * D, ln_b + 7 * D, nullptr, nullptr, W01, DEST, YB, nullptr); }
#undef IN
#undef SEAM
}

extern "C" void kernel_launch(void* const* d_in, const int* in_sizes, int n_in, void* d_out, int out_size, void* d_ws, size_t ws_size, hipStream_t stream) {
    static int ok = 0;
    if (ok == 0) {
        ok = 1;
        if (n_in != 21 || out_size != T * D || ws_size < WS_END) { fprintf(stderr, "kernel_launch: unexpected shapes (n_in %d, out %d, ws %zu < %zu)\n", n_in, out_size, ws_size, (size_t)WS_END); ok = -1; }
        if (ok > 0 && hipFuncSetAttribute((const void*)mega, hipFuncAttributeMaxDynamicSharedMemorySize, LDS_BYTES) != hipSuccess) { fprintf(stderr, "kernel_launch: hipFuncSetAttribute failed\n"); ok = -1; }
        int dev = 0, cus = 0; (void)hipGetDevice(&dev); (void)hipDeviceGetAttribute(&cus, hipDeviceAttributeMultiprocessorCount, dev);
        if (cus < GRID) { fprintf(stderr, "kernel_launch: %d CUs < %d\n", cus, GRID); ok = -1; }
        (void)hipGetLastError();
    }
    if (ok < 0) return;
    (void)hipMemsetAsync((char*)d_ws + WS_CTL, 0, CTL_ZERO_BYTES, stream);
    Args a{};
    for (int i = 0; i < 21; ++i) a.in[i] = (const float*)d_in[i];
    a.out = (float*)d_out; a.ws = (unsigned char*)d_ws;
#if MK_ONE_LAUNCH
    a.lo = 0; a.hi = NPHASE;
    hipLaunchKernelGGL(mega, dim3(GRID), dim3(NTHREADS), LDS_BYTES, stream, a);
#else
    for (int p = 0; p < NPHASE; ++p) { if (p == 11) continue; a.lo = p; a.hi = p + 1; hipLaunchKernelGGL(mega, dim3(GRID), dim3(NTHREADS), LDS_BYTES, stream, a); }
#endif
}
```

```cpp
#include <hip/hip_runtime.h>
#include <cstdio>
#include <cstdint>

#ifndef MK_ONE_LAUNCH
#define MK_ONE_LAUNCH 1
#endif
#ifndef FAST_GEMM
#define FAST_GEMM 1
#endif
#ifndef FAST_ATTN
#define FAST_ATTN 1
#endif

#ifndef PROBE
#define PROBE 0
#endif

#ifndef FP8_MOE
#define FP8_MOE 1
#endif
#define FP8_GU (FP8_MOE == 1 || FP8_MOE == 2)
#define FP8_D  (FP8_MOE == 1 || FP8_MOE == 3)
#ifndef EMU_FP8
#define EMU_FP8 0
#endif

#define GAS __attribute__((address_space(1)))
#define LAS __attribute__((address_space(3)))
typedef unsigned short bf16;
typedef unsigned v4u __attribute__((ext_vector_type(4)));
typedef unsigned v2u __attribute__((ext_vector_type(2)));
typedef float f32x4 __attribute__((ext_vector_type(4)));
typedef float f32x2 __attribute__((ext_vector_type(2)));
typedef float f32x16 __attribute__((ext_vector_type(16)));
typedef short bf16x8 __attribute__((ext_vector_type(8)));
typedef short s16x4 __attribute__((ext_vector_type(4)));
#define RLX_AGENT __ATOMIC_RELAXED, __HIP_MEMORY_SCOPE_AGENT
#define LDS_WAIT() asm volatile("s_waitcnt lgkmcnt(0)" ::: "memory")
#define VM_WAIT() asm volatile("s_waitcnt vmcnt(0)" ::: "memory")

constexpr int NB = 16, SEQ = 2048, T = NB * SEQ, D = 1024, ML = 256, MEMW = 256, MIXW = 768, HD = 64;
constexpr int FF = 2816, FFE = 3584, NE = 8;
constexpr int RMAX = (2 * T / 256 + NE) * 256;
constexpr float ALPHA = 1.6817928305074290f;
constexpr float LN_EPS = 1e-5f;
constexpr int NWAVES = 8, NTHREADS = 512, GRID = 256, NGW = GRID * NWAVES;

constexpr size_t MiB = 1u << 20;
constexpr size_t WS_CTL = 0, CTL_ZERO_BYTES = 1 * MiB;
constexpr size_t WS_META = 1 * MiB;
constexpr size_t WS_TOK = 2 * MiB;
constexpr size_t WS_WS = 4 * MiB;
constexpr size_t WS_WMOE = 64 * MiB;
constexpr size_t WS_XB = 232 * MiB;
constexpr size_t WS_MEMB = 296 * MiB;
constexpr size_t WS_MEMKV = 304 * MiB;
constexpr size_t WS_SCR = 308 * MiB;
constexpr size_t SC_H = 0, SC_CAT = 160 * MiB, SC_OG = 224 * MiB, SC_LSE = 320 * MiB, SC_DIFF = 224 * MiB;
constexpr size_t SC_HID = 0;
constexpr size_t SC_XS = 0, SC_HS = 132 * MiB;
constexpr size_t WS_END = WS_SCR + SC_HS + (size_t)RMAX * FFE * 2;
static_assert(WS_END <= 903 * MiB, "ws map");
constexpr size_t OFF_WKV = 0, OFF_AIN = 524288, OFF_AOUT = 5767168, OFF_BIN = 7864320, OFF_BOUT = 10485760, OFF_CIN = 11010048,
                 OFF_COUT = 12058624, OFF_FGU = 13107200, OFF_FD = 24641536, OFF_WS_END = 30408704;
static_assert(OFF_WS_END * 2 <= 60 * MiB, "small weights");
constexpr size_t OFF_MGU = 0, OFF_MD = (size_t)NE * 2 * FFE * D;
constexpr int CW_BAR = 4096;

constexpr int RING_BYTES = 131072, LDSCTL_OFF = RING_BYTES, MISC_OFF = LDSCTL_OFF + 320, LDS_BYTES = 147456;

__device__ __forceinline__ unsigned f2bf(float f) { unsigned u = __builtin_bit_cast(unsigned, f); return (u + 0x7fffu + ((u >> 16) & 1u)) >> 16; }
__device__ __forceinline__ float q8(float x) { const float ax = fabsf(x); if (ax < 0.015625f) return copysignf(rintf(ax * 512.f) * (1.f / 512.f), x); if (ax > 448.f) return copysignf(448.f, x);
    unsigned u = __builtin_bit_cast(unsigned, x); u += 0x7FFFFu + ((u >> 20) & 1u); u &= 0xFFF00000u; return __builtin_bit_cast(float, u); }
__device__ __forceinline__ unsigned pk2(float lo, float hi) { return f2bf(lo) | (f2bf(hi) << 16); }
__device__ __forceinline__ float bf2f(unsigned b) { return __builtin_bit_cast(float, b << 16); }
__device__ __forceinline__ float bflo(unsigned w) { return __builtin_bit_cast(float, w << 16); }
__device__ __forceinline__ float bfhi(unsigned w) { return __builtin_bit_cast(float, w & 0xffff0000u); }
__device__ __forceinline__ float wave_sum(float v) {
#pragma unroll
    for (int o = 1; o < 64; o <<= 1) v += __shfl_xor(v, o);
    return v;
}
__device__ __forceinline__ int ld_i32_agent(const int* p) { return (int)__hip_atomic_load((const unsigned*)p, RLX_AGENT); }
__device__ __forceinline__ float ld_f32_agent(const float* p) { return __builtin_bit_cast(float, __hip_atomic_load((const unsigned*)p, RLX_AGENT)); }

#define XB_TMO      128
#define XB_XCNT(j)  (256  + 64 * (j))
#define XB_XSUB(j)  (1280 + 64 * (j))
#define XB_XGEN(j)  (2304 + 64 * (j))
#define XB_TOP      3328
#define XB_TOPGEN   3392
#define XCD_BAR_WORDS 3456
#define XB_SPIN_CAP (1u << 18)
__device__ __forceinline__ unsigned xb_ld(unsigned* p)              { return __hip_atomic_load(p, __ATOMIC_RELAXED, __HIP_MEMORY_SCOPE_AGENT); }
__device__ __forceinline__ unsigned xb_add(unsigned* p, unsigned v) { return __hip_atomic_fetch_add(p, v, __ATOMIC_RELAXED, __HIP_MEMORY_SCOPE_AGENT); }
__device__ __forceinline__ unsigned xb_xcc_id() { return (unsigned)__builtin_amdgcn_s_getreg((3 << 11) | 20) & 0xFu; }
#define XB_SPIN(cond, bar) do { unsigned _sp = 0; while (cond) { __builtin_amdgcn_s_sleep(1); \
    if ((++_sp & 255u) == 0u) { if (xb_ld(&(bar)[XB_TMO])) break; if (_sp > XB_SPIN_CAP) { atomicAdd(&(bar)[XB_TMO], 1u); break; } } } } while (0)
struct XcdBarrier { unsigned* bar; unsigned x; volatile LAS unsigned* st; };
__device__ __forceinline__ XcdBarrier xcd_barrier_post(unsigned* bar, volatile LAS unsigned* st) {
    XcdBarrier b; b.bar = bar; b.x = xb_xcc_id(); b.st = st;
    if (threadIdx.x == 0) (void)xb_add(&bar[XB_XCNT(b.x)], 1u);
    return b;
}
__device__ __forceinline__ void xcd_barrier_complete(unsigned* bar, unsigned x, unsigned& nloc, unsigned& nx) {
    const unsigned G = gridDim.x * gridDim.y * gridDim.z;
    unsigned sum, cnt, mine, sp = 0u;
    for (;;) {
        sum = 0u; cnt = 0u; mine = 0u;
#pragma unroll
        for (unsigned j = 0; j < 16; ++j) { const unsigned c = xb_ld(&bar[XB_XCNT(j)]); sum += c; cnt += (c > 0u) ? 1u : 0u; mine = (j == x) ? c : mine; }
        if (sum == G) break;
        __builtin_amdgcn_s_sleep(1);
        if ((++sp & 255u) == 0u) { if (xb_ld(&bar[XB_TMO])) break; if (sp > XB_SPIN_CAP) { atomicAdd(&bar[XB_TMO], 1u); break; } }
    }
    nloc = mine > 0u ? mine : 1u; nx = cnt > 0u ? cnt : 1u;
}
__device__ __forceinline__ void xcd_barrier(const XcdBarrier& b) {
    asm volatile("s_waitcnt vmcnt(0)" ::: "memory");
    __syncthreads();
    if (threadIdx.x == 0) {
        unsigned* bar = b.bar;
        __builtin_amdgcn_s_waitcnt(0);
        unsigned nloc = b.st[0], nx = b.st[1];
        if (nloc == 0u) { xcd_barrier_complete(bar, b.x, nloc, nx); b.st[0] = nloc; b.st[1] = nx; }
        const unsigned old = xb_add(&bar[XB_XSUB(b.x)], 1u);
        const unsigned gen = old / nloc;
        if (old + 1u == (gen + 1u) * nloc) {
            __builtin_amdgcn_fence(__ATOMIC_RELEASE, "agent");
            asm volatile("s_waitcnt vmcnt(0)" ::: "memory");
            const unsigned og = xb_add(&bar[XB_TOP], 1u);
            const unsigned tg = og / nx;
            if (og + 1u == (tg + 1u) * nx) xb_add(&bar[XB_TOPGEN], 1u);
            else XB_SPIN(xb_ld(&bar[XB_TOPGEN]) == tg, bar);
            __builtin_amdgcn_fence(__ATOMIC_ACQUIRE, "agent");
            xb_add(&bar[XB_XGEN(b.x)], 1u);
            asm volatile("s_waitcnt vmcnt(0)" ::: "memory");
        } else {
            XB_SPIN(xb_ld(&bar[XB_XGEN(b.x)]) == gen, bar);
            __builtin_amdgcn_fence(__ATOMIC_ACQUIRE, "agent");
            asm volatile("s_waitcnt vmcnt(0)" ::: "memory");
        }
    }
    __syncthreads();
}

namespace pg8 {
#define PG8_LAS __attribute__((address_space(3)))
typedef unsigned short bf16_t;
typedef short bf16x8 __attribute__((ext_vector_type(8)));
typedef float f32x4 __attribute__((ext_vector_type(4)));
typedef unsigned u32x4 __attribute__((ext_vector_type(4)));
constexpr int BM = 256, BK = 64, HALF = 128, HTB = HALF * BK * 2  , STAGE_BYTES = 8 * HTB, NXCD = 8, WGM = 8;

__host__ __device__ __forceinline__ int lds_byte(int r, int c) { const int st = (r >> 4) * 2 + (c >> 5), rr = r & 15, cc = c & 31, ob = rr * 64 + cc * 2; return st * 1024 + (ob ^ (((ob >> 9) & 1) << 5)); }
__host__ __device__ __forceinline__ void stage_rc(int b, int& R, int& C) { const int st = b / 1024, sb = b % 1024, swz = sb ^ (((sb >> 9) & 1) << 5); R = (st >> 1) * 16 + swz / 64; C = (st & 1) * 32 + (swz % 64) / 2; }
__host__ __device__ __forceinline__ int perm32(int rho) { const int n = rho >> 4, i = rho & 15; return 8 * (i >> 2) + 4 * n + (i & 3); }

struct Unit { int pm, pn; };
struct Gemm { const bf16_t* A; const bf16_t* Bt; int M, N, K; int wscale; };
typedef int v8i __attribute__((ext_vector_type(8)));
typedef int v4i __attribute__((ext_vector_type(4)));
__device__ __forceinline__ void mfma8(f32x4& acc, const v8i& a, const v8i& b, int sa, int sb) {
    asm volatile("s_nop 1\n\tv_mfma_scale_f32_16x16x128_f8f6f4 %0, %1, %2, %0, %3, %4 op_sel_hi:[0,0,0]" : "+v"(acc) : "v"(a), "v"(b), "v"(sa), "v"(sb)); }
__device__ __forceinline__ bf16x8 lo8(const v8i v) { const v4i t = __builtin_shufflevector(v, v, 0, 1, 2, 3); return __builtin_bit_cast(bf16x8, t); }
__device__ __forceinline__ bf16x8 hi8(const v8i v) { const v4i t = __builtin_shufflevector(v, v, 4, 5, 6, 7); return __builtin_bit_cast(bf16x8, t); }
__device__ __forceinline__ v8i cat8(bf16x8 a, bf16x8 b) { return __builtin_shufflevector(__builtin_bit_cast(v4i, a), __builtin_bit_cast(v4i, b), 0, 1, 2, 3, 4, 5, 6, 7); }

struct StaticOrder {
    int nM, nN, nwg, G, c;
    __host__ __device__ void init(int M, int N, int G_, int c_) { nM = M / BM; nN = N / BM; nwg = nM * nN; G = G_; c = c_; }
    __host__ __device__ bool next(int i, Unit& u) const {
        const long L = (long)i * G + c; if (L >= nwg) return false;
        int wgid = (int)L; { const int q = nwg / NXCD, r = nwg % NXCD, xcd = wgid % NXCD, off = wgid / NXCD; wgid = (xcd < r ? xcd * (q + 1) : r * (q + 1) + (xcd - r) * q) + off; }
        const int nig = WGM * nN, gid = wgid / nig, fm = gid * WGM, gsz = (nM - fm) < WGM ? (nM - fm) : WGM;
        u.pm = fm + ((wgid % nig) % gsz); u.pn = (wgid % nig) / gsz; return true;
    }
    __device__ __forceinline__ void a_ready(const Unit&) const {}
    __device__ __forceinline__ void done(const Unit&) const {}
    __device__ __forceinline__ size_t boff(const Unit&) const { return 0; }
};
struct MoeOrder : StaticOrder {
    const int* tile_e; size_t estride;
    __device__ __forceinline__ size_t boff(const Unit& u) const { return (size_t)__builtin_amdgcn_readfirstlane((int)__hip_atomic_load((const unsigned*)tile_e + u.pm, __ATOMIC_RELAXED, __HIP_MEMORY_SCOPE_AGENT)) * estride; }
};

__device__ __forceinline__ unsigned cvt_pk_bf16(float lo, float hi) { unsigned r; asm volatile("v_cvt_pk_bf16_f32 %0, %1, %2" : "=v"(r) : "v"(lo), "v"(hi)); return r; }
typedef float f32x2 __attribute__((ext_vector_type(2)));
template <int ACT  > struct EpiBf16 {
    static constexpr bool PERM = true, AFTER_DRAIN = false; static_assert(ACT == 0, "EpiBf16: ACT is 0");
    bf16_t* O; int ldc; const float* bias; int split_cols; size_t split_stride; float scale0;
    __device__ __forceinline__ void operator()(const f32x4 (&acc)[2][2][4][2], const Unit& u, int wr, int wc, int fr, int fq) const {
        const int row0 = u.pm * BM + wr * 64 + fr; int colt = u.pn * BM; bf16_t* base = O;
        float sc = scale0; if (split_cols) { const int t = colt / split_cols; base += (size_t)t * split_stride; colt -= t * split_cols; if (t != 0) sc = 1.f; }
        const int col0 = colt + wc * 32 + 8 * fq, bcol0 = u.pn * BM + wc * 32 + 8 * fq;
        f32x4 bv[2][2];
#pragma unroll
        for (int bj = 0; bj < 2; ++bj)
#pragma unroll
            for (int n = 0; n < 2; ++n) bv[bj][n] = bias ? *(const f32x4*)(bias + bcol0 + bj * HALF + 4 * n) : (f32x4){0.f, 0.f, 0.f, 0.f};
#pragma unroll
        for (int ai = 0; ai < 2; ++ai)
#pragma unroll
            for (int m = 0; m < 4; ++m) { bf16_t* rowp = base + (size_t)(row0 + ai * HALF + m * 16) * ldc + col0;
#pragma unroll
                for (int bj = 0; bj < 2; ++bj) { f32x4 v0 = acc[ai][bj][m][0] + bv[bj][0], v1 = acc[ai][bj][m][1] + bv[bj][1];
                    v0 = v0 * sc; v1 = v1 * sc; u32x4 w; w.x = cvt_pk_bf16(v0[0], v0[1]); w.y = cvt_pk_bf16(v0[2], v0[3]); w.z = cvt_pk_bf16(v1[0], v1[1]); w.w = cvt_pk_bf16(v1[2], v1[3]);
                    *(u32x4*)(rowp + bj * HALF) = w; } }
    }
};

struct EpiSwiglu {
    static constexpr bool PERM = true, AFTER_DRAIN = false;
    bf16_t* O; int ldc; int quant; float sc;
    __device__ __forceinline__ void operator()(const f32x4 (&acc)[2][2][4][2], const Unit& u, int wr, int wc, int fr, int fq) const {
        const int row0 = u.pm * BM + wr * 64 + fr, col0 = u.pn * HALF + wc * 32 + 8 * fq;
#pragma unroll
        for (int ai = 0; ai < 2; ++ai)
#pragma unroll
            for (int m = 0; m < 4; ++m) { bf16_t* rowp = O + (size_t)(row0 + ai * HALF + m * 16) * ldc + col0;
                float h[8];
#pragma unroll
                for (int n = 0; n < 2; ++n)
#pragma unroll
                    for (int j = 0; j < 4; ++j) { const float gte = acc[ai][0][m][n][j] * sc, up = acc[ai][1][m][n][j] * sc;
                        h[4 * n + j] = gte * __builtin_amdgcn_rcpf(1.0f + __builtin_amdgcn_exp2f(-1.4426950408889634f * gte)) * up; if (quant) h[4 * n + j] = q8(h[4 * n + j]); }
                u32x4 w; w.x = cvt_pk_bf16(h[0], h[1]); w.y = cvt_pk_bf16(h[2], h[3]); w.z = cvt_pk_bf16(h[4], h[5]); w.w = cvt_pk_bf16(h[6], h[7]);
                *(u32x4*)rowp = w; }
    }
};

struct EpiSwiglu8 {
    static constexpr bool PERM = true, AFTER_DRAIN = false;
    unsigned char* O; int ldc; float sc;
    __device__ __forceinline__ void operator()(const f32x4 (&acc)[2][2][4][2], const Unit& u, int wr, int wc, int fr, int fq) const {
        const int row0 = u.pm * BM + wr * 64 + fr, col0 = u.pn * HALF + wc * 32 + 8 * fq;
#pragma unroll
        for (int ai = 0; ai < 2; ++ai)
#pragma unroll
            for (int m = 0; m < 4; ++m) { unsigned char* rowp = O + (size_t)(row0 + ai * HALF + m * 16) * ldc + col0;
                float h[8];
#pragma unroll
                for (int n = 0; n < 2; ++n)
#pragma unroll
                    for (int j = 0; j < 4; ++j) { const float gte = acc[ai][0][m][n][j] * sc, up = acc[ai][1][m][n][j] * sc;
                        h[4 * n + j] = gte * __builtin_amdgcn_rcpf(1.0f + __builtin_amdgcn_exp2f(-1.4426950408889634f * gte)) * up; }
                int p0 = 0, p1 = 0;
                p0 = __builtin_amdgcn_cvt_pk_fp8_f32(h[0], h[1], p0, false); p0 = __builtin_amdgcn_cvt_pk_fp8_f32(h[2], h[3], p0, true);
                p1 = __builtin_amdgcn_cvt_pk_fp8_f32(h[4], h[5], p1, false); p1 = __builtin_amdgcn_cvt_pk_fp8_f32(h[6], h[7], p1, true);
                typedef int i32x2 __attribute__((ext_vector_type(2)));
                *(i32x2*)rowp = (i32x2){p0, p1}; }
    }
};

template <bool BASE_F32> struct EpiResidB {
    static constexpr bool PERM = true, AFTER_DRAIN = false;
    const void* base; bf16_t* out; float alpha;
    __device__ __forceinline__ void operator()(const f32x4 (&acc)[2][2][4][2], const Unit& u, int wr, int wc, int fr, int fq) const {
        const int row0 = u.pm * BM + wr * 64 + fr, col0 = u.pn * BM + wc * 32 + 8 * fq;
#pragma unroll
        for (int ai = 0; ai < 2; ++ai)
#pragma unroll
            for (int m = 0; m < 4; ++m) { const size_t ro = (size_t)(row0 + ai * HALF + m * 16) * 1024 + col0;
                float bs[2][8];
#pragma unroll
                for (int bj = 0; bj < 2; ++bj) {
                    if constexpr (BASE_F32) { const f32x4 a = *(const f32x4*)((const float*)base + ro + bj * HALF), c = *(const f32x4*)((const float*)base + ro + bj * HALF + 4);
#pragma unroll
                        for (int j = 0; j < 4; ++j) { bs[bj][j] = a[j]; bs[bj][4 + j] = c[j]; } }
                    else { const u32x4 w = *(const u32x4*)((const bf16_t*)base + ro + bj * HALF);
                        bs[bj][0] = __builtin_bit_cast(float, w.x << 16); bs[bj][1] = __builtin_bit_cast(float, w.x & 0xffff0000u); bs[bj][2] = __builtin_bit_cast(float, w.y << 16); bs[bj][3] = __builtin_bit_cast(float, w.y & 0xffff0000u);
                        bs[bj][4] = __builtin_bit_cast(float, w.z << 16); bs[bj][5] = __builtin_bit_cast(float, w.z & 0xffff0000u); bs[bj][6] = __builtin_bit_cast(float, w.w << 16); bs[bj][7] = __builtin_bit_cast(float, w.w & 0xffff0000u); } }
#pragma unroll
                for (int bj = 0; bj < 2; ++bj) { float z[8];
#pragma unroll
                    for (int j = 0; j < 8; ++j) z[j] = bs[bj][j] * alpha + acc[ai][bj][m][j >> 2][j & 3];
                    u32x4 w; w.x = cvt_pk_bf16(z[0], z[1]); w.y = cvt_pk_bf16(z[2], z[3]); w.z = cvt_pk_bf16(z[4], z[5]); w.w = cvt_pk_bf16(z[6], z[7]);
                    *(u32x4*)(out + ro + bj * HALF) = w; } }
    }
};
struct EpiResid {
    static constexpr bool PERM = false, AFTER_DRAIN = false;
    const float* base; float* out; int ldc; float alpha;
    __device__ __forceinline__ void operator()(const f32x4 (&acc)[2][2][4][2], const Unit& u, int wr, int wc, int fr, int fq) const {
        const int row0 = u.pm * BM + wr * 64 + fr, col0 = u.pn * BM + wc * 32 + 4 * fq;
#pragma unroll
        for (int ai = 0; ai < 2; ++ai)
#pragma unroll
            for (int m = 0; m < 4; ++m) { const size_t ro = (size_t)(row0 + ai * HALF + m * 16) * ldc + col0;
                f32x4 bs[2][2];
#pragma unroll
                for (int bj = 0; bj < 2; ++bj)
#pragma unroll
                    for (int n = 0; n < 2; ++n) bs[bj][n] = *(const f32x4*)(base + ro + bj * HALF + n * 16);
#pragma unroll
                for (int bj = 0; bj < 2; ++bj)
#pragma unroll
                    for (int n = 0; n < 2; ++n) *(f32x4*)(out + ro + bj * HALF + n * 16) = bs[bj][n] * alpha + acc[ai][bj][m][n]; }
    }
};

template <class Epi, class Sched, bool ALIGN_EPI = false, bool SP2 = false, bool F8 = false>
__device__ __forceinline__ void gemm_phase(PG8_LAS unsigned char* lds, const Gemm g, const Sched& S, const Epi& E) {
    const int tid = threadIdx.x, wid = __builtin_amdgcn_readfirstlane(tid >> 6), lane = tid & 63, wr = wid >> 2, wc = wid & 3, fr = lane & 15, fq = lane >> 4;
    const int K = g.K, nt = K / BK; const int wsc = g.wscale;
    unsigned voffA[2], voffB[2];
#pragma unroll
    for (int i = 0; i < 2; ++i) { int R, C; stage_rc(tid * 16 + i * 8192, R, C); const int Rb = Epi::PERM ? ((R & ~31) + perm32(R & 31)) : R;
        voffA[i] = (unsigned)(R * K + C) * 2u; voffB[i] = (unsigned)(Rb * K + C) * 2u; }
    const size_t kstep = (size_t)(BK * 2);
    const size_t hstep = (size_t)HALF * K * 2;
    const size_t tstep = 2 * hstep;
    const unsigned ldsw = (unsigned)wid * 1024u;
    const int aoff = lds_byte(wr * 64 + fr, fq * 8), boff = lds_byte(wc * 32 + fr, fq * 8);
#define PG8_SA(b, h) (((b) * 2 + (h)) * HTB)
#define PG8_SB(b, h) ((4 + (b) * 2 + (h)) * HTB)
#define PG8_STAGE(bufoff, gbase, voff) do { _Pragma("unroll") for (int _i = 0; _i < 2; ++_i) \
        __builtin_amdgcn_global_load_lds((const unsigned*)((const char*)(gbase) + (voff)[_i]), (PG8_LAS unsigned*)(lds + (bufoff) + ldsw + _i * 8192), 16, 0, 0); } while (0)
#define PG8_LDA(dst, b, h) do { _Pragma("unroll") for (int m = 0; m < 4; ++m) dst[m] = cat8(*(const PG8_LAS bf16x8*)(lds + PG8_SA(b, h) + aoff + m * 2048), *(const PG8_LAS bf16x8*)(lds + PG8_SA(b, h) + aoff + m * 2048 + 1024)); } while (0)
#define PG8_LDB(dst, b, h) do { _Pragma("unroll") for (int n = 0; n < 2; ++n) dst[n] = cat8(*(const PG8_LAS bf16x8*)(lds + PG8_SB(b, h) + boff + n * 2048), *(const PG8_LAS bf16x8*)(lds + PG8_SB(b, h) + boff + n * 2048 + 1024)); } while (0)
#define PG8_MMA(ai, bj, At, Bt) do { __builtin_amdgcn_s_setprio(1); _Pragma("unroll") for (int m = 0; m < 4; ++m) _Pragma("unroll") for (int n = 0; n < 2; ++n) { \
        if constexpr (F8) mfma8(acc[ai][bj][m][n], Bt[n], At[m], wsc, 0x7F7F7F7F); \
        else { acc[ai][bj][m][n] = __builtin_amdgcn_mfma_f32_16x16x32_bf16(lo8(Bt[n]), lo8(At[m]), acc[ai][bj][m][n], 0, 0, 0); \
               acc[ai][bj][m][n] = __builtin_amdgcn_mfma_f32_16x16x32_bf16(hi8(Bt[n]), hi8(At[m]), acc[ai][bj][m][n], 0, 0, 0); } } __builtin_amdgcn_s_setprio(0); } while (0)
#define PG8_WAIT_V(n) asm volatile("s_waitcnt vmcnt(" #n ")" ::: "memory")
#define PG8_WAIT_L(n) asm volatile("s_waitcnt lgkmcnt(" #n ")" ::: "memory")
#define PG8_BAR __builtin_amdgcn_s_barrier()
#define PG8_SCHED __builtin_amdgcn_sched_barrier(0)
    Unit cur, nxt; int ui = 0;
    if (!S.next(0, cur)) return;
    f32x4 acc[2][2][4][2];
#pragma unroll
    for (int a = 0; a < 2; ++a)
#pragma unroll
        for (int b = 0; b < 2; ++b)
#pragma unroll
            for (int m = 0; m < 4; ++m)
#pragma unroll
                for (int n = 0; n < 2; ++n) acc[a][b][m][n] = (f32x4){0.f, 0.f, 0.f, 0.f};
    v8i At[4], B0[2], B1[2];
    const char* cA = (const char*)g.A + (size_t)cur.pm * tstep; const char* cB = (const char*)g.Bt + S.boff(cur) * 2 + (size_t)cur.pn * tstep;
    S.a_ready(cur);
    if constexpr (SP2) {
        PG8_STAGE(PG8_SB(0, 0), cB, voffB); PG8_STAGE(PG8_SB(0, 1), cB + hstep, voffB); PG8_STAGE(PG8_SA(0, 0), cA, voffA); PG8_STAGE(PG8_SA(0, 1), cA + hstep, voffA);
        if (wr == 1) PG8_BAR;
        PG8_WAIT_V(2); PG8_BAR;
        PG8_STAGE(PG8_SB(1, 0), cB + kstep, voffB); PG8_STAGE(PG8_SA(1, 0), cA + kstep, voffA); PG8_STAGE(PG8_SB(1, 1), cB + hstep + kstep, voffB);
        PG8_WAIT_V(6); PG8_BAR;
    } else {
        PG8_STAGE(PG8_SB(0, 0), cB, voffB); PG8_STAGE(PG8_SA(0, 0), cA, voffA); PG8_STAGE(PG8_SB(0, 1), cB + hstep, voffB); PG8_STAGE(PG8_SA(0, 1), cA + hstep, voffA);
        if (wr == 1) PG8_BAR;
        PG8_WAIT_V(4); PG8_BAR;
        PG8_STAGE(PG8_SB(1, 0), cB + kstep, voffB); PG8_STAGE(PG8_SA(1, 0), cA + kstep, voffA); PG8_STAGE(PG8_SB(1, 1), cB + hstep + kstep, voffB);
        PG8_WAIT_V(6); PG8_BAR;
    }
    for (;;) {
        const bool has_next = S.next(ui + 1, nxt);
        const char* nA = has_next ? (const char*)g.A + (size_t)nxt.pm * tstep : cA; const char* nB = has_next ? (const char*)g.Bt + S.boff(nxt) * 2 + (size_t)nxt.pn * tstep : cB;
#pragma unroll 1
        for (int t = 0; t < nt; t += 2) {
            const bool last = (t == nt - 2);
            const char* a1 = cA + (size_t)(t + 1) * kstep;
            const char* a2 = last ? nA : cA + (size_t)(t + 2) * kstep; const char* b2 = last ? nB : cB + (size_t)(t + 2) * kstep;
            const char* a3 = a2 + kstep; const char* b3 = b2 + kstep;
            if (last && has_next) S.a_ready(nxt);
            if constexpr (SP2) {
            PG8_LDB(B0, 0, 0); PG8_LDB(B1, 0, 1); PG8_SCHED; PG8_LDA(At, 0, 0); PG8_STAGE(PG8_SA(1, 1), a1 + hstep, voffA);
            PG8_WAIT_V(8); PG8_WAIT_L(0); PG8_BAR; PG8_MMA(0, 0, At, B0); PG8_MMA(0, 1, At, B1); PG8_BAR; PG8_SCHED;
            PG8_LDA(At, 0, 1); PG8_STAGE(PG8_SB(0, 0), b2, voffB); PG8_STAGE(PG8_SB(0, 1), b2 + hstep, voffB); PG8_STAGE(PG8_SA(0, 0), a2, voffA);
            PG8_WAIT_V(8); PG8_WAIT_L(0); PG8_BAR; PG8_MMA(1, 0, At, B0); PG8_MMA(1, 1, At, B1); PG8_BAR; PG8_SCHED;
            PG8_LDB(B0, 1, 0); PG8_LDB(B1, 1, 1); PG8_SCHED; PG8_LDA(At, 1, 0); PG8_STAGE(PG8_SA(0, 1), a2 + hstep, voffA);
            PG8_WAIT_V(8); PG8_WAIT_L(0); PG8_BAR; PG8_MMA(0, 0, At, B0); PG8_MMA(0, 1, At, B1); PG8_BAR; PG8_SCHED;
            PG8_LDA(At, 1, 1); PG8_STAGE(PG8_SB(1, 0), b3, voffB); PG8_STAGE(PG8_SB(1, 1), b3 + hstep, voffB); PG8_STAGE(PG8_SA(1, 0), a3, voffA);
            PG8_WAIT_V(8); PG8_WAIT_L(0); PG8_BAR; PG8_MMA(1, 0, At, B0); PG8_MMA(1, 1, At, B1); PG8_BAR; PG8_SCHED;
            } else {
            PG8_LDB(B0, 0, 0); PG8_SCHED; PG8_LDA(At, 0, 0); PG8_STAGE(PG8_SA(1, 1), a1 + hstep, voffA);
            PG8_WAIT_L(8); PG8_BAR; PG8_WAIT_L(0); PG8_MMA(0, 0, At, B0); PG8_BAR; PG8_SCHED;
            PG8_LDB(B1, 0, 1); PG8_STAGE(PG8_SB(0, 0), b2, voffB);
            PG8_BAR; PG8_WAIT_L(0); PG8_MMA(0, 1, At, B1); PG8_BAR;
            PG8_LDA(At, 0, 1); PG8_STAGE(PG8_SA(0, 0), a2, voffA);
            PG8_BAR; PG8_WAIT_L(0); PG8_MMA(1, 0, At, B0); PG8_BAR; PG8_SCHED;
            PG8_STAGE(PG8_SB(0, 1), b2 + hstep, voffB);
            PG8_WAIT_V(6); PG8_BAR; PG8_MMA(1, 1, At, B1); PG8_BAR;
            PG8_LDB(B0, 1, 0); PG8_SCHED; PG8_LDA(At, 1, 0); PG8_STAGE(PG8_SA(0, 1), a2 + hstep, voffA);
            PG8_WAIT_L(8); PG8_BAR; PG8_WAIT_L(0); PG8_MMA(0, 0, At, B0); PG8_BAR; PG8_SCHED;
            PG8_LDB(B1, 1, 1); PG8_STAGE(PG8_SB(1, 0), b3, voffB);
            PG8_BAR; PG8_WAIT_L(0); PG8_MMA(0, 1, At, B1); PG8_BAR;
            PG8_LDA(At, 1, 1); PG8_STAGE(PG8_SA(1, 0), a3, voffA);
            PG8_BAR; PG8_WAIT_L(0); PG8_MMA(1, 0, At, B0); PG8_BAR; PG8_SCHED;
            PG8_STAGE(PG8_SB(1, 1), b3 + hstep, voffB);
            PG8_WAIT_V(6); PG8_BAR; PG8_MMA(1, 1, At, B1); PG8_BAR;
            }
        }
        if constexpr (F8) asm volatile("s_nop 15\n\ts_nop 15" ::: "memory");
        if constexpr (ALIGN_EPI) { if (wr == 0) PG8_BAR; }
        if constexpr (!Epi::AFTER_DRAIN) { E(acc, cur, wr, wc, fr, fq); S.done(cur); }
        if (!has_next) break;
#pragma unroll
        for (int a = 0; a < 2; ++a)
#pragma unroll
            for (int b = 0; b < 2; ++b)
#pragma unroll
                for (int m = 0; m < 4; ++m)
#pragma unroll
                    for (int n = 0; n < 2; ++n) acc[a][b][m][n] = (f32x4){0.f, 0.f, 0.f, 0.f};
        cur = nxt; cA = nA; cB = nB; ++ui;
        if constexpr (ALIGN_EPI) { if (wr == 1) PG8_BAR; }
    }
    PG8_WAIT_V(0);
    if constexpr (!ALIGN_EPI) { if (wr == 0) PG8_BAR; }
    PG8_BAR;
    if constexpr (Epi::AFTER_DRAIN) { E.fused(acc, cur, wr, wc, fr, fq, lds, wid, lane); S.done(cur); }
#undef PG8_SA
#undef PG8_SB
#undef PG8_STAGE
#undef PG8_LDA
#undef PG8_LDB
#undef PG8_MMA
#undef PG8_WAIT_V
#undef PG8_WAIT_L
#undef PG8_BAR
#undef PG8_SCHED
}
}


struct Args { const float* in[21]; float* out; unsigned char* ws; int lo, hi; };
enum { I_X = 0, I_MEM, I_WMEMKV, I_AWIN, I_ACONV, I_AWOUT, I_BWIN, I_BWOUT, I_CWIN, I_CPOOLW, I_CPOOLS, I_CWOUT, I_LNG, I_LNB,
       I_FG, I_FU, I_FD, I_ROUTER, I_MG, I_MU, I_MD };
struct Frame { LAS unsigned char* lds; int tid, lane, wave, gw; };

template <int NWM, class Epi>
__device__ __forceinline__ void naive_gemm(const Frame& F, const bf16* A, int lda, const float* W0, const float* W1, int ldw, int M, int N, int K, const Epi& epi, const int* tile_e, size_t wstride) {
    const int lane = F.lane, r16 = lane & 15, q4 = lane >> 4;
    const int tn = N / 32, ntiles = (M / 32) * tn;
    for (int tile = F.gw; tile < ntiles; tile += NGW) {
        const int m0 = (tile / tn) * 32, n0 = (tile % tn) * 32;
        size_t woff = 0;
        if (tile_e) woff = (size_t)ld_i32_agent(tile_e + (m0 >> 8)) * wstride;
        const float* w0 = W0 + woff; const float* w1 = (NWM == 2) ? W1 + woff : nullptr;
        f32x4 acc[NWM][2][2];
#pragma unroll
        for (int w = 0; w < NWM; ++w)
#pragma unroll
            for (int i = 0; i < 2; ++i)
#pragma unroll
                for (int j = 0; j < 2; ++j) acc[w][i][j] = (f32x4){0.f, 0.f, 0.f, 0.f};
        for (int k0 = 0; k0 < K; k0 += 32) {
            bf16x8 a[2], b[NWM][2];
#pragma unroll
            for (int i = 0; i < 2; ++i) a[i] = *(const bf16x8*)(A + (size_t)(m0 + 16 * i + r16) * lda + k0 + 8 * q4);
#pragma unroll
            for (int w = 0; w < NWM; ++w)
#pragma unroll
                for (int jn = 0; jn < 2; ++jn) {
                    const float* wp = (w == 0 ? w0 : w1) + (size_t)(k0 + 8 * q4) * ldw + n0 + 16 * jn + r16;
#pragma unroll
                    for (int j = 0; j < 8; ++j) b[w][jn][j] = (short)f2bf(wp[(size_t)j * ldw]);
                }
#pragma unroll
            for (int w = 0; w < NWM; ++w)
#pragma unroll
                for (int i = 0; i < 2; ++i)
#pragma unroll
                    for (int jn = 0; jn < 2; ++jn) acc[w][i][jn] = __builtin_amdgcn_mfma_f32_16x16x32_bf16(a[i], b[w][jn], acc[w][i][jn], 0, 0, 0);
        }
#pragma unroll
        for (int i = 0; i < 2; ++i)
#pragma unroll
            for (int jn = 0; jn < 2; ++jn)
#pragma unroll
                for (int r = 0; r < 4; ++r) {
                    const int row = m0 + 16 * i + q4 * 4 + r, col = n0 + 16 * jn + r16;
                    if constexpr (NWM == 2) epi(row, col, acc[0][i][jn][r], acc[1][i][jn][r]); else epi(row, col, acc[0][i][jn][r], 0.f);
                }
    }
}
struct NEpiBf16 { bf16* O; int ldo; __device__ __forceinline__ void operator()(int r, int c, float v, float) const { O[(size_t)r * ldo + c] = (bf16)f2bf(v); } };
struct NEpiResid { const float* basef; const bf16* baseb; bf16* out; __device__ __forceinline__ void operator()(int r, int c, float v, float) const { const size_t o = (size_t)r * D + c; out[o] = (bf16)f2bf(ALPHA * (basef ? basef[o] : bf2f(baseb[o])) + v); } };
struct NEpiSwiglu { bf16* O; int ldo; __device__ __forceinline__ void operator()(int r, int c, float g, float u) const { const float s = g / (1.f + __expf(-g)); O[(size_t)r * ldo + c] = (bf16)f2bf(s * u); } };
struct NEpiScale { bf16* O; int ldo; int coff; const float* scale; __device__ __forceinline__ void operator()(int r, int c, float v, float) const { O[(size_t)r * ldo + coff + c] = (bf16)f2bf(v * scale[coff + c]); } };

__device__ __forceinline__ void prep_phase(const Frame& F, const float* x, const float* mem, bf16* XB, bf16* MEMB) {
    const size_t gt = (size_t)blockIdx.x * NTHREADS + F.tid, NT = (size_t)GRID * NTHREADS;
    for (size_t i = gt; i < (size_t)T * D / 8; i += NT) { const f32x4 a = ((const f32x4*)x)[2 * i], b = ((const f32x4*)x)[2 * i + 1];
        v4u o; o.x = pk2(a.x, a.y); o.y = pk2(a.z, a.w); o.z = pk2(b.x, b.y); o.w = pk2(b.z, b.w); ((v4u*)XB)[i] = o; }
    for (size_t i = gt; i < (size_t)NB * ML * D / 8; i += NT) { const f32x4 a = ((const f32x4*)mem)[2 * i], b = ((const f32x4*)mem)[2 * i + 1];
        v4u o; o.x = pk2(a.x, a.y); o.y = pk2(a.z, a.w); o.z = pk2(b.x, b.y); o.w = pk2(b.z, b.w); ((v4u*)MEMB)[i] = o; }
}
__device__ __forceinline__ void unpack8(const v4u w, float (&f)[8]) { f[0] = bflo(w.x); f[1] = bfhi(w.x); f[2] = bflo(w.y); f[3] = bfhi(w.y); f[4] = bflo(w.z); f[5] = bfhi(w.z); f[6] = bflo(w.w); f[7] = bfhi(w.w); }
__device__ __forceinline__ v4u pack8(const float (&f)[8]) { v4u o; o.x = pk2(f[0], f[1]); o.y = pk2(f[2], f[3]); o.z = pk2(f[4], f[5]); o.w = pk2(f[6], f[7]); return o; }

__device__ __forceinline__ void mixA_phase(const Frame& F, const bf16* H, const float* convw, bf16* CAT) {
    const size_t gt = (size_t)blockIdx.x * NTHREADS + F.tid, NT = (size_t)GRID * NTHREADS;
    for (size_t it = gt; it < (size_t)T * 96; it += NT) {
        const int t = (int)(it / 96), c8 = (int)(it % 96) * 8, s = t & (SEQ - 1);
        const bf16* hr = H + (size_t)t * 2560 + c8;
        float gb[8], z0[8], z1[8], z2[8], a[8], b[8];
        unpack8(*(const v4u*)hr, gb);
        unpack8(*(const v4u*)(hr + 768), a); unpack8(*(const v4u*)(hr + 1536), b);
#pragma unroll
        for (int i = 0; i < 8; ++i) z1[i] = a[i] * b[i];
        if (s > 0) { unpack8(*(const v4u*)(hr - 2560 + 768), a); unpack8(*(const v4u*)(hr - 2560 + 1536), b);
#pragma unroll
            for (int i = 0; i < 8; ++i) z0[i] = a[i] * b[i]; }
        else {
#pragma unroll
            for (int i = 0; i < 8; ++i) z0[i] = 0.f; }
        if (s < SEQ - 1) { unpack8(*(const v4u*)(hr + 2560 + 768), a); unpack8(*(const v4u*)(hr + 2560 + 1536), b);
#pragma unroll
            for (int i = 0; i < 8; ++i) z2[i] = a[i] * b[i]; }
        else {
#pragma unroll
            for (int i = 0; i < 8; ++i) z2[i] = 0.f; }
        float o[8];
#pragma unroll
        for (int i = 0; i < 8; ++i) o[i] = gb[i] * (convw[c8 + i] * z0[i] + convw[768 + c8 + i] * z1[i] + convw[1536 + c8 + i] * z2[i]);
        *(v4u*)(CAT + (size_t)t * 1024 + c8) = pack8(o);
    }
}
__device__ __forceinline__ void poolC_phase(const Frame& F, const bf16* H, bf16* OUT, int ldo) {
    const size_t gt = (size_t)blockIdx.x * NTHREADS + F.tid, NT = (size_t)GRID * NTHREADS;
    for (size_t it = gt; it < (size_t)T * 96; it += NT) {
        const int t = (int)(it / 96), ch = (int)(it % 96), c8 = ch * 8, s = t & (SEQ - 1), g = ch / 24, w = 2 << g;
        int lo = s - w / 2; lo = lo < 0 ? 0 : lo; int hi = s + w / 2 - 1; hi = hi > SEQ - 1 ? SEQ - 1 : hi;
        const bf16* base = H + (size_t)(t - s) * 1024 + c8;
        float acc[8], u[8], v[8];
#pragma unroll
        for (int i = 0; i < 8; ++i) acc[i] = 0.f;
        for (int p = lo; p <= hi; ++p) { unpack8(*(const v4u*)(base + (size_t)p * 1024), v);
#pragma unroll
            for (int i = 0; i < 8; ++i) acc[i] += v[i]; }
        unpack8(*(const v4u*)(base + (size_t)s * 1024), u);
        const float inv = 1.f / (float)(hi - lo + 1);
        float o[8];
#pragma unroll
        for (int i = 0; i < 8; ++i) o[i] = acc[i] * inv - u[i];
        *(v4u*)(OUT + (size_t)t * ldo + c8) = pack8(o);
    }
}


__device__ __forceinline__ void tr_item(const float* W, int N, int k0, int n0, bf16* WT, int ldk, int drow0, LAS float* scr, int lane, float qs = 0.f) {
    float v[32];
    const float* wp = W + (size_t)(k0 + (lane >> 5)) * N + n0 + (lane & 31);
#pragma unroll
    for (int i = 0; i < 32; ++i) v[i] = wp[(size_t)(2 * i) * N];
#pragma unroll
    for (int i = 0; i < 32; ++i) scr[(2 * i + (lane >> 5)) * 33 + (lane & 31)] = (qs != 0.f) ? q8(v[i] * qs) / qs : v[i];
    LDS_WAIT(); asm volatile("" ::: "memory");
    const int c = lane & 7;
#pragma unroll
    for (int j = 0; j < 4; ++j) { const int n = (lane >> 3) + 8 * j; const LAS float* sp = scr + (8 * c) * 33 + n;
        v4u o; o.x = pk2(sp[0 * 33], sp[1 * 33]); o.y = pk2(sp[2 * 33], sp[3 * 33]); o.z = pk2(sp[4 * 33], sp[5 * 33]); o.w = pk2(sp[6 * 33], sp[7 * 33]);
        *(v4u*)(WT + (size_t)(drow0 + n) * ldk + k0 + 8 * c) = o; }
    LDS_WAIT(); asm volatile("" ::: "memory");
}
template <int MODE>
__device__ __forceinline__ void tr_matrix(const Frame& F, const float* W, int K, int N, bf16* WT, int ldk, int& rot, float qs = 0.f) {
    LAS float* scr = (LAS float*)(F.lds + F.wave * 16384);
    const int nblk = N / 32, nitems = (K / 64) * nblk;
    for (int it = (F.gw + NGW - (rot % NGW)) % NGW; it < nitems; it += NGW) {
        const int k0 = (it / nblk) * 64, n0 = (it % nblk) * 32;
        const int drow0 = MODE == 0 ? n0 : ((n0 >> 7) * 256 + (n0 & 127) + (MODE == 2 ? 128 : 0));
        tr_item(W, N, k0, n0, WT, ldk, drow0, scr, F.lane, qs);
    }
    rot += nitems;
}
__device__ __forceinline__ void convert_moe(const Frame& F, const float* wg, const float* wu, const float* wd, bf16* WMOE, int& rot) {
#pragma unroll 1
    for (int e = 0; e < NE; ++e) {
        tr_matrix<1>(F, wg + (size_t)e * D * FFE, D, FFE, WMOE + OFF_MGU + (size_t)e * 2 * FFE * D, D, rot, EMU_FP8 ? 32.f : 0.f);
        tr_matrix<2>(F, wu + (size_t)e * D * FFE, D, FFE, WMOE + OFF_MGU + (size_t)e * 2 * FFE * D, D, rot, EMU_FP8 ? 32.f : 0.f);
        tr_matrix<0>(F, wd + (size_t)e * FFE * D, FFE, D, WMOE + OFF_MD + (size_t)e * D * FFE, FFE, rot, EMU_FP8 ? 128.f : 0.f);
    }
}

__device__ __forceinline__ void tr_item8(const float* W, int N, int k0, int n0, unsigned char* WT, int ldk, int drow0, LAS float* scr, int lane, float qs) {
    float v[32];
    const float* wp = W + (size_t)(k0 + (lane >> 5)) * N + n0 + (lane & 31);
#pragma unroll
    for (int i = 0; i < 32; ++i) v[i] = wp[(size_t)(2 * i) * N];
#pragma unroll
    for (int i = 0; i < 32; ++i) scr[(2 * i + (lane >> 5)) * 33 + (lane & 31)] = v[i] * qs;
    LDS_WAIT(); asm volatile("" ::: "memory");
    const int c = lane & 7;
#pragma unroll
    for (int j = 0; j < 4; ++j) { const int n = (lane >> 3) + 8 * j; const LAS float* sp = scr + (8 * c) * 33 + n;
        int p0 = 0, p1 = 0;
        p0 = __builtin_amdgcn_cvt_pk_fp8_f32(sp[0 * 33], sp[1 * 33], p0, false); p0 = __builtin_amdgcn_cvt_pk_fp8_f32(sp[2 * 33], sp[3 * 33], p0, true);
        p1 = __builtin_amdgcn_cvt_pk_fp8_f32(sp[4 * 33], sp[5 * 33], p1, false); p1 = __builtin_amdgcn_cvt_pk_fp8_f32(sp[6 * 33], sp[7 * 33], p1, true);
        v2u o; o.x = (unsigned)p0; o.y = (unsigned)p1;
        *(v2u*)(WT + (size_t)(drow0 + n) * ldk + k0 + 8 * c) = o; }
    LDS_WAIT(); asm volatile("" ::: "memory");
}
template <int MODE>
__device__ __forceinline__ void tr_matrix8(const Frame& F, const float* W, int K, int N, unsigned char* WT, int ldk, int& rot, float qs) {
    LAS float* scr = (LAS float*)(F.lds + F.wave * 16384);
    const int nblk = N / 32, nitems = (K / 64) * nblk;
    for (int it = (F.gw + NGW - (rot % NGW)) % NGW; it < nitems; it += NGW) {
        const int k0 = (it / nblk) * 64, n0 = (it % nblk) * 32;
        const int drow0 = MODE == 0 ? n0 : ((n0 >> 7) * 256 + (n0 & 127) + (MODE == 2 ? 128 : 0));
        tr_item8(W, N, k0, n0, WT, ldk, drow0, scr, F.lane, qs);
    }
    rot += nitems;
}
constexpr float QS_GU = 32.f, QS_D = 128.f;
constexpr int WSC_GU = 0x7A7A7A7A, WSC_D = 0x78787878;
constexpr size_t OFF8_MGU = 0, OFF8_MD = (size_t)NE * 2 * FFE * D;
__device__ __forceinline__ void convert_moe8(const Frame& F, const float* wg, const float* wu, const float* wd, unsigned char* WMOE8, bf16* WMOE, int& rot) {
#pragma unroll 1
    for (int e = 0; e < NE; ++e) {
#if FP8_GU
        tr_matrix8<1>(F, wg + (size_t)e * D * FFE, D, FFE, WMOE8 + OFF8_MGU + (size_t)e * 2 * FFE * D, D, rot, QS_GU);
        tr_matrix8<2>(F, wu + (size_t)e * D * FFE, D, FFE, WMOE8 + OFF8_MGU + (size_t)e * 2 * FFE * D, D, rot, QS_GU);
#else
        tr_matrix<1>(F, wg + (size_t)e * D * FFE, D, FFE, WMOE + OFF_MGU + (size_t)e * 2 * FFE * D, D, rot);
        tr_matrix<2>(F, wu + (size_t)e * D * FFE, D, FFE, WMOE + OFF_MGU + (size_t)e * 2 * FFE * D, D, rot);
#endif
#if FP8_D
        tr_matrix8<0>(F, wd + (size_t)e * FFE * D, FFE, D, WMOE8 + (FP8_GU ? OFF8_MD : 2 * OFF_MD) + (size_t)e * D * FFE, FFE, rot, QS_D);
#else
        tr_matrix<0>(F, wd + (size_t)e * FFE * D, FFE, D, WMOE + OFF_MD + (size_t)e * D * FFE, FFE, rot);
#endif
    }
}
__device__ __forceinline__ void fold_pool(const Frame& F, const float* pw, const float* ps, const float* wout, bf16* WT) {
    const int item = blockIdx.x * NTHREADS + F.tid;
    if (item < 1024 * 96) {
        const int n = item & 1023, kc = item >> 10, g = kc / 24, c0 = kc * 8 - g * 192;
        float acc[8];
#pragma unroll
        for (int i = 0; i < 8; ++i) acc[i] = 0.f;
        const float* P = pw + (size_t)g * 192 * 192 + (size_t)c0 * 192;
        for (int d = 0; d < 192; ++d) { const float w = wout[(size_t)(g * 192 + d) * D + n] * ps[g * 192 + d];
#pragma unroll
            for (int i = 0; i < 8; ++i) acc[i] += P[i * 192 + d] * w; }
        *(v4u*)(WT + (size_t)n * D + kc * 8) = pack8(acc);
    }
}
__device__ __forceinline__ void convert_small(const Frame& F, const Args& a, bf16* WSM, int& rot) {
    tr_matrix<0>(F, a.in[I_WMEMKV], D, 512, WSM + OFF_WKV, D, rot);
    tr_matrix<0>(F, a.in[I_AWIN], D, 2560, WSM + OFF_AIN, D, rot);
    tr_matrix<0>(F, a.in[I_AWIN] + (size_t)D * 2560, D, 2560, WSM + OFF_AIN + (size_t)2560 * D, D, rot);
    tr_matrix<0>(F, a.in[I_AWOUT], D, D, WSM + OFF_AOUT, D, rot);
    tr_matrix<0>(F, a.in[I_AWOUT] + (size_t)D * D, D, D, WSM + OFF_AOUT + (size_t)D * D, D, rot);
    tr_matrix<0>(F, a.in[I_BWIN], D, 2560, WSM + OFF_BIN, D, rot);
    tr_matrix<0>(F, a.in[I_BWOUT], 512, D, WSM + OFF_BOUT, 512, rot);
    tr_matrix<0>(F, a.in[I_CWIN], D, D, WSM + OFF_CIN, D, rot);
    tr_matrix<0>(F, a.in[I_CWOUT] + (size_t)768 * D, 256, D, WSM + OFF_COUT + 768, D, rot);
#pragma unroll 1
    for (int f = 0; f < 2; ++f) {
        tr_matrix<1>(F, a.in[I_FG] + (size_t)f * D * FF, D, FF, WSM + OFF_FGU + (size_t)f * 2 * FF * D, D, rot, EMU_FP8 == 2 ? 32.f : 0.f);
        tr_matrix<2>(F, a.in[I_FU] + (size_t)f * D * FF, D, FF, WSM + OFF_FGU + (size_t)f * 2 * FF * D, D, rot, EMU_FP8 == 2 ? 32.f : 0.f);
        tr_matrix<0>(F, a.in[I_FD] + (size_t)f * FF * D, FF, D, WSM + OFF_FD + (size_t)f * D * FF, FF, rot, EMU_FP8 == 2 ? 64.f : 0.f);
    }
}

template <bool ROUTER, bool COMBINE, bool FINAL>
__device__ __forceinline__ void ln_phase(const Frame& F, const bf16* XBi, bf16* XBo, float* OUTF, const float* g, const float* b, const float* router, int* E01, float* W01, const int* DEST, const bf16* YB, int* cntWG) {
    LAS int* cntL = (LAS int*)F.lds;
    if (ROUTER) { if (F.tid < 8) cntL[F.tid] = 0; __syncthreads(); }
    float gv[16], bv[16];
#pragma unroll
    for (int h = 0; h < 2; ++h)
#pragma unroll
        for (int q = 0; q < 2; ++q) { const f32x4 a = *(const f32x4*)(g + 512 * h + 8 * F.lane + 4 * q), c = *(const f32x4*)(b + 512 * h + 8 * F.lane + 4 * q);
#pragma unroll
            for (int i = 0; i < 4; ++i) { gv[8 * h + 4 * q + i] = a[i]; bv[8 * h + 4 * q + i] = c[i]; } }
    for (int i = 0; i < 16; ++i) {
        const int t = blockIdx.x * 128 + F.wave * 16 + i;
        const v4u* xi = (const v4u*)(XBi + (size_t)t * D) + F.lane;
        float v[16];
        { float f[8]; unpack8(xi[0], f);
#pragma unroll
          for (int q = 0; q < 8; ++q) v[q] = f[q];
          unpack8(xi[64], f);
#pragma unroll
          for (int q = 0; q < 8; ++q) v[8 + q] = f[q]; }
        if (COMBINE) {
            const int d0 = ld_i32_agent(DEST + 2 * t), d1 = ld_i32_agent(DEST + 2 * t + 1);
            const float w0 = ld_f32_agent(W01 + 2 * t), w1 = ld_f32_agent(W01 + 2 * t + 1);
            const v4u* y0 = (const v4u*)(YB + (size_t)d0 * D) + F.lane; const v4u* y1 = (const v4u*)(YB + (size_t)d1 * D) + F.lane;
#pragma unroll
            for (int h = 0; h < 2; ++h) { float f0[8], f1[8]; unpack8(y0[64 * h], f0); unpack8(y1[64 * h], f1);
#pragma unroll
                for (int q = 0; q < 8; ++q) v[8 * h + q] = ALPHA * v[8 * h + q] + w0 * f0[q] + w1 * f1[q]; }
        }
        float s = 0.f;
#pragma unroll
        for (int q = 0; q < 16; ++q) s += v[q];
        const float mean = wave_sum(s) * (1.f / D); float s2 = 0.f;
#pragma unroll
        for (int q = 0; q < 16; ++q) { v[q] -= mean; s2 += v[q] * v[q]; }
        const float rstd = 1.f / sqrtf(wave_sum(s2) * (1.f / D) + LN_EPS);
#pragma unroll
        for (int q = 0; q < 16; ++q) v[q] = v[q] * rstd * gv[q] + bv[q];
        if (FINAL) {
            float* o = OUTF + (size_t)t * D + 8 * F.lane;
#pragma unroll
            for (int h = 0; h < 2; ++h)
#pragma unroll
                for (int q = 0; q < 2; ++q) *(f32x4*)(o + 512 * h + 4 * q) = (f32x4){v[8 * h + 4 * q], v[8 * h + 4 * q + 1], v[8 * h + 4 * q + 2], v[8 * h + 4 * q + 3]};
        } else {
            v4u* xo = (v4u*)(XBo + (size_t)t * D) + F.lane;
            { float f[8];
#pragma unroll
              for (int q = 0; q < 8; ++q) f[q] = v[q];
              xo[0] = pack8(f);
#pragma unroll
              for (int q = 0; q < 8; ++q) f[q] = v[8 + q];
              xo[64] = pack8(f); }
        }
        if (ROUTER) {
            float lg[8];
#pragma unroll
            for (int e = 0; e < 8; ++e) lg[e] = 0.f;
#pragma unroll
            for (int q = 0; q < 16; ++q) { const int c = 512 * (q >> 3) + 8 * F.lane + (q & 7); const f32x4 r0 = ((const f32x4*)router)[2 * c], r1 = ((const f32x4*)router)[2 * c + 1]; const float xv = v[q];
                lg[0] += xv * r0.x; lg[1] += xv * r0.y; lg[2] += xv * r0.z; lg[3] += xv * r0.w; lg[4] += xv * r1.x; lg[5] += xv * r1.y; lg[6] += xv * r1.z; lg[7] += xv * r1.w; }
#pragma unroll
            for (int e = 0; e < 8; ++e) lg[e] = wave_sum(lg[e]);
            float b0 = lg[0]; int i0 = 0;
#pragma unroll
            for (int e = 1; e < 8; ++e) if (lg[e] > b0) { b0 = lg[e]; i0 = e; }
            float b1 = -3.0e38f; int i1 = 0;
#pragma unroll
            for (int e = 0; e < 8; ++e) if (e != i0 && lg[e] > b1) { b1 = lg[e]; i1 = e; }
            const float w0 = 1.f / (1.f + __expf(b1 - b0));
            if (F.lane == 0) { E01[2 * t] = i0; E01[2 * t + 1] = i1; W01[2 * t] = w0; W01[2 * t + 1] = 1.f - w0; __hip_atomic_fetch_add(&cntL[i0], 1, __ATOMIC_RELAXED, __HIP_MEMORY_SCOPE_WORKGROUP); __hip_atomic_fetch_add(&cntL[i1], 1, __ATOMIC_RELAXED, __HIP_MEMORY_SCOPE_WORKGROUP); }
        }
    }
    if (ROUTER) { __syncthreads(); if (F.tid < 8) cntWG[blockIdx.x * 8 + F.tid] = cntL[F.tid]; }
}
__device__ __forceinline__ void scatter_phase(const Frame& F, const int* cntWG, const int* E01, int* DEST, const bf16* XB, bf16* XS, int* tile_e, int* nMp) {
    LAS int* L = (LAS int*)F.lds;
    if (F.tid < 8) { int tot = 0, base = 0; for (int w = 0; w < GRID; ++w) { const int c = ld_i32_agent(cntWG + w * 8 + F.tid); if (w < (int)blockIdx.x) base += c; tot += c; } L[F.tid] = base; L[8 + F.tid] = tot; }
    __syncthreads();
    if (F.tid == 0) { int ps = 0; for (int e = 0; e < 8; ++e) { L[16 + e] = ps; ps += (L[8 + e] + 255) / 256 * 256; } L[24] = ps; }
    __syncthreads();
    if (F.wave == 0) {
        const int tA = blockIdx.x * 128 + F.lane, tB = tA + 64;
        const int eA0 = ld_i32_agent(E01 + 2 * tA), eA1 = ld_i32_agent(E01 + 2 * tA + 1), eB0 = ld_i32_agent(E01 + 2 * tB), eB1 = ld_i32_agent(E01 + 2 * tB + 1);
        const unsigned long long lt = (1ull << F.lane) - 1ull;
        int dA0 = 0, dA1 = 0, dB0 = 0, dB1 = 0;
        for (int e = 0; e < 8; ++e) {
            const unsigned long long mA0 = __ballot(eA0 == e), mA1 = __ballot(eA1 == e), mB0 = __ballot(eB0 == e), mB1 = __ballot(eB1 == e);
            const int start = L[16 + e] + L[e];
            const int cA = __popcll(mA0 & lt) + __popcll(mA1 & lt), totA = __popcll(mA0) + __popcll(mA1), cB = totA + __popcll(mB0 & lt) + __popcll(mB1 & lt);
            if (eA0 == e) dA0 = start + cA; if (eA1 == e) dA1 = start + cA;
            if (eB0 == e) dB0 = start + cB; if (eB1 == e) dB1 = start + cB;
        }
        DEST[2 * tA] = dA0; DEST[2 * tA + 1] = dA1; DEST[2 * tB] = dB0; DEST[2 * tB + 1] = dB1;
        L[32 + 2 * F.lane] = dA0; L[32 + 2 * F.lane + 1] = dA1; L[32 + 2 * (F.lane + 64)] = dB0; L[32 + 2 * (F.lane + 64) + 1] = dB1;
    }
    __syncthreads();
    for (int i = 0; i < 16; ++i) {
        const int tl = F.wave * 16 + i, t = blockIdx.x * 128 + tl;
        const v4u* src = (const v4u*)(XB + (size_t)t * D) + F.lane; v4u a = src[0], b = src[64];
#if EMU_FP8
        { float f[8]; unpack8(a, f);
#pragma unroll
          for (int q = 0; q < 8; ++q) f[q] = q8(f[q]);
          a = pack8(f); unpack8(b, f);
#pragma unroll
          for (int q = 0; q < 8; ++q) f[q] = q8(f[q]);
          b = pack8(f); }
#endif
#if FP8_GU
        v2u a8, b8;
        { float f[8]; int p0 = 0, p1 = 0; unpack8(a, f);
          p0 = __builtin_amdgcn_cvt_pk_fp8_f32(f[0], f[1], p0, false); p0 = __builtin_amdgcn_cvt_pk_fp8_f32(f[2], f[3], p0, true); p1 = __builtin_amdgcn_cvt_pk_fp8_f32(f[4], f[5], p1, false); p1 = __builtin_amdgcn_cvt_pk_fp8_f32(f[6], f[7], p1, true);
          a8.x = (unsigned)p0; a8.y = (unsigned)p1; p0 = 0; p1 = 0; unpack8(b, f);
          p0 = __builtin_amdgcn_cvt_pk_fp8_f32(f[0], f[1], p0, false); p0 = __builtin_amdgcn_cvt_pk_fp8_f32(f[2], f[3], p0, true); p1 = __builtin_amdgcn_cvt_pk_fp8_f32(f[4], f[5], p1, false); p1 = __builtin_amdgcn_cvt_pk_fp8_f32(f[6], f[7], p1, true);
          b8.x = (unsigned)p0; b8.y = (unsigned)p1; }
#pragma unroll
        for (int k = 0; k < 2; ++k) { v2u* dst = (v2u*)((unsigned char*)XS + (size_t)L[32 + 2 * tl + k] * D) + F.lane; dst[0] = a8; dst[64] = b8; }
#else
#pragma unroll
        for (int k = 0; k < 2; ++k) { v4u* dst = (v4u*)(XS + (size_t)L[32 + 2 * tl + k] * D) + F.lane; dst[0] = a; dst[64] = b; }
#endif
    }
    if (blockIdx.x == 0) {
        const int nM = L[24] / 256;
        for (int i = F.tid; i < nM; i += NTHREADS) { int e = 0;
#pragma unroll
            for (int q = 1; q < 8; ++q) if (i * 256 >= L[16 + q]) e = q;
            tile_e[i] = e; }
        if (F.tid == 0) *nMp = nM;
    }
    __syncthreads();
}

__device__ __forceinline__ void memattn_naive(const Frame& F, const bf16* H, int ldh, int qoff, const bf16* MEMKV, bf16* CAT, int ldc, int coff) {
    const size_t gt = (size_t)blockIdx.x * NTHREADS + F.tid, NT = (size_t)GRID * NTHREADS;
    for (size_t it = gt; it < (size_t)T * 4; it += NT) {
        const int t = (int)(it >> 2), h = (int)(it & 3), bb = t / SEQ;
        float q[64], o[64];
#pragma unroll
        for (int c = 0; c < 8; ++c) { float f[8]; unpack8(*(const v4u*)(H + (size_t)t * ldh + qoff + 64 * h + 8 * c), f);
#pragma unroll
            for (int i = 0; i < 8; ++i) { q[8 * c + i] = f[i] * 0.125f; o[8 * c + i] = 0.f; } }
        float m = -3.0e38f, l = 0.f;
        for (int k = 0; k < ML; ++k) {
            const bf16* kr = MEMKV + (size_t)(bb * ML + k) * 512 + 64 * h;
            float sc = 0.f;
#pragma unroll
            for (int c = 0; c < 8; ++c) { float f[8]; unpack8(*(const v4u*)(kr + 8 * c), f);
#pragma unroll
                for (int i = 0; i < 8; ++i) sc += q[8 * c + i] * f[i]; }
            const float mn = fmaxf(m, sc), al = __expf(m - mn), p = __expf(sc - mn);
            l = l * al + p; m = mn;
#pragma unroll
            for (int c = 0; c < 8; ++c) { float f[8]; unpack8(*(const v4u*)(kr + 256 + 8 * c), f);
#pragma unroll
                for (int i = 0; i < 8; ++i) o[8 * c + i] = o[8 * c + i] * al + p * f[i]; }
        }
        const float inv = 1.f / l;
#pragma unroll
        for (int c = 0; c < 8; ++c) { float f[8];
#pragma unroll
            for (int i = 0; i < 8; ++i) f[i] = o[8 * c + i] * inv;
            *(v4u*)(CAT + (size_t)t * ldc + coff + 64 * h + 8 * c) = pack8(f); }
    }
}
__device__ __forceinline__ void dilattn_naive(const Frame& F, const bf16* H, bf16* CAT, int ldc) {
    const size_t gt = (size_t)blockIdx.x * NTHREADS + F.tid, NT = (size_t)GRID * NTHREADS;
    for (size_t it = gt; it < (size_t)T * 4; it += NT) {
        const int t = (int)(it >> 2), h = (int)(it & 3), s = t & (SEQ - 1);
        float q[64], o[64];
#pragma unroll
        for (int i = 0; i < 64; ++i) o[i] = 0.f;
        float m = -3.0e38f, l = 0.f;
        for (int g = 0; g < 3; ++g) {
            const int dl = 1 << (2 * g), nsub = SEQ / dl, j = s / dl, r = s % dl;
            const float slope = exp2f(-8.f * (float)(4 * g + h + 1) / 12.f) * (float)dl;
#pragma unroll
            for (int c = 0; c < 8; ++c) { float f[8]; unpack8(*(const v4u*)(H + (size_t)t * 2560 + 256 * g + 64 * h + 8 * c), f);
#pragma unroll
                for (int i = 0; i < 8; ++i) q[8 * c + i] = f[i] * 0.125f; }
            const int jlo = j - 64 < 0 ? 0 : j - 64, jhi = j + 64 > nsub - 1 ? nsub - 1 : j + 64;
            for (int jj = jlo; jj <= jhi; ++jj) {
                const bf16* kr = H + (size_t)(t - s + jj * dl + r) * 2560 + 768 + 256 * g + 64 * h;
                float sc = 0.f;
#pragma unroll
                for (int c = 0; c < 8; ++c) { float f[8]; unpack8(*(const v4u*)(kr + 8 * c), f);
#pragma unroll
                    for (int i = 0; i < 8; ++i) sc += q[8 * c + i] * f[i]; }
                const int ad = jj > j ? jj - j : j - jj;
                sc -= slope * (float)ad;
                const float mn = fmaxf(m, sc), al = __expf(m - mn), p = __expf(sc - mn);
                l = l * al + p; m = mn;
#pragma unroll
                for (int c = 0; c < 8; ++c) { float f[8]; unpack8(*(const v4u*)(kr + 768 + 8 * c), f);
#pragma unroll
                    for (int i = 0; i < 8; ++i) o[8 * c + i] = o[8 * c + i] * al + p * f[i]; }
            }
        }
        const float inv = 1.f / l;
#pragma unroll
        for (int c = 0; c < 8; ++c) { float f[8];
#pragma unroll
            for (int i = 0; i < 8; ++i) f[i] = o[8 * c + i] * inv;
            *(v4u*)(CAT + (size_t)t * ldc + 64 * h + 8 * c) = pack8(f); }
    }
}


typedef short v4i16_t __attribute__((ext_vector_type(4)));
__device__ __forceinline__ int crow(int r, int hi) { return (r & 3) + 8 * (r >> 2) + 4 * hi; }
__device__ __forceinline__ unsigned cvtpk(float lo, float hi) { unsigned r; asm volatile("s_nop 0\n\tv_cvt_pk_bf16_f32 %0, %1, %2" : "=v"(r) : "v"(lo), "v"(hi)); return r; }
__device__ __forceinline__ s16x4 vtr(const LAS unsigned char* p) { return __builtin_bit_cast(s16x4, __builtin_amdgcn_ds_read_tr16_b64_v4i16((LAS v4i16_t*)p)); }
constexpr int VROWB = 144;
constexpr float C2 = 0.125f * 1.4426950408889634f;
struct AttnP { const bf16* kbase; size_t kstride; int voff, j0, nsub; float slope2; };
struct AttnS { float m, l; f32x16 o0, o1; };
template <int NBLK>
__device__ __forceinline__ void attn_load_k(bf16x8 (&kf)[2][4], int kb0, const AttnP& P, int lane) {
    const int r32 = lane & 31, hh = lane >> 5;
#pragma unroll
    for (int b = 0; b < NBLK; ++b) {
        int jk = P.j0 - 64 + 32 * (kb0 + b) + r32; jk = jk < 0 ? 0 : (jk > P.nsub - 1 ? P.nsub - 1 : jk);
        const bf16* kr = P.kbase + (size_t)jk * P.kstride + 8 * hh;
#pragma unroll
        for (int ks = 0; ks < 4; ++ks) kf[b][ks] = *(const bf16x8*)(kr + 16 * ks);
    }
}
template <int NBLK, int NNEXT, bool DIL>
__device__ __forceinline__ void attn_chunk(AttnS& st, const bf16x8 (&qf)[4], bf16x8 (&kf)[2][4], int kb0, const AttnP& P, LAS unsigned char* vl, int lane) {
    const int r32 = lane & 31, hh = lane >> 5;
    v4u vv[NBLK][4];
#pragma unroll
    for (int b = 0; b < NBLK; ++b)
#pragma unroll
        for (int i = 0; i < 4; ++i) { const int row = (lane >> 3) + 8 * i; int jk = P.j0 - 64 + 32 * (kb0 + b) + row; jk = jk < 0 ? 0 : (jk > P.nsub - 1 ? P.nsub - 1 : jk);
            vv[b][i] = *(const v4u*)(P.kbase + (size_t)jk * P.kstride + P.voff + (lane & 7) * 8); }
    f32x16 sc[NBLK];
#pragma unroll
    for (int b = 0; b < NBLK; ++b) {
        f32x16 a = {};
#pragma unroll
        for (int ks = 0; ks < 4; ++ks) a = __builtin_amdgcn_mfma_f32_32x32x16_bf16(kf[b][ks], qf[ks], a, 0, 0, 0);
        sc[b] = a;
    }
    if (NNEXT > 0) attn_load_k<NNEXT>(kf, kb0 + NBLK, P, lane);
    float mc = -INFINITY;
    int dbase = 4 * hh - 64 - r32; asm volatile("" : "+v"(dbase));
    const int jbase = P.j0 + dbase + r32;
#pragma unroll
    for (int b = 0; b < NBLK; ++b)
#pragma unroll
        for (int r = 0; r < 16; ++r) {
            float v = sc[b][r] * C2;
            if (DIL) { const int kc = 32 * (kb0 + b) + (r & 3) + 8 * (r >> 2), df = dbase + kc, jk = jbase + kc, ad = df < 0 ? -df : df;
                v = (ad <= 64 && (unsigned)jk < (unsigned)P.nsub) ? v - P.slope2 * (float)ad : -INFINITY; }
            sc[b][r] = v; mc = fmaxf(mc, v);
        }
    mc = fmaxf(mc, __shfl_xor(mc, 32));
    const float mn = fmaxf(st.m, mc), alpha = __builtin_amdgcn_exp2f(st.m - mn); st.m = mn;
    float ps = 0.f;
#pragma unroll
    for (int b = 0; b < NBLK; ++b)
#pragma unroll
        for (int r = 0; r < 16; ++r) { const float pv = __builtin_amdgcn_exp2f(sc[b][r] - mn); sc[b][r] = pv; ps += pv; }
    ps += __shfl_xor(ps, 32);
    st.l = st.l * alpha + ps;
    st.o0 = st.o0 * alpha; st.o1 = st.o1 * alpha;
    const int G = lane >> 4, i16 = lane & 15;
    const LAS unsigned char* trb = vl + (4 * hh + (i16 >> 2)) * VROWB + (16 * (G & 1) + 4 * (i16 & 3)) * 2;
#pragma unroll
    for (int b = 0; b < NBLK; ++b) {
#pragma unroll
        for (int i = 0; i < 4; ++i) *(LAS v4u*)(vl + ((lane >> 3) + 8 * i) * VROWB + (lane & 7) * 16) = vv[b][i];
        asm volatile("s_waitcnt lgkmcnt(0)" ::: "memory");
#pragma unroll
        for (int ss = 0; ss < 2; ++ss) {
            v4u pw; pw.x = cvtpk(sc[b][8 * ss + 0], sc[b][8 * ss + 1]); pw.y = cvtpk(sc[b][8 * ss + 2], sc[b][8 * ss + 3]); pw.z = cvtpk(sc[b][8 * ss + 4], sc[b][8 * ss + 5]); pw.w = cvtpk(sc[b][8 * ss + 6], sc[b][8 * ss + 7]);
            const bf16x8 pf = __builtin_bit_cast(bf16x8, pw);
            const s16x4 l0 = vtr(trb + (16 * ss) * VROWB), h0 = vtr(trb + (16 * ss + 8) * VROWB), l1 = vtr(trb + (16 * ss) * VROWB + 64), h1 = vtr(trb + (16 * ss + 8) * VROWB + 64);
            st.o0 = __builtin_amdgcn_mfma_f32_32x32x16_bf16((bf16x8){l0[0], l0[1], l0[2], l0[3], h0[0], h0[1], h0[2], h0[3]}, pf, st.o0, 0, 0, 0);
            st.o1 = __builtin_amdgcn_mfma_f32_32x32x16_bf16((bf16x8){l1[0], l1[1], l1[2], l1[3], h1[0], h1[1], h1[2], h1[3]}, pf, st.o1, 0, 0, 0);
        }
        asm volatile("s_waitcnt lgkmcnt(0)" ::: "memory");
    }
}
__device__ __forceinline__ void memattn_fast(const Frame& F, const bf16* H, int ldh, int qoff, const bf16* MEMKV, bf16* CAT, int ldc, int coff) {
    LAS unsigned char* vl = F.lds + F.wave * 16384;
    const int lane = F.lane, r32 = lane & 31, hh = lane >> 5;
    for (int u = F.gw; u < NB * 4 * 64; u += NGW) {
        const int qb = u & 63, h = (u >> 6) & 3, bb = u >> 8, t = bb * SEQ + qb * 32 + r32;
        const bf16* qrow = H + (size_t)t * ldh + qoff + 64 * h + 8 * hh;
        bf16x8 qf[4];
#pragma unroll
        for (int ks = 0; ks < 4; ++ks) qf[ks] = *(const bf16x8*)(qrow + 16 * ks);
        AttnP P; P.kbase = MEMKV + (size_t)bb * ML * 512 + 64 * h; P.kstride = 512; P.voff = 256; P.j0 = 64; P.nsub = ML; P.slope2 = 0.f;
        AttnS st; st.m = -1.0e30f; st.l = 0.f; st.o0 = f32x16{}; st.o1 = f32x16{};
        bf16x8 kf[2][4];
        attn_load_k<2>(kf, 0, P, lane);
#pragma unroll 1
        for (int c = 0; c < 3; ++c) attn_chunk<2, 2, false>(st, qf, kf, 2 * c, P, vl, lane);
        attn_chunk<2, 0, false>(st, qf, kf, 6, P, vl, lane);
        const float inv = 1.f / st.l;
        bf16* orow = CAT + (size_t)t * ldc + coff + 64 * h + 4 * hh;
#pragma unroll
        for (int rg = 0; rg < 4; ++rg) {
            v2u a; a.x = cvtpk(st.o0[4 * rg] * inv, st.o0[4 * rg + 1] * inv); a.y = cvtpk(st.o0[4 * rg + 2] * inv, st.o0[4 * rg + 3] * inv); *(v2u*)(orow + 8 * rg) = a;
            v2u c; c.x = cvtpk(st.o1[4 * rg] * inv, st.o1[4 * rg + 1] * inv); c.y = cvtpk(st.o1[4 * rg + 2] * inv, st.o1[4 * rg + 3] * inv); *(v2u*)(orow + 32 + 8 * rg) = c;
        }
    }
}
__device__ __forceinline__ void dilattn_fast(const Frame& F, const bf16* H, float* OG, float* LSE) {
    LAS unsigned char* vl = F.lds + F.wave * 16384;
    const int lane = F.lane, r32 = lane & 31, hh = lane >> 5;
    for (int u = F.gw; u < NB * 4 * 3 * 64; u += NGW) {
        const int jr = u & 63, g = (u >> 6) % 3, bh = u / 192, h = bh & 3, bb = bh >> 2;
        const int dl = 1 << (2 * g), nsub = SEQ >> (2 * g), sh = 6 - 2 * g, r = jr >> sh, jblk = jr & ((1 << sh) - 1), j0 = 32 * jblk;
        const int t = bb * SEQ + (j0 + r32) * dl + r;
        const bf16* qrow = H + (size_t)t * 2560 + 256 * g + 64 * h + 8 * hh;
        bf16x8 qf[4];
#pragma unroll
        for (int ks = 0; ks < 4; ++ks) qf[ks] = *(const bf16x8*)(qrow + 16 * ks);
        AttnP P; P.kbase = H + (size_t)(bb * SEQ + r) * 2560 + 768 + 256 * g + 64 * h; P.kstride = (size_t)dl * 2560; P.voff = 768; P.j0 = j0; P.nsub = nsub;
        P.slope2 = exp2f(-8.f * (float)(4 * g + h + 1) / 12.f) * (float)dl * 1.4426950408889634f;
        AttnS st; st.m = -1.0e30f; st.l = 0.f; st.o0 = f32x16{}; st.o1 = f32x16{};
        bf16x8 kf[2][4];
        attn_load_k<2>(kf, 0, P, lane);
        attn_chunk<2, 2, true>(st, qf, kf, 0, P, vl, lane);
        attn_chunk<2, 1, true>(st, qf, kf, 2, P, vl, lane);
        attn_chunk<1, 0, true>(st, qf, kf, 4, P, vl, lane);
        const float inv = 1.f / st.l;
        float* orow = OG + ((size_t)g * T + t) * 256 + 64 * h + 4 * hh;
#pragma unroll
        for (int rg = 0; rg < 4; ++rg) {
            *(f32x4*)(orow + 8 * rg) = (f32x4){st.o0[4 * rg] * inv, st.o0[4 * rg + 1] * inv, st.o0[4 * rg + 2] * inv, st.o0[4 * rg + 3] * inv};
            *(f32x4*)(orow + 32 + 8 * rg) = (f32x4){st.o1[4 * rg] * inv, st.o1[4 * rg + 1] * inv, st.o1[4 * rg + 2] * inv, st.o1[4 * rg + 3] * inv};
        }
        if (hh == 0) LSE[((size_t)g * T + t) * 4 + h] = st.m + __builtin_amdgcn_logf(st.l);
    }
}
__device__ __forceinline__ void merge_phase(const Frame& F, const float* OG, const float* LSE, bf16* CAT) {
    const size_t gt = (size_t)blockIdx.x * NTHREADS + F.tid, NT = (size_t)GRID * NTHREADS;
    for (size_t it = gt; it < (size_t)T * 32; it += NT) {
        const int t = (int)(it >> 5), c8 = (int)(it & 31) * 8, h = c8 >> 6;
        const float l0 = LSE[(size_t)t * 4 + h], l1 = LSE[((size_t)T + t) * 4 + h], l2 = LSE[((size_t)2 * T + t) * 4 + h];
        const float mx = fmaxf(l0, fmaxf(l1, l2)); float w0 = __builtin_amdgcn_exp2f(l0 - mx), w1 = __builtin_amdgcn_exp2f(l1 - mx), w2 = __builtin_amdgcn_exp2f(l2 - mx);
        const float inv = 1.f / (w0 + w1 + w2); w0 *= inv; w1 *= inv; w2 *= inv;
        const f32x4* p0 = (const f32x4*)(OG + (size_t)t * 256 + c8); const f32x4* p1 = (const f32x4*)(OG + ((size_t)T + t) * 256 + c8); const f32x4* p2 = (const f32x4*)(OG + ((size_t)2 * T + t) * 256 + c8);
        const f32x4 a = p0[0] * w0 + p1[0] * w1 + p2[0] * w2, b = p0[1] * w0 + p1[1] * w1 + p2[1] * w2;
        v4u o; o.x = pk2(a.x, a.y); o.y = pk2(a.z, a.w); o.z = pk2(b.x, b.y); o.w = pk2(b.z, b.w);
        *(v4u*)(CAT + (size_t)t * 512 + c8) = o;
    }
}

constexpr int NPHASE = 34;
__global__ void __launch_bounds__(NTHREADS, 2) mega(Args args) {
    extern __shared__ __attribute__((aligned(16))) unsigned char lds[];
    Frame F; F.lds = (LAS unsigned char*)lds; F.tid = threadIdx.x; F.lane = F.tid & 63; F.wave = __builtin_amdgcn_readfirstlane(F.tid >> 6); F.gw = blockIdx.x * NWAVES + F.wave;
    volatile LAS unsigned* MISC = (volatile LAS unsigned*)(F.lds + MISC_OFF);
    unsigned char* ws = args.ws;
    unsigned* ctl = (unsigned*)(ws + WS_CTL);
    for (int u = F.tid; u < (LDS_BYTES - LDSCTL_OFF) / 4; u += NTHREADS) ((LAS unsigned*)(F.lds + LDSCTL_OFF))[u] = 0u;
    __syncthreads();
    const int lo = args.lo, hi = args.hi;
    XcdBarrier bar; bar.bar = ctl + CW_BAR; bar.x = 0; bar.st = nullptr;
    if (hi - lo > 1) bar = xcd_barrier_post(ctl + CW_BAR, MISC + 8);
#define IN(k) (lo <= (k) && (k) < hi)
#if PROBE == 6
#define SEAM(k) do { if (IN(k) && IN((k) + 1)) { xcd_barrier(bar); xcd_barrier(bar); } else __syncthreads(); } while (0)
#else
#define SEAM(k) do { if (IN(k) && IN((k) + 1)) xcd_barrier(bar); else __syncthreads(); } while (0)
#endif
    const float* x_in = args.in[I_X];
    int* cntWG = (int*)(ws + WS_META); int* tile_e = (int*)(ws + WS_META + 16384); int* nMp = (int*)(ws + WS_META + 32768);
    int* E01 = (int*)(ws + WS_TOK); float* W01 = (float*)(ws + WS_TOK + 262144); int* DEST = (int*)(ws + WS_TOK + 524288);
    bf16* XB = (bf16*)(ws + WS_XB); bf16* MEMB = (bf16*)(ws + WS_MEMB); bf16* MEMKV = (bf16*)(ws + WS_MEMKV);
    bf16* Hb = (bf16*)(ws + WS_SCR + SC_H); bf16* CAT = (bf16*)(ws + WS_SCR + SC_CAT); bf16* DIFF = (bf16*)(ws + WS_SCR + SC_DIFF); float* OG = (float*)(ws + WS_SCR + SC_OG); float* LSE = (float*)(ws + WS_SCR + SC_LSE);
    bf16* HID = (bf16*)(ws + WS_SCR + SC_HID); bf16* XS = (bf16*)(ws + WS_SCR + SC_XS); bf16* HS = (bf16*)(ws + WS_SCR + SC_HS); bf16* YB = XS;
    const float* ln_g = args.in[I_LNG]; const float* ln_b = args.in[I_LNB];

    bf16* WSM = (bf16*)(ws + WS_WS); bf16* WMOE = (bf16*)(ws + WS_WMOE);
#if FAST_ATTN && PROBE == 2
#define MEMATTN(...) do { memattn_fast(__VA_ARGS__); memattn_fast(__VA_ARGS__); } while (0)
#elif FAST_ATTN
#define MEMATTN memattn_fast
#else
#define MEMATTN memattn_naive
#endif
#if FP8_MOE
#define CONVERT_MOE(F_, g_, u_, d_, r_) convert_moe8(F_, g_, u_, d_, (unsigned char*)WMOE, WMOE, r_)
#else
#define CONVERT_MOE(F_, g_, u_, d_, r_) convert_moe(F_, g_, u_, d_, WMOE, r_)
#endif
#if FAST_GEMM
#define GEMM_BF16(A_, B_, M_, N_, K_, O_) do { pg8::Gemm g_{A_, B_, M_, N_, K_, 0}; pg8::StaticOrder S_; S_.init(M_, N_, GRID, (int)blockIdx.x); pg8::EpiBf16<0> E_{O_, N_, nullptr, 0, 0, 1.f}; \
        pg8::gemm_phase<pg8::EpiBf16<0>, pg8::StaticOrder, true, true>(F.lds, g_, S_, E_); } while (0)
#define GEMM_RESID(A_, B_, K_, BASE_) do { pg8::Gemm g_{A_, B_, T, D, K_, 0}; pg8::StaticOrder S_; S_.init(T, D, GRID, (int)blockIdx.x); pg8::EpiResidB<false> E_{BASE_, XB, ALPHA}; \
        pg8::gemm_phase<pg8::EpiResidB<false>, pg8::StaticOrder, true, true>(F.lds, g_, S_, E_); } while (0)
#define GEMM_RESID0(A_, B_, K_, BASE_) do { pg8::Gemm g_{A_, B_, T, D, K_, 0}; pg8::StaticOrder S_; S_.init(T, D, GRID, (int)blockIdx.x); pg8::EpiResidB<true> E_{BASE_, XB, ALPHA}; \
        pg8::gemm_phase<pg8::EpiResidB<true>, pg8::StaticOrder, true, true>(F.lds, g_, S_, E_); } while (0)
#define GEMM_SWIGLU(A_, B_, M_, NH_, O_) do { pg8::Gemm g_{A_, B_, M_, 2 * (NH_), D, 0}; pg8::StaticOrder S_; S_.init(M_, 2 * (NH_), GRID, (int)blockIdx.x); pg8::EpiSwiglu E_{O_, NH_, EMU_FP8 == 2, 1.f}; \
        pg8::gemm_phase<pg8::EpiSwiglu, pg8::StaticOrder, true, true>(F.lds, g_, S_, E_); } while (0)
#if FP8_D && !FP8_GU
constexpr size_t WB_MD8 = 2 * OFF_MD;
#else
constexpr size_t WB_MD8 = OFF8_MD;
#endif
#if FP8_GU
#define MOE_GU_GEMM pg8::Gemm g_{XS, WMOE + OFF8_MGU / 2, nM_ * 256, 2 * FFE, D / 2, 0x7F7F7F7F}; const size_t es_ = (size_t)FFE * D; constexpr bool f8_ = true; const float sc_ = 1.f / QS_GU
#else
#define MOE_GU_GEMM pg8::Gemm g_{XS, WMOE + OFF_MGU, nM_ * 256, 2 * FFE, D, 0}; const size_t es_ = (size_t)2 * FFE * D; constexpr bool f8_ = false; const float sc_ = 1.f
#endif
#if FP8_D
#define GEMM_MOE_GU() do { const int nM_ = ld_i32_agent(nMp); MOE_GU_GEMM; pg8::MoeOrder S_; S_.init(nM_ * 256, 2 * FFE, GRID, (int)blockIdx.x); S_.tile_e = tile_e; S_.estride = es_; \
        pg8::EpiSwiglu8 E_{(unsigned char*)HS, FFE, sc_}; pg8::gemm_phase<pg8::EpiSwiglu8, pg8::MoeOrder, true, true, f8_>(F.lds, g_, S_, E_); } while (0)
#define GEMM_MOE_D() do { const int nM_ = ld_i32_agent(nMp); pg8::Gemm g_{HS, WMOE + WB_MD8 / 2, nM_ * 256, D, FFE / 2, 0x7F7F7F7F}; pg8::MoeOrder S_; S_.init(nM_ * 256, D, GRID, (int)blockIdx.x); S_.tile_e = tile_e; S_.estride = (size_t)D * FFE / 2; \
        pg8::EpiBf16<0> E_{YB, D, nullptr, 0, 0, 1.f / QS_D}; pg8::gemm_phase<pg8::EpiBf16<0>, pg8::MoeOrder, true, true, true>(F.lds, g_, S_, E_); } while (0)
#else
#define GEMM_MOE_GU() do { const int nM_ = ld_i32_agent(nMp); MOE_GU_GEMM; pg8::MoeOrder S_; S_.init(nM_ * 256, 2 * FFE, GRID, (int)blockIdx.x); S_.tile_e = tile_e; S_.estride = es_; \
        pg8::EpiSwiglu E_{HS, FFE, EMU_FP8 != 0, sc_}; pg8::gemm_phase<pg8::EpiSwiglu, pg8::MoeOrder, true, true, f8_>(F.lds, g_, S_, E_); } while (0)
#define GEMM_MOE_D() do { const int nM_ = ld_i32_agent(nMp); pg8::Gemm g_{HS, WMOE + OFF_MD, nM_ * 256, D, FFE, 0}; pg8::MoeOrder S_; S_.init(nM_ * 256, D, GRID, (int)blockIdx.x); S_.tile_e = tile_e; S_.estride = (size_t)D * FFE; \
        pg8::EpiBf16<0> E_{YB, D, nullptr, 0, 0, 1.f}; pg8::gemm_phase<pg8::EpiBf16<0>, pg8::MoeOrder, true, true>(F.lds, g_, S_, E_); } while (0)
#endif
#endif

    if (IN(0)) { prep_phase(F, x_in, args.in[I_MEM], XB, MEMB);
#if FAST_GEMM
        { int rot = 0; convert_small(F, args, WSM, rot); CONVERT_MOE(F, args.in[I_MG], args.in[I_MU], args.in[I_MD], rot); fold_pool(F, args.in[I_CPOOLW], args.in[I_CPOOLS], args.in[I_CWOUT], WSM + OFF_COUT); }
#if PROBE == 1
        { int rot = 0; convert_small(F, args, WSM, rot); CONVERT_MOE(F, args.in[I_MG], args.in[I_MU], args.in[I_MD], rot); fold_pool(F, args.in[I_CPOOLW], args.in[I_CPOOLS], args.in[I_CWOUT], WSM + OFF_COUT); }
#endif
#if PROBE == 7
        prep_phase(F, x_in, args.in[I_MEM], XB, MEMB);
#endif
#endif
        SEAM(0); }
    if (IN(1)) {
#if FAST_GEMM
        GEMM_BF16(MEMB, WSM + OFF_WKV, NB * ML, 512, D, MEMKV);
#else
        naive_gemm<1>(F, MEMB, D, args.in[I_WMEMKV], nullptr, 512, NB * ML, 512, D, NEpiBf16{MEMKV, 512}, nullptr, 0);
#endif
        SEAM(1); }

    if (IN(2)) {
#if FAST_GEMM
        GEMM_BF16(XB, WSM + OFF_AIN, T, 2560, D, Hb);
#else
        naive_gemm<1>(F, XB, D, args.in[I_AWIN], nullptr, 2560, T, 2560, D, NEpiBf16{Hb, 2560}, nullptr, 0);
#endif
        SEAM(2); }
    if (IN(3)) { mixA_phase(F, Hb, args.in[I_ACONV], CAT);
#if PROBE == 4
        mixA_phase(F, Hb, args.in[I_ACONV], CAT);
#endif
 MEMATTN(F, Hb, 2560, 2304, MEMKV, CAT, 1024, 768); SEAM(3); }
    if (IN(4)) {
#if FAST_GEMM
        GEMM_RESID0(CAT, WSM + OFF_AOUT, 1024, x_in);
#else
        naive_gemm<1>(F, CAT, 1024, args.in[I_AWOUT], nullptr, D, T, D, 1024, NEpiResid{x_in, nullptr, XB}, nullptr, 0);
#endif
        SEAM(4); }
    if (IN(5)) {
#if PROBE == 3
        ln_phase<false, false, false>(F, XB, HS, nullptr, ln_g + 0 * D, ln_b + 0 * D, nullptr, nullptr, nullptr, nullptr, nullptr, nullptr);
#endif
        ln_phase<false, false, false>(F, XB, XB, nullptr, ln_g + 0 * D, ln_b + 0 * D, nullptr, nullptr, nullptr, nullptr, nullptr, nullptr); SEAM(5); }
    if (IN(6)) {
#if FAST_GEMM
        GEMM_SWIGLU(XB, WSM + OFF_FGU, T, FF, HID);
#else
        naive_gemm<2>(F, XB, D, args.in[I_FG], args.in[I_FU], FF, T, FF, D, NEpiSwiglu{HID, FF}, nullptr, 0);
#endif
        SEAM(6); }
    if (IN(7)) {
#if FAST_GEMM
        GEMM_RESID(HID, WSM + OFF_FD, FF, XB);
#else
        naive_gemm<1>(F, HID, FF, args.in[I_FD], nullptr, D, T, D, FF, NEpiResid{nullptr, XB, XB}, nullptr, 0);
#endif
        SEAM(7); }
    if (IN(8)) {
#if PROBE == 3
        ln_phase<false, false, false>(F, XB, HS, nullptr, ln_g + 1 * D, ln_b + 1 * D, nullptr, nullptr, nullptr, nullptr, nullptr, nullptr);
#endif
        ln_phase<false, false, false>(F, XB, XB, nullptr, ln_g + 1 * D, ln_b + 1 * D, nullptr, nullptr, nullptr, nullptr, nullptr, nullptr); SEAM(8); }

    if (IN(9)) {
#if FAST_GEMM
        GEMM_BF16(XB, WSM + OFF_BIN, T, 2560, D, Hb);
#else
        naive_gemm<1>(F, XB, D, args.in[I_BWIN], nullptr, 2560, T, 2560, D, NEpiBf16{Hb, 2560}, nullptr, 0);
#endif
        SEAM(9); }
#if FAST_ATTN
    if (IN(10)) { dilattn_fast(F, Hb, OG, LSE);
#if PROBE == 2
        dilattn_fast(F, Hb, OG, LSE);
#endif
        MEMATTN(F, Hb, 2560, 2304, MEMKV, CAT, 512, 256); SEAM(10); }
    if (IN(11)) { merge_phase(F, OG, LSE, CAT);
#if PROBE == 2
        merge_phase(F, OG, LSE, CAT);
#endif
        SEAM(11); }
#else
    if (IN(10)) { dilattn_naive(F, Hb, CAT, 512); MEMATTN(F, Hb, 2560, 2304, MEMKV, CAT, 512, 256); SEAM(10); }
    if (IN(11)) { SEAM(11); }
#endif
    if (IN(12)) {
#if FAST_GEMM
        GEMM_RESID(CAT, WSM + OFF_BOUT, 512, XB);
#else
        naive_gemm<1>(F, CAT, 512, args.in[I_BWOUT], nullptr, D, T, D, 512, NEpiResid{nullptr, XB, XB}, nullptr, 0);
#endif
        SEAM(12); }
    if (IN(13)) { ln_phase<true, false, false>(F, XB, XB, nullptr, ln_g + 2 * D, ln_b + 2 * D, args.in[I_ROUTER], E01, W01, nullptr, nullptr, cntWG); SEAM(13); }
    if (IN(14)) { scatter_phase(F, cntWG, E01, DEST, XB, XS, tile_e, nMp);
#if PROBE == 5
        scatter_phase(F, cntWG, E01, DEST, XB, XS, tile_e, nMp);
#endif
        SEAM(14); }
    if (IN(15)) {
#if FAST_GEMM
        GEMM_MOE_GU();
#else
        const int nM = ld_i32_agent(nMp); naive_gemm<2>(F, XS, D, args.in[I_MG], args.in[I_MU], FFE, nM * 256, FFE, D, NEpiSwiglu{HS, FFE}, tile_e, (size_t)D * FFE);
#endif
        SEAM(15); }
    if (IN(16)) {
#if FAST_GEMM
        GEMM_MOE_D();
#else
        const int nM = ld_i32_agent(nMp); naive_gemm<1>(F, HS, FFE, args.in[I_MD], nullptr, D, nM * 256, D, FFE, NEpiBf16{YB, D}, tile_e, (size_t)FFE * D);
#endif
        SEAM(16); }
    if (IN(17)) { ln_phase<false, true, false>(F, XB, XB, nullptr, ln_g + 3 * D, ln_b + 3 * D, nullptr, nullptr, W01, DEST, YB, nullptr); SEAM(17); }

    if (IN(18)) {
#if FAST_GEMM
        GEMM_BF16(XB, WSM + OFF_CIN, T, 1024, D, Hb);
#else
        naive_gemm<1>(F, XB, D, args.in[I_CWIN], nullptr, 1024, T, 1024, D, NEpiBf16{Hb, 1024}, nullptr, 0);
#endif
        SEAM(18); }
#if FAST_GEMM
    if (IN(19)) { poolC_phase(F, Hb, CAT, 1024);
#if PROBE == 4
        poolC_phase(F, Hb, CAT, 1024);
#endif
        MEMATTN(F, Hb, 1024, 768, MEMKV, CAT, 1024, 768);
        { int rot = 0; CONVERT_MOE(F, args.in[I_MG] + (size_t)NE * D * FFE, args.in[I_MU] + (size_t)NE * D * FFE, args.in[I_MD] + (size_t)NE * FFE * D, rot); }
#if PROBE == 1
        { int rot = 0; CONVERT_MOE(F, args.in[I_MG] + (size_t)NE * D * FFE, args.in[I_MU] + (size_t)NE * D * FFE, args.in[I_MD] + (size_t)NE * FFE * D, rot); }
#endif
        SEAM(19); }
#else
    if (IN(19)) { poolC_phase(F, Hb, DIFF, 768); MEMATTN(F, Hb, 1024, 768, MEMKV, CAT, 1024, 768); SEAM(19); }
    if (IN(20)) {
#pragma unroll 1
        for (int g = 0; g < 4; ++g) naive_gemm<1>(F, DIFF + 192 * g, 768, args.in[I_CPOOLW] + (size_t)g * 192 * 192, nullptr, 192, T, 192, 192, NEpiScale{CAT, 1024, 192 * g, args.in[I_CPOOLS]}, nullptr, 0);
        SEAM(20); }
#endif
    if (IN(21)) {
#if FAST_GEMM
        GEMM_RESID(CAT, WSM + OFF_COUT, 1024, XB);
#else
        naive_gemm<1>(F, CAT, 1024, args.in[I_CWOUT], nullptr, D, T, D, 1024, NEpiResid{nullptr, XB, XB}, nullptr, 0);
#endif
        SEAM(21); }
    if (IN(22)) {
#if PROBE == 3
        ln_phase<false, false, false>(F, XB, HS, nullptr, ln_g + 4 * D, ln_b + 4 * D, nullptr, nullptr, nullptr, nullptr, nullptr, nullptr);
#endif
        ln_phase<false, false, false>(F, XB, XB, nullptr, ln_g + 4 * D, ln_b + 4 * D, nullptr, nullptr, nullptr, nullptr, nullptr, nullptr); SEAM(22); }
    if (IN(23)) {
#if FAST_GEMM
        GEMM_SWIGLU(XB, WSM + OFF_FGU + (size_t)2 * FF * D, T, FF, HID);
#else
        naive_gemm<2>(F, XB, D, args.in[I_FG] + (size_t)D * FF, args.in[I_FU] + (size_t)D * FF, FF, T, FF, D, NEpiSwiglu{HID, FF}, nullptr, 0);
#endif
        SEAM(23); }
    if (IN(24)) {
#if FAST_GEMM
        GEMM_RESID(HID, WSM + OFF_FD + (size_t)D * FF, FF, XB);
#else
        naive_gemm<1>(F, HID, FF, args.in[I_FD] + (size_t)FF * D, nullptr, D, T, D, FF, NEpiResid{nullptr, XB, XB}, nullptr, 0);
#endif
        SEAM(24); }
    if (IN(25)) {
#if PROBE == 3
        ln_phase<false, false, false>(F, XB, HS, nullptr, ln_g + 5 * D, ln_b + 5 * D, nullptr, nullptr, nullptr, nullptr, nullptr, nullptr);
#endif
        ln_phase<false, false, false>(F, XB, XB, nullptr, ln_g + 5 * D, ln_b + 5 * D, nullptr, nullptr, nullptr, nullptr, nullptr, nullptr); SEAM(25); }

    if (IN(26)) {
#if FAST_GEMM
        GEMM_BF16(XB, WSM + OFF_AIN + (size_t)2560 * D, T, 2560, D, Hb);
#else
        naive_gemm<1>(F, XB, D, args.in[I_AWIN] + (size_t)D * 2560, nullptr, 2560, T, 2560, D, NEpiBf16{Hb, 2560}, nullptr, 0);
#endif
        SEAM(26); }
    if (IN(27)) { mixA_phase(F, Hb, args.in[I_ACONV] + 3 * 768, CAT);
#if PROBE == 4
        mixA_phase(F, Hb, args.in[I_ACONV] + 3 * 768, CAT);
#endif
 MEMATTN(F, Hb, 2560, 2304, MEMKV, CAT, 1024, 768); SEAM(27); }
    if (IN(28)) {
#if FAST_GEMM
        GEMM_RESID(CAT, WSM + OFF_AOUT + (size_t)D * D, 1024, XB);
#else
        naive_gemm<1>(F, CAT, 1024, args.in[I_AWOUT] + (size_t)D * D, nullptr, D, T, D, 1024, NEpiResid{nullptr, XB, XB}, nullptr, 0);
#endif
        SEAM(28); }
    if (IN(29)) { ln_phase<true, false, false>(F, XB, XB, nullptr, ln_g + 6 * D, ln_b + 6 * D, args.in[I_ROUTER] + D * NE, E01, W01, nullptr, nullptr, cntWG); SEAM(29); }
    if (IN(30)) { scatter_phase(F, cntWG, E01, DEST, XB, XS, tile_e, nMp);
#if PROBE == 5
        scatter_phase(F, cntWG, E01, DEST, XB, XS, tile_e, nMp);
#endif
        SEAM(30); }
    if (IN(31)) {
#if FAST_GEMM
        GEMM_MOE_GU();
#else
        const int nM = ld_i32_agent(nMp); naive_gemm<2>(F, XS, D, args.in[I_MG] + (size_t)NE * D * FFE, args.in[I_MU] + (size_t)NE * D * FFE, FFE, nM * 256, FFE, D, NEpiSwiglu{HS, FFE}, tile_e, (size_t)D * FFE);
#endif
        SEAM(31); }
    if (IN(32)) {
#if FAST_GEMM
        GEMM_MOE_D();
#else
        const int nM = ld_i32_agent(nMp); naive_gemm<1>(F, HS, FFE, args.in[I_MD] + (size_t)NE * FFE * D, nullptr, D, nM * 256, D, FFE, NEpiBf16{YB, D}, tile_e, (size_t)FFE * D);
#endif
        SEAM(32); }
    if (IN(33)) { ln_phase<false, true, true>(F, XB, nullptr, args.out, ln_g + 7 * D, ln_b + 7 * D, nullptr, nullptr, W01, DEST, YB, nullptr); }
#undef IN
#undef SEAM
}

extern "C" void kernel_launch(void* const* d_in, const int* in_sizes, int n_in, void* d_out, int out_size, void* d_ws, size_t ws_size, hipStream_t stream) {
    static int ok = 0;
    if (ok == 0) {
        ok = 1;
        if (n_in != 21 || out_size != T * D || ws_size < WS_END) { fprintf(stderr, "kernel_launch: unexpected shapes (n_in %d, out %d, ws %zu < %zu)\n", n_in, out_size, ws_size, (size_t)WS_END); ok = -1; }
        if (ok > 0 && hipFuncSetAttribute((const void*)mega, hipFuncAttributeMaxDynamicSharedMemorySize, LDS_BYTES) != hipSuccess) { fprintf(stderr, "kernel_launch: hipFuncSetAttribute failed\n"); ok = -1; }
        int dev = 0, cus = 0; (void)hipGetDevice(&dev); (void)hipDeviceGetAttribute(&cus, hipDeviceAttributeMultiprocessorCount, dev);
        if (cus < GRID) { fprintf(stderr, "kernel_launch: %d CUs < %d\n", cus, GRID); ok = -1; }
        (void)hipGetLastError();
    }
    if (ok < 0) return;
    (void)hipMemsetAsync((char*)d_ws + WS_CTL, 0, CTL_ZERO_BYTES, stream);
    Args a{};
    for (int i = 0; i < 21; ++i) a.in[i] = (const float*)d_in[i];
    a.out = (float*)d_out; a.ws = (unsigned char*)d_ws;
#if MK_ONE_LAUNCH
    a.lo = 0; a.hi = NPHASE;
    hipLaunchKernelGGL(mega, dim3(GRID), dim3(NTHREADS), LDS_BYTES, stream, a);
#else
    for (int p = 0; p < NPHASE; ++p) { if (p == 11) continue; a.lo = p; a.hi = p + 1; hipLaunchKernelGGL(mega, dim3(GRID), dim3(NTHREADS), LDS_BYTES, stream, a); }
#endif
}
```

```cpp
#include <hip/hip_runtime.h>
#include <cstdio>
#include <cstdint>

#ifndef MK_ONE_LAUNCH
#define MK_ONE_LAUNCH 1
#endif
#ifndef FAST_GEMM
#define FAST_GEMM 1
#endif
#ifndef FAST_ATTN
#define FAST_ATTN 1
#endif

#ifndef PROBE
#define PROBE 0
#endif

#ifndef FP8_MOE
#define FP8_MOE 1
#endif
#define FP8_GU (FP8_MOE == 1 || FP8_MOE == 2)
#define FP8_D  (FP8_MOE == 1 || FP8_MOE == 3)
#ifndef EMU_FP8
#define EMU_FP8 0
#endif

#define GAS __attribute__((address_space(1)))
#define LAS __attribute__((address_space(3)))
typedef unsigned short bf16;
typedef unsigned v4u __attribute__((ext_vector_type(4)));
typedef unsigned v2u __attribute__((ext_vector_type(2)));
typedef float f32x4 __attribute__((ext_vector_type(4)));
typedef float f32x2 __attribute__((ext_vector_type(2)));
typedef float f32x16 __attribute__((ext_vector_type(16)));
typedef short bf16x8 __attribute__((ext_vector_type(8)));
typedef short s16x4 __attribute__((ext_vector_type(4)));
#define RLX_AGENT __ATOMIC_RELAXED, __HIP_MEMORY_SCOPE_AGENT
#define LDS_WAIT() asm volatile("s_waitcnt lgkmcnt(0)" ::: "memory")
#define VM_WAIT() asm volatile("s_waitcnt vmcnt(0)" ::: "memory")

constexpr int NB = 16, SEQ = 2048, T = NB * SEQ, D = 1024, ML = 256, MEMW = 256, MIXW = 768, HD = 64;
constexpr int FF = 2816, FFE = 3584, NE = 8;
constexpr int RMAX = (2 * T / 256 + NE) * 256;
constexpr float ALPHA = 1.6817928305074290f;
constexpr float LN_EPS = 1e-5f;
constexpr int NWAVES = 8, NTHREADS = 512, GRID = 256, NGW = GRID * NWAVES;

constexpr size_t MiB = 1u << 20;
constexpr size_t WS_CTL = 0, CTL_ZERO_BYTES = 1 * MiB;
constexpr size_t WS_META = 1 * MiB;
constexpr size_t WS_TOK = 2 * MiB;
constexpr size_t WS_WS = 4 * MiB;
constexpr size_t WS_WMOE = 64 * MiB;
constexpr size_t WS_XB = 232 * MiB;
constexpr size_t WS_MEMB = 296 * MiB;
constexpr size_t WS_MEMKV = 304 * MiB;
constexpr size_t WS_SCR = 308 * MiB;
constexpr size_t SC_H = 0, SC_CAT = 160 * MiB, SC_OG = 224 * MiB, SC_LSE = 320 * MiB, SC_DIFF = 224 * MiB;
constexpr size_t SC_HID = 0;
constexpr size_t SC_XS = 0, SC_HS = 132 * MiB;
constexpr size_t WS_END = WS_SCR + SC_HS + (size_t)RMAX * FFE * 2;
static_assert(WS_END <= 903 * MiB, "ws map");
constexpr size_t OFF_WKV = 0, OFF_AIN = 524288, OFF_AOUT = 5767168, OFF_BIN = 7864320, OFF_BOUT = 10485760, OFF_CIN = 11010048,
                 OFF_COUT = 12058624, OFF_FGU = 13107200, OFF_FD = 24641536, OFF_WS_END = 30408704;
static_assert(OFF_WS_END * 2 <= 60 * MiB, "small weights");
constexpr size_t OFF_MGU = 0, OFF_MD = (size_t)NE * 2 * FFE * D;
constexpr int CW_BAR = 4096;

constexpr int RING_BYTES = 131072, LDSCTL_OFF = RING_BYTES, MISC_OFF = LDSCTL_OFF + 320, LDS_BYTES = 147456;

__device__ __forceinline__ unsigned f2bf(float f) { unsigned u = __builtin_bit_cast(unsigned, f); return (u + 0x7fffu + ((u >> 16) & 1u)) >> 16; }
__device__ __forceinline__ float q8(float x) { const float ax = fabsf(x); if (ax < 0.015625f) return copysignf(rintf(ax * 512.f) * (1.f / 512.f), x); if (ax > 448.f) return copysignf(448.f, x);
    unsigned u = __builtin_bit_cast(unsigned, x); u += 0x7FFFFu + ((u >> 20) & 1u); u &= 0xFFF00000u; return __builtin_bit_cast(float, u); }
__device__ __forceinline__ unsigned pk2(float lo, float hi) { return f2bf(lo) | (f2bf(hi) << 16); }
__device__ __forceinline__ float bf2f(unsigned b) { return __builtin_bit_cast(float, b << 16); }
__device__ __forceinline__ float bflo(unsigned w) { return __builtin_bit_cast(float, w << 16); }
__device__ __forceinline__ float bfhi(unsigned w) { return __builtin_bit_cast(float, w & 0xffff0000u); }
__device__ __forceinline__ float wave_sum(float v) {
#pragma unroll
    for (int o = 1; o < 64; o <<= 1) v += __shfl_xor(v, o);
    return v;
}
__device__ __forceinline__ int ld_i32_agent(const int* p) { return (int)__hip_atomic_load((const unsigned*)p, RLX_AGENT); }
__device__ __forceinline__ float ld_f32_agent(const float* p) { return __builtin_bit_cast(float, __hip_atomic_load((const unsigned*)p, RLX_AGENT)); }

#define XB_TMO      128
#define XB_XCNT(j)  (256  + 64 * (j))
#define XB_XSUB(j)  (1280 + 64 * (j))
#define XB_XGEN(j)  (2304 + 64 * (j))
#define XB_TOP      3328
#define XB_TOPGEN   3392
#define XCD_BAR_WORDS 3456
#define XB_SPIN_CAP (1u << 18)
__device__ __forceinline__ unsigned xb_ld(unsigned* p)              { return __hip_atomic_load(p, __ATOMIC_RELAXED, __HIP_MEMORY_SCOPE_AGENT); }
__device__ __forceinline__ unsigned xb_add(unsigned* p, unsigned v) { return __hip_atomic_fetch_add(p, v, __ATOMIC_RELAXED, __HIP_MEMORY_SCOPE_AGENT); }
__device__ __forceinline__ unsigned xb_xcc_id() { return (unsigned)__builtin_amdgcn_s_getreg((3 << 11) | 20) & 0xFu; }
#define XB_SPIN(cond, bar) do { unsigned _sp = 0; while (cond) { __builtin_amdgcn_s_sleep(1); \
    if ((++_sp & 255u) == 0u) { if (xb_ld(&(bar)[XB_TMO])) break; if (_sp > XB_SPIN_CAP) { atomicAdd(&(bar)[XB_TMO], 1u); break; } } } } while (0)
struct XcdBarrier { unsigned* bar; unsigned x; volatile LAS unsigned* st; };
__device__ __forceinline__ XcdBarrier xcd_barrier_post(unsigned* bar, volatile LAS unsigned* st) {
    XcdBarrier b; b.bar = bar; b.x = xb_xcc_id(); b.st = st;
    if (threadIdx.x == 0) (void)xb_add(&bar[XB_XCNT(b.x)], 1u);
    return b;
}
__device__ __forceinline__ void xcd_barrier_complete(unsigned* bar, unsigned x, unsigned& nloc, unsigned& nx) {
    const unsigned G = gridDim.x * gridDim.y * gridDim.z;
    unsigned sum, cnt, mine, sp = 0u;
    for (;;) {
        sum = 0u; cnt = 0u; mine = 0u;
#pragma unroll
        for (unsigned j = 0; j < 16; ++j) { const unsigned c = xb_ld(&bar[XB_XCNT(j)]); sum += c; cnt += (c > 0u) ? 1u : 0u; mine = (j == x) ? c : mine; }
        if (sum == G) break;
        __builtin_amdgcn_s_sleep(1);
        if ((++sp & 255u) == 0u) { if (xb_ld(&bar[XB_TMO])) break; if (sp > XB_SPIN_CAP) { atomicAdd(&bar[XB_TMO], 1u); break; } }
    }
    nloc = mine > 0u ? mine : 1u; nx = cnt > 0u ? cnt : 1u;
}
__device__ __forceinline__ void xcd_barrier(const XcdBarrier& b) {
    asm volatile("s_waitcnt vmcnt(0)" ::: "memory");
    __syncthreads();
    if (threadIdx.x == 0) {
        unsigned* bar = b.bar;
        __builtin_amdgcn_s_waitcnt(0);
        unsigned nloc = b.st[0], nx = b.st[1];
        if (nloc == 0u) { xcd_barrier_complete(bar, b.x, nloc, nx); b.st[0] = nloc; b.st[1] = nx; }
        const unsigned old = xb_add(&bar[XB_XSUB(b.x)], 1u);
        const unsigned gen = old / nloc;
        if (old + 1u == (gen + 1u) * nloc) {
            __builtin_amdgcn_fence(__ATOMIC_RELEASE, "agent");
            asm volatile("s_waitcnt vmcnt(0)" ::: "memory");
            const unsigned og = xb_add(&bar[XB_TOP], 1u);
            const unsigned tg = og / nx;
            if (og + 1u == (tg + 1u) * nx) xb_add(&bar[XB_TOPGEN], 1u);
            else XB_SPIN(xb_ld(&bar[XB_TOPGEN]) == tg, bar);
            __builtin_amdgcn_fence(__ATOMIC_ACQUIRE, "agent");
            xb_add(&bar[XB_XGEN(b.x)], 1u);
            asm volatile("s_waitcnt vmcnt(0)" ::: "memory");
        } else {
            XB_SPIN(xb_ld(&bar[XB_XGEN(b.x)]) == gen, bar);
            __builtin_amdgcn_fence(__ATOMIC_ACQUIRE, "agent");
            asm volatile("s_waitcnt vmcnt(0)" ::: "memory");
        }
    }
    __syncthreads();
}

namespace pg8 {
#define PG8_LAS __attribute__((address_space(3)))
typedef unsigned short bf16_t;
typedef short bf16x8 __attribute__((ext_vector_type(8)));
typedef float f32x4 __attribute__((ext_vector_type(4)));
typedef unsigned u32x4 __attribute__((ext_vector_type(4)));
constexpr int BM = 256, BK = 64, HALF = 128, HTB = HALF * BK * 2  , STAGE_BYTES = 8 * HTB, NXCD = 8, WGM = 8;

__host__ __device__ __forceinline__ int lds_byte(int r, int c) { const int st = (r >> 4) * 2 + (c >> 5), rr = r & 15, cc = c & 31, ob = rr * 64 + cc * 2; return st * 1024 + (ob ^ (((ob >> 9) & 1) << 5)); }
__host__ __device__ __forceinline__ void stage_rc(int b, int& R, int& C) { const int st = b / 1024, sb = b % 1024, swz = sb ^ (((sb >> 9) & 1) << 5); R = (st >> 1) * 16 + swz / 64; C = (st & 1) * 32 + (swz % 64) / 2; }
__host__ __device__ __forceinline__ int perm32(int rho) { const int n = rho >> 4, i = rho & 15; return 8 * (i >> 2) + 4 * n + (i & 3); }

struct Unit { int pm, pn; };
struct Gemm { const bf16_t* A; const bf16_t* Bt; int M, N, K; int wscale; };
typedef int v8i __attribute__((ext_vector_type(8)));
typedef int v4i __attribute__((ext_vector_type(4)));
__device__ __forceinline__ void mfma8(f32x4& acc, const v8i& a, const v8i& b, int sa, int sb) {
    asm volatile("s_nop 1\n\tv_mfma_scale_f32_16x16x128_f8f6f4 %0, %1, %2, %0, %3, %4 op_sel_hi:[0,0,0]" : "+v"(acc) : "v"(a), "v"(b), "v"(sa), "v"(sb)); }
__device__ __forceinline__ bf16x8 lo8(const v8i v) { const v4i t = __builtin_shufflevector(v, v, 0, 1, 2, 3); return __builtin_bit_cast(bf16x8, t); }
__device__ __forceinline__ bf16x8 hi8(const v8i v) { const v4i t = __builtin_shufflevector(v, v, 4, 5, 6, 7); return __builtin_bit_cast(bf16x8, t); }
__device__ __forceinline__ v8i cat8(bf16x8 a, bf16x8 b) { return __builtin_shufflevector(__builtin_bit_cast(v4i, a), __builtin_bit_cast(v4i, b), 0, 1, 2, 3, 4, 5, 6, 7); }

struct StaticOrder {
    int nM, nN, nwg, G, c;
    __host__ __device__ void init(int M, int N, int G_, int c_) { nM = M / BM; nN = N / BM; nwg = nM * nN; G = G_; c = c_; }
    __host__ __device__ bool next(int i, Unit& u) const {
        const long L = (long)i * G + c; if (L >= nwg) return false;
        int wgid = (int)L; { const int q = nwg / NXCD, r = nwg % NXCD, xcd = wgid % NXCD, off = wgid / NXCD; wgid = (xcd < r ? xcd * (q + 1) : r * (q + 1) + (xcd - r) * q) + off; }
        const int nig = WGM * nN, gid = wgid / nig, fm = gid * WGM, gsz = (nM - fm) < WGM ? (nM - fm) : WGM;
        u.pm = fm + ((wgid % nig) % gsz); u.pn = (wgid % nig) / gsz; return true;
    }
    __device__ __forceinline__ void a_ready(const Unit&) const {}
    __device__ __forceinline__ void done(const Unit&) const {}
    __device__ __forceinline__ size_t boff(const Unit&) const { return 0; }
};
struct MoeOrder : StaticOrder {
    const PG8_LAS int* tile_e; size_t estride;
    __device__ __forceinline__ size_t boff(const Unit& u) const { return (size_t)__builtin_amdgcn_readfirstlane(tile_e[u.pm]) * estride; }
};

__device__ __forceinline__ unsigned cvt_pk_bf16(float lo, float hi) { unsigned r; asm volatile("v_cvt_pk_bf16_f32 %0, %1, %2" : "=v"(r) : "v"(lo), "v"(hi)); return r; }
typedef float f32x2 __attribute__((ext_vector_type(2)));
template <int ACT  > struct EpiBf16 {
    static constexpr bool PERM = true, AFTER_DRAIN = false; static_assert(ACT == 0, "EpiBf16: ACT is 0");
    bf16_t* O; int ldc; const float* bias; int split_cols; size_t split_stride; float scale0;
    __device__ __forceinline__ void operator()(const f32x4 (&acc)[2][2][4][2], const Unit& u, int wr, int wc, int fr, int fq) const {
        const int row0 = u.pm * BM + wr * 64 + fr; int colt = u.pn * BM; bf16_t* base = O;
        float sc = scale0; if (split_cols) { const int t = colt / split_cols; base += (size_t)t * split_stride; colt -= t * split_cols; if (t != 0) sc = 1.f; }
        const int col0 = colt + wc * 32 + 8 * fq, bcol0 = u.pn * BM + wc * 32 + 8 * fq;
        f32x4 bv[2][2];
#pragma unroll
        for (int bj = 0; bj < 2; ++bj)
#pragma unroll
            for (int n = 0; n < 2; ++n) bv[bj][n] = bias ? *(const f32x4*)(bias + bcol0 + bj * HALF + 4 * n) : (f32x4){0.f, 0.f, 0.f, 0.f};
#pragma unroll
        for (int ai = 0; ai < 2; ++ai)
#pragma unroll
            for (int m = 0; m < 4; ++m) { bf16_t* rowp = base + (size_t)(row0 + ai * HALF + m * 16) * ldc + col0;
#pragma unroll
                for (int bj = 0; bj < 2; ++bj) { f32x4 v0 = acc[ai][bj][m][0] + bv[bj][0], v1 = acc[ai][bj][m][1] + bv[bj][1];
                    v0 = v0 * sc; v1 = v1 * sc; u32x4 w; w.x = cvt_pk_bf16(v0[0], v0[1]); w.y = cvt_pk_bf16(v0[2], v0[3]); w.z = cvt_pk_bf16(v1[0], v1[1]); w.w = cvt_pk_bf16(v1[2], v1[3]);
                    *(u32x4*)(rowp + bj * HALF) = w; } }
    }
};

struct EpiSwiglu {
    static constexpr bool PERM = true, AFTER_DRAIN = false;
    bf16_t* O; int ldc; int quant; float sc;
    __device__ __forceinline__ void operator()(const f32x4 (&acc)[2][2][4][2], const Unit& u, int wr, int wc, int fr, int fq) const {
        const int row0 = u.pm * BM + wr * 64 + fr, col0 = u.pn * HALF + wc * 32 + 8 * fq;
#pragma unroll
        for (int ai = 0; ai < 2; ++ai)
#pragma unroll
            for (int m = 0; m < 4; ++m) { bf16_t* rowp = O + (size_t)(row0 + ai * HALF + m * 16) * ldc + col0;
                float h[8];
#pragma unroll
                for (int n = 0; n < 2; ++n)
#pragma unroll
                    for (int j = 0; j < 4; ++j) { const float gte = acc[ai][0][m][n][j] * sc, up = acc[ai][1][m][n][j] * sc;
                        h[4 * n + j] = gte * __builtin_amdgcn_rcpf(1.0f + __builtin_amdgcn_exp2f(-1.4426950408889634f * gte)) * up; if (quant) h[4 * n + j] = q8(h[4 * n + j]); }
                u32x4 w; w.x = cvt_pk_bf16(h[0], h[1]); w.y = cvt_pk_bf16(h[2], h[3]); w.z = cvt_pk_bf16(h[4], h[5]); w.w = cvt_pk_bf16(h[6], h[7]);
                *(u32x4*)rowp = w; }
    }
};

struct EpiSwiglu8 {
    static constexpr bool PERM = true, AFTER_DRAIN = false;
    unsigned char* O; int ldc; float sc;
    __device__ __forceinline__ void operator()(const f32x4 (&acc)[2][2][4][2], const Unit& u, int wr, int wc, int fr, int fq) const {
        const int row0 = u.pm * BM + wr * 64 + fr, col0 = u.pn * HALF + wc * 32 + 8 * fq;
#pragma unroll
        for (int ai = 0; ai < 2; ++ai)
#pragma unroll
            for (int m = 0; m < 4; ++m) { unsigned char* rowp = O + (size_t)(row0 + ai * HALF + m * 16) * ldc + col0;
                float h[8];
#pragma unroll
                for (int n = 0; n < 2; ++n)
#pragma unroll
                    for (int j = 0; j < 4; ++j) { const float gte = acc[ai][0][m][n][j] * sc, up = acc[ai][1][m][n][j] * sc;
                        h[4 * n + j] = gte * __builtin_amdgcn_rcpf(1.0f + __builtin_amdgcn_exp2f(-1.4426950408889634f * gte)) * up; }
                int p0 = 0, p1 = 0;
                p0 = __builtin_amdgcn_cvt_pk_fp8_f32(h[0], h[1], p0, false); p0 = __builtin_amdgcn_cvt_pk_fp8_f32(h[2], h[3], p0, true);
                p1 = __builtin_amdgcn_cvt_pk_fp8_f32(h[4], h[5], p1, false); p1 = __builtin_amdgcn_cvt_pk_fp8_f32(h[6], h[7], p1, true);
                typedef int i32x2 __attribute__((ext_vector_type(2)));
                *(i32x2*)rowp = (i32x2){p0, p1}; }
    }
};

template <bool BASE_F32> struct EpiResidB {
    static constexpr bool PERM = true, AFTER_DRAIN = false;
    const void* base; bf16_t* out; float alpha;
    __device__ __forceinline__ void operator()(const f32x4 (&acc)[2][2][4][2], const Unit& u, int wr, int wc, int fr, int fq) const {
        const int row0 = u.pm * BM + wr * 64 + fr, col0 = u.pn * BM + wc * 32 + 8 * fq;
#pragma unroll
        for (int ai = 0; ai < 2; ++ai)
#pragma unroll
            for (int m = 0; m < 4; ++m) { const size_t ro = (size_t)(row0 + ai * HALF + m * 16) * 1024 + col0;
                float bs[2][8];
#pragma unroll
                for (int bj = 0; bj < 2; ++bj) {
                    if constexpr (BASE_F32) { const f32x4 a = *(const f32x4*)((const float*)base + ro + bj * HALF), c = *(const f32x4*)((const float*)base + ro + bj * HALF + 4);
#pragma unroll
                        for (int j = 0; j < 4; ++j) { bs[bj][j] = a[j]; bs[bj][4 + j] = c[j]; } }
                    else { const u32x4 w = *(const u32x4*)((const bf16_t*)base + ro + bj * HALF);
                        bs[bj][0] = __builtin_bit_cast(float, w.x << 16); bs[bj][1] = __builtin_bit_cast(float, w.x & 0xffff0000u); bs[bj][2] = __builtin_bit_cast(float, w.y << 16); bs[bj][3] = __builtin_bit_cast(float, w.y & 0xffff0000u);
                        bs[bj][4] = __builtin_bit_cast(float, w.z << 16); bs[bj][5] = __builtin_bit_cast(float, w.z & 0xffff0000u); bs[bj][6] = __builtin_bit_cast(float, w.w << 16); bs[bj][7] = __builtin_bit_cast(float, w.w & 0xffff0000u); } }
#pragma unroll
                for (int bj = 0; bj < 2; ++bj) { float z[8];
#pragma unroll
                    for (int j = 0; j < 8; ++j) z[j] = bs[bj][j] * alpha + acc[ai][bj][m][j >> 2][j & 3];
                    u32x4 w; w.x = cvt_pk_bf16(z[0], z[1]); w.y = cvt_pk_bf16(z[2], z[3]); w.z = cvt_pk_bf16(z[4], z[5]); w.w = cvt_pk_bf16(z[6], z[7]);
                    *(u32x4*)(out + ro + bj * HALF) = w; } }
    }
};

struct EpiNull {
    static constexpr bool PERM = true, AFTER_DRAIN = false;
    __device__ __forceinline__ void operator()(const f32x4 (&acc)[2][2][4][2], const Unit&, int, int, int, int) const {
#pragma unroll
        for (int a = 0; a < 2; ++a)
#pragma unroll
            for (int b = 0; b < 2; ++b)
#pragma unroll
                for (int m = 0; m < 4; ++m)
#pragma unroll
                    for (int n = 0; n < 2; ++n) asm volatile("" :: "v"(acc[a][b][m][n]));
    }
};
struct EpiResid {
    static constexpr bool PERM = false, AFTER_DRAIN = false;
    const float* base; float* out; int ldc; float alpha;
    __device__ __forceinline__ void operator()(const f32x4 (&acc)[2][2][4][2], const Unit& u, int wr, int wc, int fr, int fq) const {
        const int row0 = u.pm * BM + wr * 64 + fr, col0 = u.pn * BM + wc * 32 + 4 * fq;
#pragma unroll
        for (int ai = 0; ai < 2; ++ai)
#pragma unroll
            for (int m = 0; m < 4; ++m) { const size_t ro = (size_t)(row0 + ai * HALF + m * 16) * ldc + col0;
                f32x4 bs[2][2];
#pragma unroll
                for (int bj = 0; bj < 2; ++bj)
#pragma unroll
                    for (int n = 0; n < 2; ++n) bs[bj][n] = *(const f32x4*)(base + ro + bj * HALF + n * 16);
#pragma unroll
                for (int bj = 0; bj < 2; ++bj)
#pragma unroll
                    for (int n = 0; n < 2; ++n) *(f32x4*)(out + ro + bj * HALF + n * 16) = bs[bj][n] * alpha + acc[ai][bj][m][n]; }
    }
};

template <class Epi, class Sched, bool ALIGN_EPI = false, bool SP2 = false, bool F8 = false>
__device__ __forceinline__ void gemm_phase(PG8_LAS unsigned char* lds, const Gemm g, const Sched& S, const Epi& E) {
    const int tid = threadIdx.x, wid = __builtin_amdgcn_readfirstlane(tid >> 6), lane = tid & 63, wr = wid >> 2, wc = wid & 3, fr = lane & 15, fq = lane >> 4;
    const int K = g.K, nt = K / BK; const int wsc = g.wscale;
    unsigned voffA[2], voffB[2];
#pragma unroll
    for (int i = 0; i < 2; ++i) { int R, C; stage_rc(tid * 16 + i * 8192, R, C); const int Rb = Epi::PERM ? ((R & ~31) + perm32(R & 31)) : R;
        voffA[i] = (unsigned)(R * K + C) * 2u; voffB[i] = (unsigned)(Rb * K + C) * 2u; }
    const size_t kstep = (size_t)(BK * 2);
    const size_t hstep = (size_t)HALF * K * 2;
    const size_t tstep = 2 * hstep;
    const unsigned ldsw = (unsigned)wid * 1024u;
    const int aoff = lds_byte(wr * 64 + fr, fq * 8), boff = lds_byte(wc * 32 + fr, fq * 8);
#define PG8_SA(b, h) (((b) * 2 + (h)) * HTB)
#define PG8_SB(b, h) ((4 + (b) * 2 + (h)) * HTB)
#define PG8_STAGE(bufoff, gbase, voff) do { _Pragma("unroll") for (int _i = 0; _i < 2; ++_i) \
        __builtin_amdgcn_global_load_lds((const unsigned*)((const char*)(gbase) + (voff)[_i]), (PG8_LAS unsigned*)(lds + (bufoff) + ldsw + _i * 8192), 16, 0, 0); } while (0)
#define PG8_LDA(dst, b, h) do { _Pragma("unroll") for (int m = 0; m < 4; ++m) dst[m] = cat8(*(const PG8_LAS bf16x8*)(lds + PG8_SA(b, h) + aoff + m * 2048), *(const PG8_LAS bf16x8*)(lds + PG8_SA(b, h) + aoff + m * 2048 + 1024)); } while (0)
#define PG8_LDB(dst, b, h) do { _Pragma("unroll") for (int n = 0; n < 2; ++n) dst[n] = cat8(*(const PG8_LAS bf16x8*)(lds + PG8_SB(b, h) + boff + n * 2048), *(const PG8_LAS bf16x8*)(lds + PG8_SB(b, h) + boff + n * 2048 + 1024)); } while (0)
#define PG8_MMA(ai, bj, At, Bt) do { __builtin_amdgcn_s_setprio(1); _Pragma("unroll") for (int m = 0; m < 4; ++m) _Pragma("unroll") for (int n = 0; n < 2; ++n) { \
        if constexpr (F8) mfma8(acc[ai][bj][m][n], Bt[n], At[m], wsc, 0x7F7F7F7F); \
        else { acc[ai][bj][m][n] = __builtin_amdgcn_mfma_f32_16x16x32_bf16(lo8(Bt[n]), lo8(At[m]), acc[ai][bj][m][n], 0, 0, 0); \
               acc[ai][bj][m][n] = __builtin_amdgcn_mfma_f32_16x16x32_bf16(hi8(Bt[n]), hi8(At[m]), acc[ai][bj][m][n], 0, 0, 0); } } __builtin_amdgcn_s_setprio(0); } while (0)
#define PG8_WAIT_V(n) asm volatile("s_waitcnt vmcnt(" #n ")" ::: "memory")
#define PG8_WAIT_L(n) asm volatile("s_waitcnt lgkmcnt(" #n ")" ::: "memory")
#define PG8_BAR __builtin_amdgcn_s_barrier()
#define PG8_SCHED __builtin_amdgcn_sched_barrier(0)
    Unit cur, nxt; int ui = 0;
    if (!S.next(0, cur)) return;
    f32x4 acc[2][2][4][2];
#pragma unroll
    for (int a = 0; a < 2; ++a)
#pragma unroll
        for (int b = 0; b < 2; ++b)
#pragma unroll
            for (int m = 0; m < 4; ++m)
#pragma unroll
                for (int n = 0; n < 2; ++n) acc[a][b][m][n] = (f32x4){0.f, 0.f, 0.f, 0.f};
    v8i At[4], B0[2], B1[2];
    const char* cA = (const char*)g.A + (size_t)cur.pm * tstep; const char* cB = (const char*)g.Bt + S.boff(cur) * 2 + (size_t)cur.pn * tstep;
    S.a_ready(cur);
    if constexpr (SP2) {
        PG8_STAGE(PG8_SB(0, 0), cB, voffB); PG8_STAGE(PG8_SB(0, 1), cB + hstep, voffB); PG8_STAGE(PG8_SA(0, 0), cA, voffA); PG8_STAGE(PG8_SA(0, 1), cA + hstep, voffA);
        if (wr == 1) PG8_BAR;
        PG8_WAIT_V(2); PG8_BAR;
        PG8_STAGE(PG8_SB(1, 0), cB + kstep, voffB); PG8_STAGE(PG8_SA(1, 0), cA + kstep, voffA); PG8_STAGE(PG8_SB(1, 1), cB + hstep + kstep, voffB);
        PG8_WAIT_V(6); PG8_BAR;
    } else {
        PG8_STAGE(PG8_SB(0, 0), cB, voffB); PG8_STAGE(PG8_SA(0, 0), cA, voffA); PG8_STAGE(PG8_SB(0, 1), cB + hstep, voffB); PG8_STAGE(PG8_SA(0, 1), cA + hstep, voffA);
        if (wr == 1) PG8_BAR;
        PG8_WAIT_V(4); PG8_BAR;
        PG8_STAGE(PG8_SB(1, 0), cB + kstep, voffB); PG8_STAGE(PG8_SA(1, 0), cA + kstep, voffA); PG8_STAGE(PG8_SB(1, 1), cB + hstep + kstep, voffB);
        PG8_WAIT_V(6); PG8_BAR;
    }
    for (;;) {
        const bool has_next = S.next(ui + 1, nxt);
        const char* nA = has_next ? (const char*)g.A + (size_t)nxt.pm * tstep : cA; const char* nB = has_next ? (const char*)g.Bt + S.boff(nxt) * 2 + (size_t)nxt.pn * tstep : cB;
#pragma unroll 1
        for (int t = 0; t < nt; t += 2) {
            const bool last = (t == nt - 2);
            const char* a1 = cA + (size_t)(t + 1) * kstep;
            const char* a2 = last ? nA : cA + (size_t)(t + 2) * kstep; const char* b2 = last ? nB : cB + (size_t)(t + 2) * kstep;
            const char* a3 = a2 + kstep; const char* b3 = b2 + kstep;
            if (last && has_next) S.a_ready(nxt);
            if constexpr (SP2) {
            PG8_LDB(B0, 0, 0); PG8_LDB(B1, 0, 1); PG8_SCHED; PG8_LDA(At, 0, 0); PG8_STAGE(PG8_SA(1, 1), a1 + hstep, voffA);
            PG8_WAIT_V(8); PG8_WAIT_L(0); PG8_BAR; PG8_MMA(0, 0, At, B0); PG8_MMA(0, 1, At, B1); PG8_BAR; PG8_SCHED;
            PG8_LDA(At, 0, 1); PG8_STAGE(PG8_SB(0, 0), b2, voffB); PG8_STAGE(PG8_SB(0, 1), b2 + hstep, voffB); PG8_STAGE(PG8_SA(0, 0), a2, voffA);
            PG8_WAIT_V(8); PG8_WAIT_L(0); PG8_BAR; PG8_MMA(1, 0, At, B0); PG8_MMA(1, 1, At, B1); PG8_BAR; PG8_SCHED;
            PG8_LDB(B0, 1, 0); PG8_LDB(B1, 1, 1); PG8_SCHED; PG8_LDA(At, 1, 0); PG8_STAGE(PG8_SA(0, 1), a2 + hstep, voffA);
            PG8_WAIT_V(8); PG8_WAIT_L(0); PG8_BAR; PG8_MMA(0, 0, At, B0); PG8_MMA(0, 1, At, B1); PG8_BAR; PG8_SCHED;
            PG8_LDA(At, 1, 1); PG8_STAGE(PG8_SB(1, 0), b3, voffB); PG8_STAGE(PG8_SB(1, 1), b3 + hstep, voffB); PG8_STAGE(PG8_SA(1, 0), a3, voffA);
            PG8_WAIT_V(8); PG8_WAIT_L(0); PG8_BAR; PG8_MMA(1, 0, At, B0); PG8_MMA(1, 1, At, B1); PG8_BAR; PG8_SCHED;
            } else {
            PG8_LDB(B0, 0, 0); PG8_SCHED; PG8_LDA(At, 0, 0); PG8_STAGE(PG8_SA(1, 1), a1 + hstep, voffA);
            PG8_WAIT_L(8); PG8_BAR; PG8_WAIT_L(0); PG8_MMA(0, 0, At, B0); PG8_BAR; PG8_SCHED;
            PG8_LDB(B1, 0, 1); PG8_STAGE(PG8_SB(0, 0), b2, voffB);
            PG8_BAR; PG8_WAIT_L(0); PG8_MMA(0, 1, At, B1); PG8_BAR;
            PG8_LDA(At, 0, 1); PG8_STAGE(PG8_SA(0, 0), a2, voffA);
            PG8_BAR; PG8_WAIT_L(0); PG8_MMA(1, 0, At, B0); PG8_BAR; PG8_SCHED;
            PG8_STAGE(PG8_SB(0, 1), b2 + hstep, voffB);
            PG8_WAIT_V(6); PG8_BAR; PG8_MMA(1, 1, At, B1); PG8_BAR;
            PG8_LDB(B0, 1, 0); PG8_SCHED; PG8_LDA(At, 1, 0); PG8_STAGE(PG8_SA(0, 1), a2 + hstep, voffA);
            PG8_WAIT_L(8); PG8_BAR; PG8_WAIT_L(0); PG8_MMA(0, 0, At, B0); PG8_BAR; PG8_SCHED;
            PG8_LDB(B1, 1, 1); PG8_STAGE(PG8_SB(1, 0), b3, voffB);
            PG8_BAR; PG8_WAIT_L(0); PG8_MMA(0, 1, At, B1); PG8_BAR;
            PG8_LDA(At, 1, 1); PG8_STAGE(PG8_SA(1, 0), a3, voffA);
            PG8_BAR; PG8_WAIT_L(0); PG8_MMA(1, 0, At, B0); PG8_BAR; PG8_SCHED;
            PG8_STAGE(PG8_SB(1, 1), b3 + hstep, voffB);
            PG8_WAIT_V(6); PG8_BAR; PG8_MMA(1, 1, At, B1); PG8_BAR;
            }
        }
        if constexpr (F8) asm volatile("s_nop 15\n\ts_nop 15" ::: "memory");
        if constexpr (ALIGN_EPI) { if (wr == 0) PG8_BAR; }
        if constexpr (!Epi::AFTER_DRAIN) { E(acc, cur, wr, wc, fr, fq); S.done(cur); }
        if (!has_next) break;
#pragma unroll
        for (int a = 0; a < 2; ++a)
#pragma unroll
            for (int b = 0; b < 2; ++b)
#pragma unroll
                for (int m = 0; m < 4; ++m)
#pragma unroll
                    for (int n = 0; n < 2; ++n) acc[a][b][m][n] = (f32x4){0.f, 0.f, 0.f, 0.f};
        cur = nxt; cA = nA; cB = nB; ++ui;
        if constexpr (ALIGN_EPI) { if (wr == 1) PG8_BAR; }
    }
    PG8_WAIT_V(0);
    if constexpr (!ALIGN_EPI) { if (wr == 0) PG8_BAR; }
    PG8_BAR;
    if constexpr (Epi::AFTER_DRAIN) { E.fused(acc, cur, wr, wc, fr, fq, lds, wid, lane); S.done(cur); }
#undef PG8_SA
#undef PG8_SB
#undef PG8_STAGE
#undef PG8_LDA
#undef PG8_LDB
#undef PG8_MMA
#undef PG8_WAIT_V
#undef PG8_WAIT_L
#undef PG8_BAR
#undef PG8_SCHED
}
}


struct Args { const float* in[21]; float* out; unsigned char* ws; int lo, hi; };
enum { I_X = 0, I_MEM, I_WMEMKV, I_AWIN, I_ACONV, I_AWOUT, I_BWIN, I_BWOUT, I_CWIN, I_CPOOLW, I_CPOOLS, I_CWOUT, I_LNG, I_LNB,
       I_FG, I_FU, I_FD, I_ROUTER, I_MG, I_MU, I_MD };
struct Frame { LAS unsigned char* lds; int tid, lane, wave, gw; };

template <int NWM, class Epi>
__device__ __forceinline__ void naive_gemm(const Frame& F, const bf16* A, int lda, const float* W0, const float* W1, int ldw, int M, int N, int K, const Epi& epi, const int* tile_e, size_t wstride) {
    const int lane = F.lane, r16 = lane & 15, q4 = lane >> 4;
    const int tn = N / 32, ntiles = (M / 32) * tn;
    for (int tile = F.gw; tile < ntiles; tile += NGW) {
        const int m0 = (tile / tn) * 32, n0 = (tile % tn) * 32;
        size_t woff = 0;
        if (tile_e) woff = (size_t)ld_i32_agent(tile_e + (m0 >> 8)) * wstride;
        const float* w0 = W0 + woff; const float* w1 = (NWM == 2) ? W1 + woff : nullptr;
        f32x4 acc[NWM][2][2];
#pragma unroll
        for (int w = 0; w < NWM; ++w)
#pragma unroll
            for (int i = 0; i < 2; ++i)
#pragma unroll
                for (int j = 0; j < 2; ++j) acc[w][i][j] = (f32x4){0.f, 0.f, 0.f, 0.f};
        for (int k0 = 0; k0 < K; k0 += 32) {
            bf16x8 a[2], b[NWM][2];
#pragma unroll
            for (int i = 0; i < 2; ++i) a[i] = *(const bf16x8*)(A + (size_t)(m0 + 16 * i + r16) * lda + k0 + 8 * q4);
#pragma unroll
            for (int w = 0; w < NWM; ++w)
#pragma unroll
                for (int jn = 0; jn < 2; ++jn) {
                    const float* wp = (w == 0 ? w0 : w1) + (size_t)(k0 + 8 * q4) * ldw + n0 + 16 * jn + r16;
#pragma unroll
                    for (int j = 0; j < 8; ++j) b[w][jn][j] = (short)f2bf(wp[(size_t)j * ldw]);
                }
#pragma unroll
            for (int w = 0; w < NWM; ++w)
#pragma unroll
                for (int i = 0; i < 2; ++i)
#pragma unroll
                    for (int jn = 0; jn < 2; ++jn) acc[w][i][jn] = __builtin_amdgcn_mfma_f32_16x16x32_bf16(a[i], b[w][jn], acc[w][i][jn], 0, 0, 0);
        }
#pragma unroll
        for (int i = 0; i < 2; ++i)
#pragma unroll
            for (int jn = 0; jn < 2; ++jn)
#pragma unroll
                for (int r = 0; r < 4; ++r) {
                    const int row = m0 + 16 * i + q4 * 4 + r, col = n0 + 16 * jn + r16;
                    if constexpr (NWM == 2) epi(row, col, acc[0][i][jn][r], acc[1][i][jn][r]); else epi(row, col, acc[0][i][jn][r], 0.f);
                }
    }
}
struct NEpiBf16 { bf16* O; int ldo; __device__ __forceinline__ void operator()(int r, int c, float v, float) const { O[(size_t)r * ldo + c] = (bf16)f2bf(v); } };
struct NEpiResid { const float* basef; const bf16* baseb; bf16* out; __device__ __forceinline__ void operator()(int r, int c, float v, float) const { const size_t o = (size_t)r * D + c; out[o] = (bf16)f2bf(ALPHA * (basef ? basef[o] : bf2f(baseb[o])) + v); } };
struct NEpiSwiglu { bf16* O; int ldo; __device__ __forceinline__ void operator()(int r, int c, float g, float u) const { const float s = g / (1.f + __expf(-g)); O[(size_t)r * ldo + c] = (bf16)f2bf(s * u); } };
struct NEpiScale { bf16* O; int ldo; int coff; const float* scale; __device__ __forceinline__ void operator()(int r, int c, float v, float) const { O[(size_t)r * ldo + coff + c] = (bf16)f2bf(v * scale[coff + c]); } };

__device__ __forceinline__ void prep_phase(const Frame& F, const float* x, const float* mem, bf16* XB, bf16* MEMB) {
    const size_t gt = (size_t)blockIdx.x * NTHREADS + F.tid, NT = (size_t)GRID * NTHREADS;
    for (size_t i = gt; i < (size_t)T * D / 8; i += NT) { const f32x4 a = ((const f32x4*)x)[2 * i], b = ((const f32x4*)x)[2 * i + 1];
        v4u o; o.x = pk2(a.x, a.y); o.y = pk2(a.z, a.w); o.z = pk2(b.x, b.y); o.w = pk2(b.z, b.w); ((v4u*)XB)[i] = o; }
    for (size_t i = gt; i < (size_t)NB * ML * D / 8; i += NT) { const f32x4 a = ((const f32x4*)mem)[2 * i], b = ((const f32x4*)mem)[2 * i + 1];
        v4u o; o.x = pk2(a.x, a.y); o.y = pk2(a.z, a.w); o.z = pk2(b.x, b.y); o.w = pk2(b.z, b.w); ((v4u*)MEMB)[i] = o; }
}
__device__ __forceinline__ void unpack8(const v4u w, float (&f)[8]) { f[0] = bflo(w.x); f[1] = bfhi(w.x); f[2] = bflo(w.y); f[3] = bfhi(w.y); f[4] = bflo(w.z); f[5] = bfhi(w.z); f[6] = bflo(w.w); f[7] = bfhi(w.w); }
__device__ __forceinline__ v4u pack8(const float (&f)[8]) { v4u o; o.x = pk2(f[0], f[1]); o.y = pk2(f[2], f[3]); o.z = pk2(f[4], f[5]); o.w = pk2(f[6], f[7]); return o; }

__device__ __forceinline__ void mixA_phase(const Frame& F, const bf16* __restrict__ H, const float* __restrict__ convw, bf16* __restrict__ CAT) {
    const size_t gt = (size_t)blockIdx.x * NTHREADS + F.tid, NT = (size_t)GRID * NTHREADS;
    for (size_t it = gt; it < (size_t)(T / 4) * 96; it += NT) {
        const int t0 = (int)(it / 96) * 4, c8 = (int)(it % 96) * 8, s0 = t0 & (SEQ - 1);
        const bf16* hr = H + (size_t)t0 * 2560 + c8;
        v4u gcw[6], uw[6], gbw[4];
#pragma unroll
        for (int j = 0; j < 6; ++j) { const int sj = s0 - 1 + j; const bool ok = (sj >= 0) && (sj < SEQ);
            gcw[j] = ok ? *(const v4u*)(hr + (ptrdiff_t)(j - 1) * 2560 + 768) : (v4u){0u, 0u, 0u, 0u}; uw[j] = ok ? *(const v4u*)(hr + (ptrdiff_t)(j - 1) * 2560 + 1536) : (v4u){0u, 0u, 0u, 0u}; }
#pragma unroll
        for (int i = 0; i < 4; ++i) gbw[i] = *(const v4u*)(hr + (size_t)i * 2560);
        float w0[8], w1[8], w2[8];
#pragma unroll
        for (int i = 0; i < 8; ++i) { w0[i] = convw[c8 + i]; w1[i] = convw[768 + c8 + i]; w2[i] = convw[1536 + c8 + i]; }
        float z[6][8];
#pragma unroll
        for (int j = 0; j < 6; ++j) { float a[8], b[8]; unpack8(gcw[j], a); unpack8(uw[j], b);
#pragma unroll
            for (int i = 0; i < 8; ++i) z[j][i] = a[i] * b[i]; }
#pragma unroll
        for (int q = 0; q < 4; ++q) { float gb[8], o[8]; unpack8(gbw[q], gb);
#pragma unroll
            for (int i = 0; i < 8; ++i) o[i] = gb[i] * (w0[i] * z[q][i] + w1[i] * z[q + 1][i] + w2[i] * z[q + 2][i]);
            *(v4u*)(CAT + (size_t)(t0 + q) * 1024 + c8) = pack8(o); }
    }
}
template <int W>
__device__ __forceinline__ void poolC_group(const Frame& F, const bf16* __restrict__ H, bf16* __restrict__ OUT, int ldo, int g) {
    const size_t gt = (size_t)blockIdx.x * NTHREADS + F.tid, NT = (size_t)GRID * NTHREADS;
    for (size_t it = gt; it < (size_t)(T / 2) * 24; it += NT) {
        const int t0 = (int)(it / 24) * 2, c8 = (g * 24 + (int)(it % 24)) * 8, s0 = t0 & (SEQ - 1);
        const bf16* base = H + (size_t)(t0 - s0) * 1024 + c8;
        v4u rw[W + 1];
#pragma unroll
        for (int j = 0; j <= W; ++j) { const int sj = s0 - W / 2 + j; rw[j] = (sj >= 0 && sj < SEQ) ? *(const v4u*)(base + (size_t)sj * 1024) : (v4u){0u, 0u, 0u, 0u}; }
        float a0[8], a1[8];
#pragma unroll
        for (int i = 0; i < 8; ++i) { a0[i] = 0.f; a1[i] = 0.f; }
#pragma unroll
        for (int j = 0; j <= W; ++j) { float v[8]; unpack8(rw[j], v);
#pragma unroll
            for (int i = 0; i < 8; ++i) { if (j < W) a0[i] += v[i]; if (j >= 1) a1[i] += v[i]; } }
#pragma unroll
        for (int q = 0; q < 2; ++q) { const int s = s0 + q; int lo = s - W / 2; lo = lo < 0 ? 0 : lo; int hi = s + W / 2 - 1; hi = hi > SEQ - 1 ? SEQ - 1 : hi;
            const float inv = 1.f / (float)(hi - lo + 1); float u[8], o[8]; unpack8(rw[W / 2 + q], u);
#pragma unroll
            for (int i = 0; i < 8; ++i) o[i] = (q == 0 ? a0[i] : a1[i]) * inv - u[i];
            *(v4u*)(OUT + (size_t)(t0 + q) * ldo + c8) = pack8(o); }
    }
}
__device__ __forceinline__ void poolC_phase(const Frame& F, const bf16* H, bf16* OUT, int ldo) {
    poolC_group<2>(F, H, OUT, ldo, 0); poolC_group<4>(F, H, OUT, ldo, 1); poolC_group<8>(F, H, OUT, ldo, 2); poolC_group<16>(F, H, OUT, ldo, 3);
}

__device__ __forceinline__ void tr_item(const float* W, int N, int k0, int n0, bf16* WT, int ldk, int drow0, LAS float* scr, int lane, float qs = 0.f) {
    float v[32];
    const float* wp = W + (size_t)(k0 + (lane >> 5)) * N + n0 + (lane & 31);
#pragma unroll
    for (int i = 0; i < 32; ++i) v[i] = wp[(size_t)(2 * i) * N];
#pragma unroll
    for (int i = 0; i < 32; ++i) scr[(2 * i + (lane >> 5)) * 33 + (lane & 31)] = (qs != 0.f) ? q8(v[i] * qs) / qs : v[i];
    LDS_WAIT(); asm volatile("" ::: "memory");
    const int c = lane & 7;
#pragma unroll
    for (int j = 0; j < 4; ++j) { const int n = (lane >> 3) + 8 * j; const LAS float* sp = scr + (8 * c) * 33 + n;
        v4u o; o.x = pk2(sp[0 * 33], sp[1 * 33]); o.y = pk2(sp[2 * 33], sp[3 * 33]); o.z = pk2(sp[4 * 33], sp[5 * 33]); o.w = pk2(sp[6 * 33], sp[7 * 33]);
        *(v4u*)(WT + (size_t)(drow0 + n) * ldk + k0 + 8 * c) = o; }
    LDS_WAIT(); asm volatile("" ::: "memory");
}
template <int MODE>
__device__ __forceinline__ void tr_matrix(const Frame& F, const float* W, int K, int N, bf16* WT, int ldk, int& rot, float qs = 0.f) {
    LAS float* scr = (LAS float*)(F.lds + F.wave * 16384);
    const int nblk = N / 32, nitems = (K / 64) * nblk;
    for (int it = (F.gw + NGW - (rot % NGW)) % NGW; it < nitems; it += NGW) {
        const int k0 = (it / nblk) * 64, n0 = (it % nblk) * 32;
        const int drow0 = MODE == 0 ? n0 : ((n0 >> 7) * 256 + (n0 & 127) + (MODE == 2 ? 128 : 0));
        tr_item(W, N, k0, n0, WT, ldk, drow0, scr, F.lane, qs);
    }
    rot += nitems;
}
__device__ __forceinline__ void convert_moe(const Frame& F, const float* wg, const float* wu, const float* wd, bf16* WMOE, int& rot) {
#pragma unroll 1
    for (int e = 0; e < NE; ++e) {
        tr_matrix<1>(F, wg + (size_t)e * D * FFE, D, FFE, WMOE + OFF_MGU + (size_t)e * 2 * FFE * D, D, rot, EMU_FP8 ? 32.f : 0.f);
        tr_matrix<2>(F, wu + (size_t)e * D * FFE, D, FFE, WMOE + OFF_MGU + (size_t)e * 2 * FFE * D, D, rot, EMU_FP8 ? 32.f : 0.f);
        tr_matrix<0>(F, wd + (size_t)e * FFE * D, FFE, D, WMOE + OFF_MD + (size_t)e * D * FFE, FFE, rot, EMU_FP8 ? 128.f : 0.f);
    }
}

__device__ __forceinline__ void tr_item8(const float* W, int N, int k0, int n0, unsigned char* WT, int ldk, int drow0, LAS float* scr, int lane, float qs) {
    float v[32];
    const float* wp = W + (size_t)(k0 + (lane >> 5)) * N + n0 + (lane & 31);
#pragma unroll
    for (int i = 0; i < 32; ++i) v[i] = wp[(size_t)(2 * i) * N];
#pragma unroll
    for (int i = 0; i < 32; ++i) scr[(2 * i + (lane >> 5)) * 33 + (lane & 31)] = v[i] * qs;
    LDS_WAIT(); asm volatile("" ::: "memory");
    const int c = lane & 7;
#pragma unroll
    for (int j = 0; j < 4; ++j) { const int n = (lane >> 3) + 8 * j; const LAS float* sp = scr + (8 * c) * 33 + n;
        int p0 = 0, p1 = 0;
        p0 = __builtin_amdgcn_cvt_pk_fp8_f32(sp[0 * 33], sp[1 * 33], p0, false); p0 = __builtin_amdgcn_cvt_pk_fp8_f32(sp[2 * 33], sp[3 * 33], p0, true);
        p1 = __builtin_amdgcn_cvt_pk_fp8_f32(sp[4 * 33], sp[5 * 33], p1, false); p1 = __builtin_amdgcn_cvt_pk_fp8_f32(sp[6 * 33], sp[7 * 33], p1, true);
        v2u o; o.x = (unsigned)p0; o.y = (unsigned)p1;
        *(v2u*)(WT + (size_t)(drow0 + n) * ldk + k0 + 8 * c) = o; }
    LDS_WAIT(); asm volatile("" ::: "memory");
}
template <int MODE>
__device__ __forceinline__ void tr_matrix8(const Frame& F, const float* W, int K, int N, unsigned char* WT, int ldk, int& rot, float qs) {
    LAS float* scr = (LAS float*)(F.lds + F.wave * 16384);
    const int nblk = N / 32, nitems = (K / 64) * nblk;
    for (int it = (F.gw + NGW - (rot % NGW)) % NGW; it < nitems; it += NGW) {
        const int k0 = (it / nblk) * 64, n0 = (it % nblk) * 32;
        const int drow0 = MODE == 0 ? n0 : ((n0 >> 7) * 256 + (n0 & 127) + (MODE == 2 ? 128 : 0));
        tr_item8(W, N, k0, n0, WT, ldk, drow0, scr, F.lane, qs);
    }
    rot += nitems;
}
constexpr float QS_GU = 32.f, QS_D = 128.f;
constexpr int WSC_GU = 0x7A7A7A7A, WSC_D = 0x78787878;
constexpr size_t OFF8_MGU = 0, OFF8_MD = (size_t)NE * 2 * FFE * D;
__device__ __forceinline__ void convert_moe8(const Frame& F, const float* wg, const float* wu, const float* wd, unsigned char* WMOE8, bf16* WMOE, int& rot) {
#pragma unroll 1
    for (int e = 0; e < NE; ++e) {
#if FP8_GU
        tr_matrix8<1>(F, wg + (size_t)e * D * FFE, D, FFE, WMOE8 + OFF8_MGU + (size_t)e * 2 * FFE * D, D, rot, QS_GU);
        tr_matrix8<2>(F, wu + (size_t)e * D * FFE, D, FFE, WMOE8 + OFF8_MGU + (size_t)e * 2 * FFE * D, D, rot, QS_GU);
#else
        tr_matrix<1>(F, wg + (size_t)e * D * FFE, D, FFE, WMOE + OFF_MGU + (size_t)e * 2 * FFE * D, D, rot);
        tr_matrix<2>(F, wu + (size_t)e * D * FFE, D, FFE, WMOE + OFF_MGU + (size_t)e * 2 * FFE * D, D, rot);
#endif
#if FP8_D
        tr_matrix8<0>(F, wd + (size_t)e * FFE * D, FFE, D, WMOE8 + (FP8_GU ? OFF8_MD : 2 * OFF_MD) + (size_t)e * D * FFE, FFE, rot, QS_D);
#else
        tr_matrix<0>(F, wd + (size_t)e * FFE * D, FFE, D, WMOE + OFF_MD + (size_t)e * D * FFE, FFE, rot);
#endif
    }
}
__device__ __forceinline__ void fold_pool(const Frame& F, const float* pw, const float* ps, const float* wout, bf16* WT) {
    const int item = blockIdx.x * NTHREADS + F.tid;
    if (item < 1024 * 96) {
        const int n = item & 1023, kc = item >> 10, g = kc / 24, c0 = kc * 8 - g * 192;
        float acc[8];
#pragma unroll
        for (int i = 0; i < 8; ++i) acc[i] = 0.f;
        const float* P = pw + (size_t)g * 192 * 192 + (size_t)c0 * 192;
        for (int d = 0; d < 192; ++d) { const float w = wout[(size_t)(g * 192 + d) * D + n] * ps[g * 192 + d];
#pragma unroll
            for (int i = 0; i < 8; ++i) acc[i] += P[i * 192 + d] * w; }
        *(v4u*)(WT + (size_t)n * D + kc * 8) = pack8(acc);
    }
}
__device__ __forceinline__ void convert_small(const Frame& F, const Args& a, bf16* WSM, int& rot) {
    tr_matrix<0>(F, a.in[I_WMEMKV], D, 512, WSM + OFF_WKV, D, rot);
    tr_matrix<0>(F, a.in[I_AWIN], D, 2560, WSM + OFF_AIN, D, rot);
    tr_matrix<0>(F, a.in[I_AWIN] + (size_t)D * 2560, D, 2560, WSM + OFF_AIN + (size_t)2560 * D, D, rot);
    tr_matrix<0>(F, a.in[I_AWOUT], D, D, WSM + OFF_AOUT, D, rot);
    tr_matrix<0>(F, a.in[I_AWOUT] + (size_t)D * D, D, D, WSM + OFF_AOUT + (size_t)D * D, D, rot);
    tr_matrix<0>(F, a.in[I_BWIN], D, 2560, WSM + OFF_BIN, D, rot);
    tr_matrix<0>(F, a.in[I_BWOUT], 512, D, WSM + OFF_BOUT, 512, rot);
    tr_matrix<0>(F, a.in[I_CWIN], D, D, WSM + OFF_CIN, D, rot);
    tr_matrix<0>(F, a.in[I_CWOUT] + (size_t)768 * D, 256, D, WSM + OFF_COUT + 768, D, rot);
#pragma unroll 1
    for (int f = 0; f < 2; ++f) {
        tr_matrix<1>(F, a.in[I_FG] + (size_t)f * D * FF, D, FF, WSM + OFF_FGU + (size_t)f * 2 * FF * D, D, rot, EMU_FP8 == 2 ? 32.f : 0.f);
        tr_matrix<2>(F, a.in[I_FU] + (size_t)f * D * FF, D, FF, WSM + OFF_FGU + (size_t)f * 2 * FF * D, D, rot, EMU_FP8 == 2 ? 32.f : 0.f);
        tr_matrix<0>(F, a.in[I_FD] + (size_t)f * FF * D, FF, D, WSM + OFF_FD + (size_t)f * D * FF, FF, rot, EMU_FP8 == 2 ? 64.f : 0.f);
    }
}

template <bool ROUTER, bool COMBINE, bool FINAL>
__device__ __forceinline__ void ln_phase(const Frame& F, const bf16* XBi, bf16* XBo, float* OUTF, const float* g, const float* b, const float* router, int* E01, float* W01, const int* DEST, const bf16* YB, int* cntWG) {
    LAS int* cntL = (LAS int*)F.lds;
    if (ROUTER) { if (F.tid < 8) cntL[F.tid] = 0; __syncthreads(); }
    float gv[16], bv[16];
#pragma unroll
    for (int h = 0; h < 2; ++h)
#pragma unroll
        for (int q = 0; q < 2; ++q) { const f32x4 a = *(const f32x4*)(g + 512 * h + 8 * F.lane + 4 * q), c = *(const f32x4*)(b + 512 * h + 8 * F.lane + 4 * q);
#pragma unroll
            for (int i = 0; i < 4; ++i) { gv[8 * h + 4 * q + i] = a[i]; bv[8 * h + 4 * q + i] = c[i]; } }
    for (int i = 0; i < 16; ++i) {
        const int t = blockIdx.x * 128 + F.wave * 16 + i;
        const v4u* xi = (const v4u*)(XBi + (size_t)t * D) + F.lane;
        float v[16];
        { float f[8]; unpack8(xi[0], f);
#pragma unroll
          for (int q = 0; q < 8; ++q) v[q] = f[q];
          unpack8(xi[64], f);
#pragma unroll
          for (int q = 0; q < 8; ++q) v[8 + q] = f[q]; }
        if (COMBINE) {
            const int d0 = ld_i32_agent(DEST + 2 * t), d1 = ld_i32_agent(DEST + 2 * t + 1);
            const float w0 = ld_f32_agent(W01 + 2 * t), w1 = ld_f32_agent(W01 + 2 * t + 1);
            const v4u* y0 = (const v4u*)(YB + (size_t)d0 * D) + F.lane; const v4u* y1 = (const v4u*)(YB + (size_t)d1 * D) + F.lane;
#pragma unroll
            for (int h = 0; h < 2; ++h) { float f0[8], f1[8]; unpack8(y0[64 * h], f0); unpack8(y1[64 * h], f1);
#pragma unroll
                for (int q = 0; q < 8; ++q) v[8 * h + q] = ALPHA * v[8 * h + q] + w0 * f0[q] + w1 * f1[q]; }
        }
        float s = 0.f;
#pragma unroll
        for (int q = 0; q < 16; ++q) s += v[q];
        const float mean = wave_sum(s) * (1.f / D); float s2 = 0.f;
#pragma unroll
        for (int q = 0; q < 16; ++q) { v[q] -= mean; s2 += v[q] * v[q]; }
        const float rstd = 1.f / sqrtf(wave_sum(s2) * (1.f / D) + LN_EPS);
#pragma unroll
        for (int q = 0; q < 16; ++q) v[q] = v[q] * rstd * gv[q] + bv[q];
        if (FINAL) {
            float* o = OUTF + (size_t)t * D + 8 * F.lane;
#pragma unroll
            for (int h = 0; h < 2; ++h)
#pragma unroll
                for (int q = 0; q < 2; ++q) *(f32x4*)(o + 512 * h + 4 * q) = (f32x4){v[8 * h + 4 * q], v[8 * h + 4 * q + 1], v[8 * h + 4 * q + 2], v[8 * h + 4 * q + 3]};
        } else {
            v4u* xo = (v4u*)(XBo + (size_t)t * D) + F.lane;
            { float f[8];
#pragma unroll
              for (int q = 0; q < 8; ++q) f[q] = v[q];
              xo[0] = pack8(f);
#pragma unroll
              for (int q = 0; q < 8; ++q) f[q] = v[8 + q];
              xo[64] = pack8(f); }
        }
        if (ROUTER) {
            float lg[8];
#pragma unroll
            for (int e = 0; e < 8; ++e) lg[e] = 0.f;
#pragma unroll
            for (int q = 0; q < 16; ++q) { const int c = 512 * (q >> 3) + 8 * F.lane + (q & 7); const f32x4 r0 = ((const f32x4*)router)[2 * c], r1 = ((const f32x4*)router)[2 * c + 1]; const float xv = v[q];
                lg[0] += xv * r0.x; lg[1] += xv * r0.y; lg[2] += xv * r0.z; lg[3] += xv * r0.w; lg[4] += xv * r1.x; lg[5] += xv * r1.y; lg[6] += xv * r1.z; lg[7] += xv * r1.w; }
#pragma unroll
            for (int e = 0; e < 8; ++e) lg[e] = wave_sum(lg[e]);
            float b0 = lg[0]; int i0 = 0;
#pragma unroll
            for (int e = 1; e < 8; ++e) if (lg[e] > b0) { b0 = lg[e]; i0 = e; }
            float b1 = -3.0e38f; int i1 = 0;
#pragma unroll
            for (int e = 0; e < 8; ++e) if (e != i0 && lg[e] > b1) { b1 = lg[e]; i1 = e; }
            const float w0 = 1.f / (1.f + __expf(b1 - b0));
            if (F.lane == 0) { E01[2 * t] = i0; E01[2 * t + 1] = i1; W01[2 * t] = w0; W01[2 * t + 1] = 1.f - w0; __hip_atomic_fetch_add(&cntL[i0], 1, __ATOMIC_RELAXED, __HIP_MEMORY_SCOPE_WORKGROUP); __hip_atomic_fetch_add(&cntL[i1], 1, __ATOMIC_RELAXED, __HIP_MEMORY_SCOPE_WORKGROUP); }
        }
    }
    if (ROUTER) { __syncthreads(); if (F.tid < 8) cntWG[blockIdx.x * 8 + F.tid] = cntL[F.tid]; }
}
__device__ __forceinline__ void scatter_phase(const Frame& F, const int* cntWG, const int* E01, int* DEST, const bf16* XB, bf16* XS, int* tile_e, int* nMp) {
    LAS int* L = (LAS int*)F.lds;
    if (F.tid < 8) { int tot = 0, base = 0; for (int w = 0; w < GRID; ++w) { const int c = ld_i32_agent(cntWG + w * 8 + F.tid); if (w < (int)blockIdx.x) base += c; tot += c; } L[F.tid] = base; L[8 + F.tid] = tot; }
    __syncthreads();
    if (F.tid == 0) { int ps = 0; for (int e = 0; e < 8; ++e) { L[16 + e] = ps; ps += (L[8 + e] + 255) / 256 * 256; } L[24] = ps; }
    __syncthreads();
    if (F.wave == 0) {
        const int tA = blockIdx.x * 128 + F.lane, tB = tA + 64;
        const int eA0 = ld_i32_agent(E01 + 2 * tA), eA1 = ld_i32_agent(E01 + 2 * tA + 1), eB0 = ld_i32_agent(E01 + 2 * tB), eB1 = ld_i32_agent(E01 + 2 * tB + 1);
        const unsigned long long lt = (1ull << F.lane) - 1ull;
        int dA0 = 0, dA1 = 0, dB0 = 0, dB1 = 0;
        for (int e = 0; e < 8; ++e) {
            const unsigned long long mA0 = __ballot(eA0 == e), mA1 = __ballot(eA1 == e), mB0 = __ballot(eB0 == e), mB1 = __ballot(eB1 == e);
            const int start = L[16 + e] + L[e];
            const int cA = __popcll(mA0 & lt) + __popcll(mA1 & lt), totA = __popcll(mA0) + __popcll(mA1), cB = totA + __popcll(mB0 & lt) + __popcll(mB1 & lt);
            if (eA0 == e) dA0 = start + cA; if (eA1 == e) dA1 = start + cA;
            if (eB0 == e) dB0 = start + cB; if (eB1 == e) dB1 = start + cB;
        }
        DEST[2 * tA] = dA0; DEST[2 * tA + 1] = dA1; DEST[2 * tB] = dB0; DEST[2 * tB + 1] = dB1;
        L[32 + 2 * F.lane] = dA0; L[32 + 2 * F.lane + 1] = dA1; L[32 + 2 * (F.lane + 64)] = dB0; L[32 + 2 * (F.lane + 64) + 1] = dB1;
    }
    __syncthreads();
    for (int i = 0; i < 16; ++i) {
        const int tl = F.wave * 16 + i, t = blockIdx.x * 128 + tl;
        const v4u* src = (const v4u*)(XB + (size_t)t * D) + F.lane; v4u a = src[0], b = src[64];
#if EMU_FP8
        { float f[8]; unpack8(a, f);
#pragma unroll
          for (int q = 0; q < 8; ++q) f[q] = q8(f[q]);
          a = pack8(f); unpack8(b, f);
#pragma unroll
          for (int q = 0; q < 8; ++q) f[q] = q8(f[q]);
          b = pack8(f); }
#endif
#if FP8_GU
        v2u a8, b8;
        { float f[8]; int p0 = 0, p1 = 0; unpack8(a, f);
          p0 = __builtin_amdgcn_cvt_pk_fp8_f32(f[0], f[1], p0, false); p0 = __builtin_amdgcn_cvt_pk_fp8_f32(f[2], f[3], p0, true); p1 = __builtin_amdgcn_cvt_pk_fp8_f32(f[4], f[5], p1, false); p1 = __builtin_amdgcn_cvt_pk_fp8_f32(f[6], f[7], p1, true);
          a8.x = (unsigned)p0; a8.y = (unsigned)p1; p0 = 0; p1 = 0; unpack8(b, f);
          p0 = __builtin_amdgcn_cvt_pk_fp8_f32(f[0], f[1], p0, false); p0 = __builtin_amdgcn_cvt_pk_fp8_f32(f[2], f[3], p0, true); p1 = __builtin_amdgcn_cvt_pk_fp8_f32(f[4], f[5], p1, false); p1 = __builtin_amdgcn_cvt_pk_fp8_f32(f[6], f[7], p1, true);
          b8.x = (unsigned)p0; b8.y = (unsigned)p1; }
#pragma unroll
        for (int k = 0; k < 2; ++k) { v2u* dst = (v2u*)((unsigned char*)XS + (size_t)L[32 + 2 * tl + k] * D) + F.lane; dst[0] = a8; dst[64] = b8; }
#else
#pragma unroll
        for (int k = 0; k < 2; ++k) { v4u* dst = (v4u*)(XS + (size_t)L[32 + 2 * tl + k] * D) + F.lane; dst[0] = a; dst[64] = b; }
#endif
    }
    if (blockIdx.x == 0) {
        const int nM = L[24] / 256;
        for (int i = F.tid; i < nM; i += NTHREADS) { int e = 0;
#pragma unroll
            for (int q = 1; q < 8; ++q) if (i * 256 >= L[16 + q]) e = q;
            tile_e[i] = e; }
        if (F.tid == 0) *nMp = nM;
    }
    __syncthreads();
}

__device__ __forceinline__ void memattn_naive(const Frame& F, const bf16* H, int ldh, int qoff, const bf16* MEMKV, bf16* CAT, int ldc, int coff) {
    const size_t gt = (size_t)blockIdx.x * NTHREADS + F.tid, NT = (size_t)GRID * NTHREADS;
    for (size_t it = gt; it < (size_t)T * 4; it += NT) {
        const int t = (int)(it >> 2), h = (int)(it & 3), bb = t / SEQ;
        float q[64], o[64];
#pragma unroll
        for (int c = 0; c < 8; ++c) { float f[8]; unpack8(*(const v4u*)(H + (size_t)t * ldh + qoff + 64 * h + 8 * c), f);
#pragma unroll
            for (int i = 0; i < 8; ++i) { q[8 * c + i] = f[i] * 0.125f; o[8 * c + i] = 0.f; } }
        float m = -3.0e38f, l = 0.f;
        for (int k = 0; k < ML; ++k) {
            const bf16* kr = MEMKV + (size_t)(bb * ML + k) * 512 + 64 * h;
            float sc = 0.f;
#pragma unroll
            for (int c = 0; c < 8; ++c) { float f[8]; unpack8(*(const v4u*)(kr + 8 * c), f);
#pragma unroll
                for (int i = 0; i < 8; ++i) sc += q[8 * c + i] * f[i]; }
            const float mn = fmaxf(m, sc), al = __expf(m - mn), p = __expf(sc - mn);
            l = l * al + p; m = mn;
#pragma unroll
            for (int c = 0; c < 8; ++c) { float f[8]; unpack8(*(const v4u*)(kr + 256 + 8 * c), f);
#pragma unroll
                for (int i = 0; i < 8; ++i) o[8 * c + i] = o[8 * c + i] * al + p * f[i]; }
        }
        const float inv = 1.f / l;
#pragma unroll
        for (int c = 0; c < 8; ++c) { float f[8];
#pragma unroll
            for (int i = 0; i < 8; ++i) f[i] = o[8 * c + i] * inv;
            *(v4u*)(CAT + (size_t)t * ldc + coff + 64 * h + 8 * c) = pack8(f); }
    }
}
__device__ __forceinline__ void dilattn_naive(const Frame& F, const bf16* H, bf16* CAT, int ldc) {
    const size_t gt = (size_t)blockIdx.x * NTHREADS + F.tid, NT = (size_t)GRID * NTHREADS;
    for (size_t it = gt; it < (size_t)T * 4; it += NT) {
        const int t = (int)(it >> 2), h = (int)(it & 3), s = t & (SEQ - 1);
        float q[64], o[64];
#pragma unroll
        for (int i = 0; i < 64; ++i) o[i] = 0.f;
        float m = -3.0e38f, l = 0.f;
        for (int g = 0; g < 3; ++g) {
            const int dl = 1 << (2 * g), nsub = SEQ / dl, j = s / dl, r = s % dl;
            const float slope = exp2f(-8.f * (float)(4 * g + h + 1) / 12.f) * (float)dl;
#pragma unroll
            for (int c = 0; c < 8; ++c) { float f[8]; unpack8(*(const v4u*)(H + (size_t)t * 2560 + 256 * g + 64 * h + 8 * c), f);
#pragma unroll
                for (int i = 0; i < 8; ++i) q[8 * c + i] = f[i] * 0.125f; }
            const int jlo = j - 64 < 0 ? 0 : j - 64, jhi = j + 64 > nsub - 1 ? nsub - 1 : j + 64;
            for (int jj = jlo; jj <= jhi; ++jj) {
                const bf16* kr = H + (size_t)(t - s + jj * dl + r) * 2560 + 768 + 256 * g + 64 * h;
                float sc = 0.f;
#pragma unroll
                for (int c = 0; c < 8; ++c) { float f[8]; unpack8(*(const v4u*)(kr + 8 * c), f);
#pragma unroll
                    for (int i = 0; i < 8; ++i) sc += q[8 * c + i] * f[i]; }
                const int ad = jj > j ? jj - j : j - jj;
                sc -= slope * (float)ad;
                const float mn = fmaxf(m, sc), al = __expf(m - mn), p = __expf(sc - mn);
                l = l * al + p; m = mn;
#pragma unroll
                for (int c = 0; c < 8; ++c) { float f[8]; unpack8(*(const v4u*)(kr + 768 + 8 * c), f);
#pragma unroll
                    for (int i = 0; i < 8; ++i) o[8 * c + i] = o[8 * c + i] * al + p * f[i]; }
            }
        }
        const float inv = 1.f / l;
#pragma unroll
        for (int c = 0; c < 8; ++c) { float f[8];
#pragma unroll
            for (int i = 0; i < 8; ++i) f[i] = o[8 * c + i] * inv;
            *(v4u*)(CAT + (size_t)t * ldc + 64 * h + 8 * c) = pack8(f); }
    }
}


typedef short v4i16_t __attribute__((ext_vector_type(4)));
__device__ __forceinline__ int crow(int r, int hi) { return (r & 3) + 8 * (r >> 2) + 4 * hi; }
__device__ __forceinline__ unsigned cvtpk(float lo, float hi) { unsigned r; asm volatile("s_nop 0\n\tv_cvt_pk_bf16_f32 %0, %1, %2" : "=v"(r) : "v"(lo), "v"(hi)); return r; }
__device__ __forceinline__ s16x4 vtr(const LAS unsigned char* p) { return __builtin_bit_cast(s16x4, __builtin_amdgcn_ds_read_tr16_b64_v4i16((LAS v4i16_t*)p)); }
constexpr int VROWB = 144;
constexpr float C2 = 0.125f * 1.4426950408889634f;
struct AttnP { const bf16* kbase; size_t kstride; int voff, j0, nsub; float slope2; };
struct AttnS { float m, l; f32x16 o0, o1; };
template <int NBLK>
__device__ __forceinline__ void attn_load_k(bf16x8 (&kf)[2][4], int kb0, const AttnP& P, int lane) {
    const int r32 = lane & 31, hh = lane >> 5;
#pragma unroll
    for (int b = 0; b < NBLK; ++b) {
        int jk = P.j0 - 64 + 32 * (kb0 + b) + r32; jk = jk < 0 ? 0 : (jk > P.nsub - 1 ? P.nsub - 1 : jk);
        const bf16* kr = P.kbase + (size_t)jk * P.kstride + 8 * hh;
#pragma unroll
        for (int ks = 0; ks < 4; ++ks) kf[b][ks] = *(const bf16x8*)(kr + 16 * ks);
    }
}
template <int NBLK, int NNEXT, bool DIL>
__device__ __forceinline__ void attn_chunk(AttnS& st, const bf16x8 (&qf)[4], bf16x8 (&kf)[2][4], int kb0, const AttnP& P, LAS unsigned char* vl, int lane) {
    const int r32 = lane & 31, hh = lane >> 5;
    v4u vv[NBLK][4];
#pragma unroll
    for (int b = 0; b < NBLK; ++b)
#pragma unroll
        for (int i = 0; i < 4; ++i) { const int row = (lane >> 3) + 8 * i; int jk = P.j0 - 64 + 32 * (kb0 + b) + row; jk = jk < 0 ? 0 : (jk > P.nsub - 1 ? P.nsub - 1 : jk);
            vv[b][i] = *(const v4u*)(P.kbase + (size_t)jk * P.kstride + P.voff + (lane & 7) * 8); }
    f32x16 sc[NBLK];
#pragma unroll
    for (int b = 0; b < NBLK; ++b) {
        f32x16 a = {};
#pragma unroll
        for (int ks = 0; ks < 4; ++ks) a = __builtin_amdgcn_mfma_f32_32x32x16_bf16(kf[b][ks], qf[ks], a, 0, 0, 0);
        sc[b] = a;
    }
    if (NNEXT > 0) attn_load_k<NNEXT>(kf, kb0 + NBLK, P, lane);
    float mc = -INFINITY;
    int dbase = 4 * hh - 64 - r32; asm volatile("" : "+v"(dbase));
    const int jbase = P.j0 + dbase + r32;
#pragma unroll
    for (int b = 0; b < NBLK; ++b)
#pragma unroll
        for (int r = 0; r < 16; ++r) {
            float v = sc[b][r] * C2;
            if (DIL) { const int kc = 32 * (kb0 + b) + (r & 3) + 8 * (r >> 2), df = dbase + kc, jk = jbase + kc, ad = df < 0 ? -df : df;
                v = (ad <= 64 && (unsigned)jk < (unsigned)P.nsub) ? v - P.slope2 * (float)ad : -INFINITY; }
            sc[b][r] = v; mc = fmaxf(mc, v);
        }
    mc = fmaxf(mc, __shfl_xor(mc, 32));
    const float mn = fmaxf(st.m, mc), alpha = __builtin_amdgcn_exp2f(st.m - mn); st.m = mn;
    float ps = 0.f;
#pragma unroll
    for (int b = 0; b < NBLK; ++b)
#pragma unroll
        for (int r = 0; r < 16; ++r) { const float pv = __builtin_amdgcn_exp2f(sc[b][r] - mn); sc[b][r] = pv; ps += pv; }
    ps += __shfl_xor(ps, 32);
    st.l = st.l * alpha + ps;
    st.o0 = st.o0 * alpha; st.o1 = st.o1 * alpha;
    const int G = lane >> 4, i16 = lane & 15;
    const LAS unsigned char* trb = vl + (4 * hh + (i16 >> 2)) * VROWB + (16 * (G & 1) + 4 * (i16 & 3)) * 2;
#pragma unroll
    for (int b = 0; b < NBLK; ++b) {
#pragma unroll
        for (int i = 0; i < 4; ++i) *(LAS v4u*)(vl + ((lane >> 3) + 8 * i) * VROWB + (lane & 7) * 16) = vv[b][i];
        asm volatile("s_waitcnt lgkmcnt(0)" ::: "memory");
#pragma unroll
        for (int ss = 0; ss < 2; ++ss) {
            v4u pw; pw.x = cvtpk(sc[b][8 * ss + 0], sc[b][8 * ss + 1]); pw.y = cvtpk(sc[b][8 * ss + 2], sc[b][8 * ss + 3]); pw.z = cvtpk(sc[b][8 * ss + 4], sc[b][8 * ss + 5]); pw.w = cvtpk(sc[b][8 * ss + 6], sc[b][8 * ss + 7]);
            const bf16x8 pf = __builtin_bit_cast(bf16x8, pw);
            const s16x4 l0 = vtr(trb + (16 * ss) * VROWB), h0 = vtr(trb + (16 * ss + 8) * VROWB), l1 = vtr(trb + (16 * ss) * VROWB + 64), h1 = vtr(trb + (16 * ss + 8) * VROWB + 64);
            st.o0 = __builtin_amdgcn_mfma_f32_32x32x16_bf16((bf16x8){l0[0], l0[1], l0[2], l0[3], h0[0], h0[1], h0[2], h0[3]}, pf, st.o0, 0, 0, 0);
            st.o1 = __builtin_amdgcn_mfma_f32_32x32x16_bf16((bf16x8){l1[0], l1[1], l1[2], l1[3], h1[0], h1[1], h1[2], h1[3]}, pf, st.o1, 0, 0, 0);
        }
        asm volatile("s_waitcnt lgkmcnt(0)" ::: "memory");
    }
}
__device__ __forceinline__ void memattn_fast(const Frame& F, const bf16* H, int ldh, int qoff, const bf16* MEMKV, bf16* CAT, int ldc, int coff) {
    LAS unsigned char* vl = F.lds + F.wave * 16384;
    const int lane = F.lane, r32 = lane & 31, hh = lane >> 5;
    for (int u = F.gw; u < NB * 4 * 64; u += NGW) {
        const int qb = u & 63, h = (u >> 6) & 3, bb = u >> 8, t = bb * SEQ + qb * 32 + r32;
        const bf16* qrow = H + (size_t)t * ldh + qoff + 64 * h + 8 * hh;
        bf16x8 qf[4];
#pragma unroll
        for (int ks = 0; ks < 4; ++ks) qf[ks] = *(const bf16x8*)(qrow + 16 * ks);
        AttnP P; P.kbase = MEMKV + (size_t)bb * ML * 512 + 64 * h; P.kstride = 512; P.voff = 256; P.j0 = 64; P.nsub = ML; P.slope2 = 0.f;
        AttnS st; st.m = -1.0e30f; st.l = 0.f; st.o0 = f32x16{}; st.o1 = f32x16{};
        bf16x8 kf[2][4];
        attn_load_k<2>(kf, 0, P, lane);
#pragma unroll 1
        for (int c = 0; c < 3; ++c) attn_chunk<2, 2, false>(st, qf, kf, 2 * c, P, vl, lane);
        attn_chunk<2, 0, false>(st, qf, kf, 6, P, vl, lane);
        const float inv = 1.f / st.l;
        bf16* orow = CAT + (size_t)t * ldc + coff + 64 * h + 4 * hh;
#pragma unroll
        for (int rg = 0; rg < 4; ++rg) {
            v2u a; a.x = cvtpk(st.o0[4 * rg] * inv, st.o0[4 * rg + 1] * inv); a.y = cvtpk(st.o0[4 * rg + 2] * inv, st.o0[4 * rg + 3] * inv); *(v2u*)(orow + 8 * rg) = a;
            v2u c; c.x = cvtpk(st.o1[4 * rg] * inv, st.o1[4 * rg + 1] * inv); c.y = cvtpk(st.o1[4 * rg + 2] * inv, st.o1[4 * rg + 3] * inv); *(v2u*)(orow + 32 + 8 * rg) = c;
        }
    }
}
__device__ __forceinline__ void dilattn_fast(const Frame& F, const bf16* H, float* OG, float* LSE) {
    LAS unsigned char* vl = F.lds + F.wave * 16384;
    const int lane = F.lane, r32 = lane & 31, hh = lane >> 5;
    for (int u = F.gw; u < NB * 4 * 3 * 64; u += NGW) {
        const int jr = u & 63, g = (u >> 6) % 3, bh = u / 192, h = bh & 3, bb = bh >> 2;
        const int dl = 1 << (2 * g), nsub = SEQ >> (2 * g), sh = 6 - 2 * g, r = jr >> sh, jblk = jr & ((1 << sh) - 1), j0 = 32 * jblk;
        const int t = bb * SEQ + (j0 + r32) * dl + r;
        const bf16* qrow = H + (size_t)t * 2560 + 256 * g + 64 * h + 8 * hh;
        bf16x8 qf[4];
#pragma unroll
        for (int ks = 0; ks < 4; ++ks) qf[ks] = *(const bf16x8*)(qrow + 16 * ks);
        AttnP P; P.kbase = H + (size_t)(bb * SEQ + r) * 2560 + 768 + 256 * g + 64 * h; P.kstride = (size_t)dl * 2560; P.voff = 768; P.j0 = j0; P.nsub = nsub;
        P.slope2 = exp2f(-8.f * (float)(4 * g + h + 1) / 12.f) * (float)dl * 1.4426950408889634f;
        AttnS st; st.m = -1.0e30f; st.l = 0.f; st.o0 = f32x16{}; st.o1 = f32x16{};
        bf16x8 kf[2][4];
        attn_load_k<2>(kf, 0, P, lane);
        attn_chunk<2, 2, true>(st, qf, kf, 0, P, vl, lane);
        attn_chunk<2, 1, true>(st, qf, kf, 2, P, vl, lane);
        attn_chunk<1, 0, true>(st, qf, kf, 4, P, vl, lane);
        const float inv = 1.f / st.l;
        float* orow = OG + ((size_t)g * T + t) * 256 + 64 * h + 4 * hh;
#pragma unroll
        for (int rg = 0; rg < 4; ++rg) {
            *(f32x4*)(orow + 8 * rg) = (f32x4){st.o0[4 * rg] * inv, st.o0[4 * rg + 1] * inv, st.o0[4 * rg + 2] * inv, st.o0[4 * rg + 3] * inv};
            *(f32x4*)(orow + 32 + 8 * rg) = (f32x4){st.o1[4 * rg] * inv, st.o1[4 * rg + 1] * inv, st.o1[4 * rg + 2] * inv, st.o1[4 * rg + 3] * inv};
        }
        if (hh == 0) LSE[((size_t)g * T + t) * 4 + h] = st.m + __builtin_amdgcn_logf(st.l);
    }
}
__device__ __forceinline__ void merge_phase(const Frame& F, const float* OG, const float* LSE, bf16* CAT) {
    const size_t gt = (size_t)blockIdx.x * NTHREADS + F.tid, NT = (size_t)GRID * NTHREADS;
    for (size_t it = gt; it < (size_t)T * 32; it += NT) {
        const int t = (int)(it >> 5), c8 = (int)(it & 31) * 8, h = c8 >> 6;
        const float l0 = LSE[(size_t)t * 4 + h], l1 = LSE[((size_t)T + t) * 4 + h], l2 = LSE[((size_t)2 * T + t) * 4 + h];
        const float mx = fmaxf(l0, fmaxf(l1, l2)); float w0 = __builtin_amdgcn_exp2f(l0 - mx), w1 = __builtin_amdgcn_exp2f(l1 - mx), w2 = __builtin_amdgcn_exp2f(l2 - mx);
        const float inv = 1.f / (w0 + w1 + w2); w0 *= inv; w1 *= inv; w2 *= inv;
        const f32x4* p0 = (const f32x4*)(OG + (size_t)t * 256 + c8); const f32x4* p1 = (const f32x4*)(OG + ((size_t)T + t) * 256 + c8); const f32x4* p2 = (const f32x4*)(OG + ((size_t)2 * T + t) * 256 + c8);
        const f32x4 a = p0[0] * w0 + p1[0] * w1 + p2[0] * w2, b = p0[1] * w0 + p1[1] * w1 + p2[1] * w2;
        v4u o; o.x = pk2(a.x, a.y); o.y = pk2(a.z, a.w); o.z = pk2(b.x, b.y); o.w = pk2(b.z, b.w);
        *(v4u*)(CAT + (size_t)t * 512 + c8) = o;
    }
}

constexpr int NPHASE = 34;
__global__ void __launch_bounds__(NTHREADS, 2) mega(Args args) {
    extern __shared__ __attribute__((aligned(16))) unsigned char lds[];
    Frame F; F.lds = (LAS unsigned char*)lds; F.tid = threadIdx.x; F.lane = F.tid & 63; F.wave = __builtin_amdgcn_readfirstlane(F.tid >> 6); F.gw = blockIdx.x * NWAVES + F.wave;
    volatile LAS unsigned* MISC = (volatile LAS unsigned*)(F.lds + MISC_OFF);
    unsigned char* ws = args.ws;
    unsigned* ctl = (unsigned*)(ws + WS_CTL);
    for (int u = F.tid; u < (LDS_BYTES - LDSCTL_OFF) / 4; u += NTHREADS) ((LAS unsigned*)(F.lds + LDSCTL_OFF))[u] = 0u;
    __syncthreads();
    const int lo = args.lo, hi = args.hi;
    XcdBarrier bar; bar.bar = ctl + CW_BAR; bar.x = 0; bar.st = nullptr;
    if (hi - lo > 1) bar = xcd_barrier_post(ctl + CW_BAR, MISC + 8);
#define IN(k) (lo <= (k) && (k) < hi)
#if PROBE == 6
#define SEAM(k) do { if (IN(k) && IN((k) + 1)) { xcd_barrier(bar); xcd_barrier(bar); } else __syncthreads(); } while (0)
#else
#define SEAM(k) do { if (IN(k) && IN((k) + 1)) xcd_barrier(bar); else __syncthreads(); } while (0)
#endif
    const float* x_in = args.in[I_X];
    int* cntWG = (int*)(ws + WS_META); int* tile_e = (int*)(ws + WS_META + 16384); int* nMp = (int*)(ws + WS_META + 32768);
    int* E01 = (int*)(ws + WS_TOK); float* W01 = (float*)(ws + WS_TOK + 262144); int* DEST = (int*)(ws + WS_TOK + 524288);
    bf16* XB = (bf16*)(ws + WS_XB); bf16* MEMB = (bf16*)(ws + WS_MEMB); bf16* MEMKV = (bf16*)(ws + WS_MEMKV);
    bf16* Hb = (bf16*)(ws + WS_SCR + SC_H); bf16* CAT = (bf16*)(ws + WS_SCR + SC_CAT); bf16* DIFF = (bf16*)(ws + WS_SCR + SC_DIFF); float* OG = (float*)(ws + WS_SCR + SC_OG); float* LSE = (float*)(ws + WS_SCR + SC_LSE);
    bf16* HID = (bf16*)(ws + WS_SCR + SC_HID); bf16* XS = (bf16*)(ws + WS_SCR + SC_XS); bf16* HS = (bf16*)(ws + WS_SCR + SC_HS); bf16* YB = XS;
    const float* ln_g = args.in[I_LNG]; const float* ln_b = args.in[I_LNB];

    bf16* WSM = (bf16*)(ws + WS_WS); bf16* WMOE = (bf16*)(ws + WS_WMOE);
    LAS int* tile_l = (LAS int*)(F.lds + LDSCTL_OFF + 1024);
#if FAST_ATTN && PROBE == 2
#define MEMATTN(...) do { memattn_fast(__VA_ARGS__); memattn_fast(__VA_ARGS__); } while (0)
#elif FAST_ATTN
#define MEMATTN memattn_fast
#else
#define MEMATTN memattn_naive
#endif
#if FP8_MOE
#define CONVERT_MOE(F_, g_, u_, d_, r_) convert_moe8(F_, g_, u_, d_, (unsigned char*)WMOE, WMOE, r_)
#else
#define CONVERT_MOE(F_, g_, u_, d_, r_) convert_moe(F_, g_, u_, d_, WMOE, r_)
#endif
#if FAST_GEMM
#define GEMM_BF16(A_, B_, M_, N_, K_, O_) do { pg8::Gemm g_{A_, B_, M_, N_, K_, 0}; pg8::StaticOrder S_; S_.init(M_, N_, GRID, (int)blockIdx.x); pg8::EpiBf16<0> E_{O_, N_, nullptr, 0, 0, 1.f}; \
        pg8::gemm_phase<pg8::EpiBf16<0>, pg8::StaticOrder, true, true>(F.lds, g_, S_, E_); } while (0)
#define GEMM_RESID(A_, B_, K_, BASE_) do { pg8::Gemm g_{A_, B_, T, D, K_, 0}; pg8::StaticOrder S_; S_.init(T, D, GRID, (int)blockIdx.x); pg8::EpiResidB<false> E_{BASE_, XB, ALPHA}; \
        pg8::gemm_phase<pg8::EpiResidB<false>, pg8::StaticOrder, true, true>(F.lds, g_, S_, E_); } while (0)
#define GEMM_RESID_DUMMY(A_, B_, K_, BASE_) do { pg8::Gemm g_{A_, B_, T, D, K_, 0}; pg8::StaticOrder S_; S_.init(T, D, GRID, (int)blockIdx.x); pg8::EpiResidB<false> E_{BASE_, HS, ALPHA}; \
        pg8::gemm_phase<pg8::EpiResidB<false>, pg8::StaticOrder, true, true>(F.lds, g_, S_, E_); } while (0)
#define GEMM_RESID0(A_, B_, K_, BASE_) do { pg8::Gemm g_{A_, B_, T, D, K_, 0}; pg8::StaticOrder S_; S_.init(T, D, GRID, (int)blockIdx.x); pg8::EpiResidB<true> E_{BASE_, XB, ALPHA}; \
        pg8::gemm_phase<pg8::EpiResidB<true>, pg8::StaticOrder, true, true>(F.lds, g_, S_, E_); } while (0)
#define GEMM_SWIGLU(A_, B_, M_, NH_, O_) do { pg8::Gemm g_{A_, B_, M_, 2 * (NH_), D, 0}; pg8::StaticOrder S_; S_.init(M_, 2 * (NH_), GRID, (int)blockIdx.x); pg8::EpiSwiglu E_{O_, NH_, EMU_FP8 == 2, 1.f}; \
        pg8::gemm_phase<pg8::EpiSwiglu, pg8::StaticOrder, true, true>(F.lds, g_, S_, E_); } while (0)
#define MOE_TILE_LDS(n_) do { for (int i_ = F.tid; i_ < (n_); i_ += NTHREADS) tile_l[i_] = ld_i32_agent(tile_e + i_); __syncthreads(); } while (0)
#if FP8_D && !FP8_GU
constexpr size_t WB_MD8 = 2 * OFF_MD;
#else
constexpr size_t WB_MD8 = OFF8_MD;
#endif
#if FP8_GU
#define MOE_GU_GEMM pg8::Gemm g_{XS, WMOE + OFF8_MGU / 2, nM_ * 256, 2 * FFE, D / 2, 0x7F7F7F7F}; const size_t es_ = (size_t)FFE * D; constexpr bool f8_ = true; const float sc_ = 1.f / QS_GU
#else
#define MOE_GU_GEMM pg8::Gemm g_{XS, WMOE + OFF_MGU, nM_ * 256, 2 * FFE, D, 0}; const size_t es_ = (size_t)2 * FFE * D; constexpr bool f8_ = false; const float sc_ = 1.f
#endif
#if FP8_D
#define GEMM_MOE_GU() do { const int nM_ = ld_i32_agent(nMp); MOE_GU_GEMM; pg8::MoeOrder S_; S_.init(nM_ * 256, 2 * FFE, GRID, (int)blockIdx.x); MOE_TILE_LDS(nM_); S_.tile_e = tile_l; S_.estride = es_; \
        pg8::EpiSwiglu8 E_{(unsigned char*)HS, FFE, sc_}; pg8::gemm_phase<pg8::EpiSwiglu8, pg8::MoeOrder, true, true, f8_>(F.lds, g_, S_, E_); } while (0)
#define GEMM_MOE_D() do { const int nM_ = ld_i32_agent(nMp); pg8::Gemm g_{HS, WMOE + WB_MD8 / 2, nM_ * 256, D, FFE / 2, 0x7F7F7F7F}; pg8::MoeOrder S_; S_.init(nM_ * 256, D, GRID, (int)blockIdx.x); MOE_TILE_LDS(nM_); S_.tile_e = tile_l; S_.estride = (size_t)D * FFE / 2; \
        pg8::EpiBf16<0> E_{YB, D, nullptr, 0, 0, 1.f / QS_D}; pg8::gemm_phase<pg8::EpiBf16<0>, pg8::MoeOrder, true, true, true>(F.lds, g_, S_, E_); } while (0)
#else
#define GEMM_MOE_GU() do { const int nM_ = ld_i32_agent(nMp); MOE_GU_GEMM; pg8::MoeOrder S_; S_.init(nM_ * 256, 2 * FFE, GRID, (int)blockIdx.x); MOE_TILE_LDS(nM_); S_.tile_e = tile_l; S_.estride = es_; \
        pg8::EpiSwiglu E_{HS, FFE, EMU_FP8 != 0, sc_}; pg8::gemm_phase<pg8::EpiSwiglu, pg8::MoeOrder, true, true, f8_>(F.lds, g_, S_, E_); } while (0)
#define GEMM_MOE_D() do { const int nM_ = ld_i32_agent(nMp); pg8::Gemm g_{HS, WMOE + OFF_MD, nM_ * 256, D, FFE, 0}; pg8::MoeOrder S_; S_.init(nM_ * 256, D, GRID, (int)blockIdx.x); MOE_TILE_LDS(nM_); S_.tile_e = tile_l; S_.estride = (size_t)D * FFE; \
        pg8::EpiBf16<0> E_{YB, D, nullptr, 0, 0, 1.f}; pg8::gemm_phase<pg8::EpiBf16<0>, pg8::MoeOrder, true, true>(F.lds, g_, S_, E_); } while (0)
#endif
#endif

    if (IN(0)) { prep_phase(F, x_in, args.in[I_MEM], XB, MEMB);
#if FAST_GEMM
        { int rot = 0; convert_small(F, args, WSM, rot); CONVERT_MOE(F, args.in[I_MG], args.in[I_MU], args.in[I_MD], rot); fold_pool(F, args.in[I_CPOOLW], args.in[I_CPOOLS], args.in[I_CWOUT], WSM + OFF_COUT); }
#if PROBE == 1
        { int rot = 0; convert_small(F, args, WSM, rot); CONVERT_MOE(F, args.in[I_MG], args.in[I_MU], args.in[I_MD], rot); fold_pool(F, args.in[I_CPOOLW], args.in[I_CPOOLS], args.in[I_CWOUT], WSM + OFF_COUT); }
#endif
#if PROBE == 7
        prep_phase(F, x_in, args.in[I_MEM], XB, MEMB);
#endif
#endif
        SEAM(0); }
    if (IN(1)) {
#if FAST_GEMM
        GEMM_BF16(MEMB, WSM + OFF_WKV, NB * ML, 512, D, MEMKV);
#else
        naive_gemm<1>(F, MEMB, D, args.in[I_WMEMKV], nullptr, 512, NB * ML, 512, D, NEpiBf16{MEMKV, 512}, nullptr, 0);
#endif
        SEAM(1); }

    if (IN(2)) {
#if FAST_GEMM
        GEMM_BF16(XB, WSM + OFF_AIN, T, 2560, D, Hb);
#if PROBE == 11
        GEMM_BF16(XB, WSM + OFF_AIN, T, 2560, D, Hb);
#endif
#else
        naive_gemm<1>(F, XB, D, args.in[I_AWIN], nullptr, 2560, T, 2560, D, NEpiBf16{Hb, 2560}, nullptr, 0);
#endif
        SEAM(2); }
    if (IN(3)) { mixA_phase(F, Hb, args.in[I_ACONV], CAT);
#if PROBE == 4
        mixA_phase(F, Hb, args.in[I_ACONV], CAT);
#endif
 MEMATTN(F, Hb, 2560, 2304, MEMKV, CAT, 1024, 768); SEAM(3); }
    if (IN(4)) {
#if FAST_GEMM
        GEMM_RESID0(CAT, WSM + OFF_AOUT, 1024, x_in);
#else
        naive_gemm<1>(F, CAT, 1024, args.in[I_AWOUT], nullptr, D, T, D, 1024, NEpiResid{x_in, nullptr, XB}, nullptr, 0);
#endif
        SEAM(4); }
    if (IN(5)) {
#if PROBE == 3
        ln_phase<false, false, false>(F, XB, HS, nullptr, ln_g + 0 * D, ln_b + 0 * D, nullptr, nullptr, nullptr, nullptr, nullptr, nullptr);
#endif
        ln_phase<false, false, false>(F, XB, XB, nullptr, ln_g + 0 * D, ln_b + 0 * D, nullptr, nullptr, nullptr, nullptr, nullptr, nullptr); SEAM(5); }
    if (IN(6)) {
#if FAST_GEMM
        GEMM_SWIGLU(XB, WSM + OFF_FGU, T, FF, HID);
#if PROBE == 10
        GEMM_SWIGLU(XB, WSM + OFF_FGU, T, FF, HID);
#endif
#if PROBE == 14
        { pg8::Gemm g_{XB, WSM + OFF_FGU, T, 2 * FF, D, 0}; pg8::StaticOrder S_; S_.init(T, 2 * FF, GRID, (int)blockIdx.x); pg8::EpiNull E_{}; pg8::gemm_phase<pg8::EpiNull, pg8::StaticOrder, true, true>(F.lds, g_, S_, E_); }
#endif
#else
        naive_gemm<2>(F, XB, D, args.in[I_FG], args.in[I_FU], FF, T, FF, D, NEpiSwiglu{HID, FF}, nullptr, 0);
#endif
        SEAM(6); }
    if (IN(7)) {
#if FAST_GEMM
#if PROBE == 12
        GEMM_RESID_DUMMY(HID, WSM + OFF_FD, FF, XB);
#endif
        GEMM_RESID(HID, WSM + OFF_FD, FF, XB);
#else
        naive_gemm<1>(F, HID, FF, args.in[I_FD], nullptr, D, T, D, FF, NEpiResid{nullptr, XB, XB}, nullptr, 0);
#endif
        SEAM(7); }
    if (IN(8)) {
#if PROBE == 3
        ln_phase<false, false, false>(F, XB, HS, nullptr, ln_g + 1 * D, ln_b + 1 * D, nullptr, nullptr, nullptr, nullptr, nullptr, nullptr);
#endif
        ln_phase<false, false, false>(F, XB, XB, nullptr, ln_g + 1 * D, ln_b + 1 * D, nullptr, nullptr, nullptr, nullptr, nullptr, nullptr); SEAM(8); }

    if (IN(9)) {
#if FAST_GEMM
        GEMM_BF16(XB, WSM + OFF_BIN, T, 2560, D, Hb);
#if PROBE == 11
        GEMM_BF16(XB, WSM + OFF_BIN, T, 2560, D, Hb);
#endif
#else
        naive_gemm<1>(F, XB, D, args.in[I_BWIN], nullptr, 2560, T, 2560, D, NEpiBf16{Hb, 2560}, nullptr, 0);
#endif
        SEAM(9); }
#if FAST_ATTN
    if (IN(10)) { dilattn_fast(F, Hb, OG, LSE);
#if PROBE == 2
        dilattn_fast(F, Hb, OG, LSE);
#endif
        MEMATTN(F, Hb, 2560, 2304, MEMKV, CAT, 512, 256); SEAM(10); }
    if (IN(11)) { merge_phase(F, OG, LSE, CAT);
#if PROBE == 2
        merge_phase(F, OG, LSE, CAT);
#endif
        SEAM(11); }
#else
    if (IN(10)) { dilattn_naive(F, Hb, CAT, 512); MEMATTN(F, Hb, 2560, 2304, MEMKV, CAT, 512, 256); SEAM(10); }
    if (IN(11)) { SEAM(11); }
#endif
    if (IN(12)) {
#if FAST_GEMM
        GEMM_RESID(CAT, WSM + OFF_BOUT, 512, XB);
#else
        naive_gemm<1>(F, CAT, 512, args.in[I_BWOUT], nullptr, D, T, D, 512, NEpiResid{nullptr, XB, XB}, nullptr, 0);
#endif
        SEAM(12); }
    if (IN(13)) { ln_phase<true, false, false>(F, XB, XB, nullptr, ln_g + 2 * D, ln_b + 2 * D, args.in[I_ROUTER], E01, W01, nullptr, nullptr, cntWG); SEAM(13); }
    if (IN(14)) { scatter_phase(F, cntWG, E01, DEST, XB, XS, tile_e, nMp);
#if PROBE == 5
        scatter_phase(F, cntWG, E01, DEST, XB, XS, tile_e, nMp);
#endif
        SEAM(14); }
    if (IN(15)) {
#if FAST_GEMM
        GEMM_MOE_GU();
#if PROBE == 8
        GEMM_MOE_GU();
#endif
#if PROBE == 13
        { const int nM_ = ld_i32_agent(nMp); MOE_GU_GEMM; pg8::MoeOrder S_; S_.init(nM_ * 256, 2 * FFE, GRID, (int)blockIdx.x); MOE_TILE_LDS(nM_); S_.tile_e = tile_l; S_.estride = es_; (void)sc_; pg8::EpiNull E_{}; pg8::gemm_phase<pg8::EpiNull, pg8::MoeOrder, true, true, f8_>(F.lds, g_, S_, E_); }
#endif
#else
        const int nM = ld_i32_agent(nMp); naive_gemm<2>(F, XS, D, args.in[I_MG], args.in[I_MU], FFE, nM * 256, FFE, D, NEpiSwiglu{HS, FFE}, tile_e, (size_t)D * FFE);
#endif
        SEAM(15); }
    if (IN(16)) {
#if FAST_GEMM
        GEMM_MOE_D();
#if PROBE == 9
        GEMM_MOE_D();
#endif
#else
        const int nM = ld_i32_agent(nMp); naive_gemm<1>(F, HS, FFE, args.in[I_MD], nullptr, D, nM * 256, D, FFE, NEpiBf16{YB, D}, tile_e, (size_t)FFE * D);
#endif
        SEAM(16); }
    if (IN(17)) { ln_phase<false, true, false>(F, XB, XB, nullptr, ln_g + 3 * D, ln_b + 3 * D, nullptr, nullptr, W01, DEST, YB, nullptr); SEAM(17); }

    if (IN(18)) {
#if FAST_GEMM
        GEMM_BF16(XB, WSM + OFF_CIN, T, 1024, D, Hb);
#if PROBE == 11
        GEMM_BF16(XB, WSM + OFF_CIN, T, 1024, D, Hb);
#endif
#else
        naive_gemm<1>(F, XB, D, args.in[I_CWIN], nullptr, 1024, T, 1024, D, NEpiBf16{Hb, 1024}, nullptr, 0);
#endif
        SEAM(18); }
#if FAST_GEMM
    if (IN(19)) { poolC_phase(F, Hb, CAT, 1024);
#if PROBE == 4
        poolC_phase(F, Hb, CAT, 1024);
#endif
        MEMATTN(F, Hb, 1024, 768, MEMKV, CAT, 1024, 768);
        { int rot = 0; CONVERT_MOE(F, args.in[I_MG] + (size_t)NE * D * FFE, args.in[I_MU] + (size_t)NE * D * FFE, args.in[I_MD] + (size_t)NE * FFE * D, rot); }
#if PROBE == 1
        { int rot = 0; CONVERT_MOE(F, args.in[I_MG] + (size_t)NE * D * FFE, args.in[I_MU] + (size_t)NE * D * FFE, args.in[I_MD] + (size_t)NE * FFE * D, rot); }
#endif
        SEAM(19); }
#else
    if (IN(19)) { poolC_phase(F, Hb, DIFF, 768); MEMATTN(F, Hb, 1024, 768, MEMKV, CAT, 1024, 768); SEAM(19); }
    if (IN(20)) {
#pragma unroll 1
        for (int g = 0; g < 4; ++g) naive_gemm<1>(F, DIFF + 192 * g, 768, args.in[I_CPOOLW] + (size_t)g * 192 * 192, nullptr, 192, T, 192, 192, NEpiScale{CAT, 1024, 192 * g, args.in[I_CPOOLS]}, nullptr, 0);
        SEAM(20); }
#endif
    if (IN(21)) {
#if FAST_GEMM
#if PROBE == 12
        GEMM_RESID_DUMMY(CAT, WSM + OFF_COUT, 1024, XB);
#endif
        GEMM_RESID(CAT, WSM + OFF_COUT, 1024, XB);
#else
        naive_gemm<1>(F, CAT, 1024, args.in[I_CWOUT], nullptr, D, T, D, 1024, NEpiResid{nullptr, XB, XB}, nullptr, 0);
#endif
        SEAM(21); }
    if (IN(22)) {
#if PROBE == 3
        ln_phase<false, false, false>(F, XB, HS, nullptr, ln_g + 4 * D, ln_b + 4 * D, nullptr, nullptr, nullptr, nullptr, nullptr, nullptr);
#endif
        ln_phase<false, false, false>(F, XB, XB, nullptr, ln_g + 4 * D, ln_b + 4 * D, nullptr, nullptr, nullptr, nullptr, nullptr, nullptr); SEAM(22); }
    if (IN(23)) {
#if FAST_GEMM
        GEMM_SWIGLU(XB, WSM + OFF_FGU + (size_t)2 * FF * D, T, FF, HID);
#if PROBE == 10
        GEMM_SWIGLU(XB, WSM + OFF_FGU + (size_t)2 * FF * D, T, FF, HID);
#endif
#if PROBE == 14
        { pg8::Gemm g_{XB, WSM + OFF_FGU + (size_t)2 * FF * D, T, 2 * FF, D, 0}; pg8::StaticOrder S_; S_.init(T, 2 * FF, GRID, (int)blockIdx.x); pg8::EpiNull E_{}; pg8::gemm_phase<pg8::EpiNull, pg8::StaticOrder, true, true>(F.lds, g_, S_, E_); }
#endif
#else
        naive_gemm<2>(F, XB, D, args.in[I_FG] + (size_t)D * FF, args.in[I_FU] + (size_t)D * FF, FF, T, FF, D, NEpiSwiglu{HID, FF}, nullptr, 0);
#endif
        SEAM(23); }
    if (IN(24)) {
#if FAST_GEMM
#if PROBE == 12
        GEMM_RESID_DUMMY(HID, WSM + OFF_FD + (size_t)D * FF, FF, XB);
#endif
        GEMM_RESID(HID, WSM + OFF_FD + (size_t)D * FF, FF, XB);
#else
        naive_gemm<1>(F, HID, FF, args.in[I_FD] + (size_t)FF * D, nullptr, D, T, D, FF, NEpiResid{nullptr, XB, XB}, nullptr, 0);
#endif
        SEAM(24); }
    if (IN(25)) {
#if PROBE == 3
        ln_phase<false, false, false>(F, XB, HS, nullptr, ln_g + 5 * D, ln_b + 5 * D, nullptr, nullptr, nullptr, nullptr, nullptr, nullptr);
#endif
        ln_phase<false, false, false>(F, XB, XB, nullptr, ln_g + 5 * D, ln_b + 5 * D, nullptr, nullptr, nullptr, nullptr, nullptr, nullptr); SEAM(25); }

    if (IN(26)) {
#if FAST_GEMM
        GEMM_BF16(XB, WSM + OFF_AIN + (size_t)2560 * D, T, 2560, D, Hb);
#if PROBE == 11
        GEMM_BF16(XB, WSM + OFF_AIN + (size_t)2560 * D, T, 2560, D, Hb);
#endif
#else
        naive_gemm<1>(F, XB, D, args.in[I_AWIN] + (size_t)D * 2560, nullptr, 2560, T, 2560, D, NEpiBf16{Hb, 2560}, nullptr, 0);
#endif
        SEAM(26); }
    if (IN(27)) { mixA_phase(F, Hb, args.in[I_ACONV] + 3 * 768, CAT);
#if PROBE == 4
        mixA_phase(F, Hb, args.in[I_ACONV] + 3 * 768, CAT);
#endif
 MEMATTN(F, Hb, 2560, 2304, MEMKV, CAT, 1024, 768); SEAM(27); }
    if (IN(28)) {
#if FAST_GEMM
        GEMM_RESID(CAT, WSM + OFF_AOUT + (size_t)D * D, 1024, XB);
#else
        naive_gemm<1>(F, CAT, 1024, args.in[I_AWOUT] + (size_t)D * D, nullptr, D, T, D, 1024, NEpiResid{nullptr, XB, XB}, nullptr, 0);
#endif
        SEAM(28); }
    if (IN(29)) { ln_phase<true, false, false>(F, XB, XB, nullptr, ln_g + 6 * D, ln_b + 6 * D, args.in[I_ROUTER] + D * NE, E01, W01, nullptr, nullptr, cntWG); SEAM(29); }
    if (IN(30)) { scatter_phase(F, cntWG, E01, DEST, XB, XS, tile_e, nMp);
#if PROBE == 5
        scatter_phase(F, cntWG, E01, DEST, XB, XS, tile_e, nMp);
#endif
        SEAM(30); }
    if (IN(31)) {
#if FAST_GEMM
        GEMM_MOE_GU();
#if PROBE == 8
        GEMM_MOE_GU();
#endif
#if PROBE == 13
        { const int nM_ = ld_i32_agent(nMp); MOE_GU_GEMM; pg8::MoeOrder S_; S_.init(nM_ * 256, 2 * FFE, GRID, (int)blockIdx.x); MOE_TILE_LDS(nM_); S_.tile_e = tile_l; S_.estride = es_; (void)sc_; pg8::EpiNull E_{}; pg8::gemm_phase<pg8::EpiNull, pg8::MoeOrder, true, true, f8_>(F.lds, g_, S_, E_); }
#endif
#else
        const int nM = ld_i32_agent(nMp); naive_gemm<2>(F, XS, D, args.in[I_MG] + (size_t)NE * D * FFE, args.in[I_MU] + (size_t)NE * D * FFE, FFE, nM * 256, FFE, D, NEpiSwiglu{HS, FFE}, tile_e, (size_t)D * FFE);
#endif
        SEAM(31); }
    if (IN(32)) {
#if FAST_GEMM
        GEMM_MOE_D();
#if PROBE == 9
        GEMM_MOE_D();
#endif
#else
        const int nM = ld_i32_agent(nMp); naive_gemm<1>(F, HS, FFE, args.in[I_MD] + (size_t)NE * FFE * D, nullptr, D, nM * 256, D, FFE, NEpiBf16{YB, D}, tile_e, (size_t)FFE * D);
#endif
        SEAM(32); }
    if (IN(33)) { ln_phase<false, true, true>(F, XB, nullptr, args.out, ln_g + 7 * D, ln_b + 7 * D, nullptr, nullptr, W01, DEST, YB, nullptr); }
#undef IN
#undef SEAM
}

extern "C" void kernel_launch(void* const* d_in, const int* in_sizes, int n_in, void* d_out, int out_size, void* d_ws, size_t ws_size, hipStream_t stream) {
    static int ok = 0;
    if (ok == 0) {
        ok = 1;
        if (n_in != 21 || out_size != T * D || ws_size < WS_END) { fprintf(stderr, "kernel_launch: unexpected shapes (n_in %d, out %d, ws %zu < %zu)\n", n_in, out_size, ws_size, (size_t)WS_END); ok = -1; }
        if (ok > 0 && hipFuncSetAttribute((const void*)mega, hipFuncAttributeMaxDynamicSharedMemorySize, LDS_BYTES) != hipSuccess) { fprintf(stderr, "kernel_launch: hipFuncSetAttribute failed\n"); ok = -1; }
        int dev = 0, cus = 0; (void)hipGetDevice(&dev); (void)hipDeviceGetAttribute(&cus, hipDeviceAttributeMultiprocessorCount, dev);
        if (cus < GRID) { fprintf(stderr, "kernel_launch: %d CUs < %d\n", cus, GRID); ok = -1; }
        (void)hipGetLastError();
    }
    if (ok < 0) return;
    (void)hipMemsetAsync((char*)d_ws + WS_CTL, 0, CTL_ZERO_BYTES, stream);
    Args a{};
    for (int i = 0; i < 21; ++i) a.in[i] = (const float*)d_in[i];
    a.out = (float*)d_out; a.ws = (unsigned char*)d_ws;
#if MK_ONE_LAUNCH
    a.lo = 0; a.hi = NPHASE;
    hipLaunchKernelGGL(mega, dim3(GRID), dim3(NTHREADS), LDS_BYTES, stream, a);
#else
    for (int p = 0; p < NPHASE; ++p) { if (p == 11) continue; a.lo = p; a.hi = p + 1; hipLaunchKernelGGL(mega, dim3(GRID), dim3(NTHREADS), LDS_BYTES, stream, a); }
#endif
}
```
